# Optimizing an MI355X kernel written in HIP

```python
import jax, jax.numpy as jnp
from jax import lax
import numpy as np

D_MODEL = 1024
BATCH = 2
SEQ = 16384
DEPTH = 2

GRID_W = 64
CTX_LEN = 256
N_MIXERS = 2
N_EVEN_LAYERS = (DEPTH + 1) // 2
N_ODD_LAYERS = DEPTH // 2
POOL_WINDOWS = (2, 4, 8, 16)
N_POOL_GROUPS = len(POOL_WINDOWS)
POOL_GROUP_DIM = D_MODEL // N_POOL_GROUPS
HEAD_DIM = 64
N_HEADS = D_MODEL // HEAD_DIM
N_KV_HEADS = 4
GROUP = N_HEADS // N_KV_HEADS
Q_DIM = N_HEADS * HEAD_DIM
KV_DIM = N_KV_HEADS * HEAD_DIM
ROPE_THETA = 10000.0
Q_BLOCK = 128
D_FF = 2816
N_EXPERTS = 8
TOP_K = 2
MOE_BLOCK = 256
NORM_EPS = 1e-6
N_MOD = 6

kernel_name = "hybrid_pool_gqa_moe_dit_block"


def rmsnorm(x, g):
    xf = x.astype(jnp.float32)
    y = xf * lax.rsqrt(jnp.mean(xf * xf, axis=-1, keepdims=True) + NORM_EPS)
    return (y * g.astype(jnp.float32)).astype(x.dtype)


def adaln(cvec, w, b):
    m = jax.nn.silu(cvec.astype(jnp.float32)) @ w.astype(jnp.float32) + b.astype(jnp.float32)
    m = m.astype(cvec.dtype)[:, None, :]
    return jnp.split(m, N_MOD, axis=-1)


def modulate(h, shift, scale):
    return h * (1.0 + scale) + shift


def pool_mix(h, w_grp, scale):
    B, L, D = h.shape
    h4 = h.reshape(B, L, N_POOL_GROUPS, POOL_GROUP_DIM)
    cs = jnp.cumsum(h4.astype(jnp.float32), axis=1)
    cs = jnp.concatenate([jnp.zeros_like(cs[:, :1]), cs], axis=1)
    t = jnp.arange(L, dtype=jnp.int32)[:, None]
    half = jnp.asarray(POOL_WINDOWS, dtype=jnp.int32) // 2
    lo = jnp.clip(t - half, 0, L)
    hi = jnp.clip(t + half, 0, L)
    gid = jnp.arange(N_POOL_GROUPS, dtype=jnp.int32)[None, :]
    win_sum = cs[:, hi, gid] - cs[:, lo, gid]
    mean = win_sum / (hi - lo).astype(jnp.float32)[None, :, :, None]
    d = (mean - h4.astype(jnp.float32)).astype(h.dtype)
    y = jnp.einsum('blgc,gce->blge', d, w_grp).reshape(B, L, D)
    return y * scale


def rope_1d(x, pos):
    half = x.shape[-1] // 2
    freqs = ROPE_THETA ** (-jnp.arange(half, dtype=jnp.float32) / half)
    ang = pos.astype(jnp.float32)[:, None] * freqs
    shape = (ang.shape[0],) + (1,) * (x.ndim - 3) + (half,)
    cos = jnp.cos(ang).reshape(shape)
    sin = jnp.sin(ang).reshape(shape)
    x1, x2 = x[..., :half], x[..., half:]
    return jnp.concatenate([x1 * cos - x2 * sin, x2 * cos + x1 * sin], axis=-1).astype(x.dtype)


def rope_2d(x, row, col):
    d = HEAD_DIM // 2
    return jnp.concatenate([rope_1d(x[..., :d], row), rope_1d(x[..., d:], col)], axis=-1)


def heads_q(q_flat, g):
    B, L = q_flat.shape[:2]
    return rmsnorm(q_flat.reshape(B, L, N_KV_HEADS, GROUP, HEAD_DIM), g)


def heads_kv(kv_flat, g):
    B, L = kv_flat.shape[:2]
    kv = kv_flat.reshape(B, L, 2, N_KV_HEADS, HEAD_DIM)
    return rmsnorm(kv[:, :, 0], g), kv[:, :, 1]


def attend(q, k, v):
    B, Lq = q.shape[:2]
    nb = Lq // Q_BLOCK
    qb = q.reshape(B, nb, Q_BLOCK, N_KV_HEADS, GROUP, HEAD_DIM).swapaxes(0, 1)
    sm_scale = HEAD_DIM ** -0.5

    def one_block(qblk):
        s = jnp.einsum('bqkgd,bnkd->bkgqn', qblk, k, preferred_element_type=jnp.float32) * sm_scale
        p = jax.nn.softmax(s, axis=-1)
        return jnp.einsum('bkgqn,bnkd->bqkgd', p.astype(v.dtype), v)

    o = lax.map(one_block, qb)
    return o.swapaxes(0, 1).reshape(B, Lq, Q_DIM)


def swiglu(h, w1, w3, w2):
    return (jax.nn.silu(h @ w1) * (h @ w3)) @ w2


def moe_swiglu(h, router_w, w1, w3, w2):
    B, L, D = h.shape
    T = B * L
    hf = h.reshape(T, D)
    logits = hf.astype(jnp.float32) @ router_w.astype(jnp.float32)
    top_logit, top_e = lax.top_k(logits, TOP_K)
    gates = jax.nn.softmax(top_logit, axis=-1)
    n_assign = T * TOP_K
    flat_e = top_e.reshape(-1)
    flat_tok = jnp.arange(n_assign, dtype=jnp.int32) // TOP_K
    flat_g = gates.reshape(-1)
    order = jnp.argsort(flat_e)
    e_sorted = flat_e[order]
    sizes = jnp.bincount(flat_e, length=N_EXPERTS)
    padded = (sizes + MOE_BLOCK - 1) // MOE_BLOCK * MOE_BLOCK
    start = jnp.cumsum(sizes) - sizes
    ends = jnp.cumsum(padded)
    pstart = ends - padded
    dest = pstart[e_sorted] + (jnp.arange(n_assign, dtype=jnp.int32) - start[e_sorted])
    cap = n_assign + N_EXPERTS * MOE_BLOCK
    n_blk = cap // MOE_BLOCK
    buf_tok = jnp.zeros((cap,), jnp.int32).at[dest].set(flat_tok[order])
    buf_gate = jnp.zeros((cap,), jnp.float32).at[dest].set(flat_g[order])
    blk_start = jnp.arange(n_blk, dtype=jnp.int32) * MOE_BLOCK
    blk_e = jnp.clip(jnp.searchsorted(ends, blk_start, side='right'), 0, N_EXPERTS - 1)

    def expert_block(args):
        tok, g, e = args
        xb = hf[tok]
        return swiglu(xb, w1[e], w3[e], w2[e]) * g[:, None].astype(xb.dtype)

    y = lax.map(expert_block, (buf_tok.reshape(n_blk, MOE_BLOCK),
                               buf_gate.reshape(n_blk, MOE_BLOCK), blk_e))
    out = jnp.zeros_like(hf).at[buf_tok].add(y.reshape(cap, D))
    return out.reshape(B, L, D)


def setup_inputs(seed: int = 0) -> dict:
    key = jax.random.key(seed)
    ks = jax.random.split(key, 21)

    def nrm(k, shape, s):
        return jax.random.normal(k, shape, jnp.float32) * s

    D = D_MODEL
    return {
        "x": nrm(ks[0], (BATCH, SEQ, D), 1.0),
        "c": nrm(ks[1], (BATCH, D), 1.0),
        "ctx": nrm(ks[2], (BATCH, CTX_LEN, D), 1.0),
        "c_ctx": nrm(ks[3], (D,), 1.0),
        "ada_w": nrm(ks[4], (DEPTH, D, N_MOD * D), 0.5 * D ** -0.5),
        "ada_b": nrm(ks[5], (DEPTH, N_MOD * D), 0.02),
        "norm_g": 1.0 + nrm(ks[6], (DEPTH, 2, D), 0.1),
        "pool_w": nrm(ks[7], (N_EVEN_LAYERS, N_POOL_GROUPS, POOL_GROUP_DIM, POOL_GROUP_DIM), POOL_GROUP_DIM ** -0.5),
        "pool_scale": 1.0 + nrm(ks[8], (N_EVEN_LAYERS, D), 0.1),
        "ffn_w1": nrm(ks[9], (N_EVEN_LAYERS, D, D_FF), D ** -0.5),
        "ffn_w3": nrm(ks[10], (N_EVEN_LAYERS, D, D_FF), D ** -0.5),
        "ffn_w2": nrm(ks[11], (N_EVEN_LAYERS, D_FF, D), D_FF ** -0.5),
        "w_qkv": nrm(ks[12], (N_ODD_LAYERS, D, Q_DIM + 2 * KV_DIM), D ** -0.5),
        "w_o": nrm(ks[13], (N_ODD_LAYERS, Q_DIM, D), Q_DIM ** -0.5),
        "q_norm_g": 1.0 + nrm(ks[14], (N_ODD_LAYERS, HEAD_DIM), 0.1),
        "k_norm_g": 1.0 + nrm(ks[15], (N_ODD_LAYERS, HEAD_DIM), 0.1),
        "router_w": nrm(ks[16], (N_ODD_LAYERS, D, N_EXPERTS), D ** -0.5),
        "moe_w1": nrm(ks[17], (N_ODD_LAYERS, N_EXPERTS, D, D_FF), D ** -0.5),
        "moe_w3": nrm(ks[18], (N_ODD_LAYERS, N_EXPERTS, D, D_FF), D ** -0.5),
        "moe_w2": nrm(ks[19], (N_ODD_LAYERS, N_EXPERTS, D_FF, D), D_FF ** -0.5),
        "final_g": 1.0 + nrm(ks[20], (D,), 0.1),
    }


def reference(x, c, ctx, c_ctx, ada_w, ada_b, norm_g, pool_w, pool_scale, ffn_w1, ffn_w3, ffn_w2,
              w_qkv, w_o, q_norm_g, k_norm_g, router_w, moe_w1, moe_w3, moe_w2, final_g):
    L = x.shape[1]
    ROWS = L // GRID_W
    t_row = jnp.repeat(jnp.arange(ROWS, dtype=jnp.int32), GRID_W)
    t_col = jnp.tile(jnp.arange(GRID_W, dtype=jnp.int32), ROWS)

    for i in range(DEPTH):
        j = i // N_MIXERS
        last = i == DEPTH - 1
        sh1, sc1, g1, sh2, sc2, g2 = adaln(c, ada_w[i], ada_b[i])
        ksh1, ksc1, kg1, ksh2, ksc2, kg2 = adaln(c_ctx[None, :], ada_w[i], ada_b[i])

        hx = modulate(rmsnorm(x, norm_g[i, 0]), sh1, sc1)
        hk = modulate(rmsnorm(ctx, norm_g[i, 0]), ksh1, ksc1)
        if i % N_MIXERS == 0:
            x = x + g1 * pool_mix(hx, pool_w[j], pool_scale[j])
            if not last:
                ctx = ctx + kg1 * pool_mix(hk, pool_w[j], pool_scale[j])
        else:
            qkv = hx @ w_qkv[j]
            qx = rope_2d(heads_q(qkv[..., :Q_DIM], q_norm_g[j]), t_row, t_col)
            kx, vx = heads_kv(qkv[..., Q_DIM:], k_norm_g[j])
            kx = rope_2d(kx, t_row, t_col)
            if last:
                kk, vk = heads_kv(hk @ w_qkv[j][:, Q_DIM:], k_norm_g[j])
            else:
                qkv_c = hk @ w_qkv[j]
                kk, vk = heads_kv(qkv_c[..., Q_DIM:], k_norm_g[j])
                qk = heads_q(qkv_c[..., :Q_DIM], q_norm_g[j])
                ctx = ctx + kg1 * (attend(qk, kk, vk) @ w_o[j])
            k_all = jnp.concatenate([kx, kk], axis=1)
            v_all = jnp.concatenate([vx, vk], axis=1)
            x = x + g1 * (attend(qx, k_all, v_all) @ w_o[j])

        hx = modulate(rmsnorm(x, norm_g[i, 1]), sh2, sc2)
        if i % N_MIXERS == 0:
            x = x + g2 * swiglu(hx, ffn_w1[j], ffn_w3[j], ffn_w2[j])
            if not last:
                hk = modulate(rmsnorm(ctx, norm_g[i, 1]), ksh2, ksc2)
                ctx = ctx + kg2 * swiglu(hk, ffn_w1[j], ffn_w3[j], ffn_w2[j])
        else:
            x = x + g2 * moe_swiglu(hx, router_w[j], moe_w1[j], moe_w3[j], moe_w2[j])
            if not last:
                hk = modulate(rmsnorm(ctx, norm_g[i, 1]), ksh2, ksc2)
                ctx = ctx + kg2 * moe_swiglu(hk, router_w[j], moe_w1[j], moe_w3[j], moe_w2[j])

    return rmsnorm(x, final_g)
```

```cpp
#include <hip/hip_runtime.h>
#include <hip/hip_bf16.h>
#include <cstdio>
#include <cstdint>
#include <cmath>

namespace pg8 {
#define PG8_LAS __attribute__((address_space(3)))
typedef unsigned short bf16_t;
typedef short bf16x8 __attribute__((ext_vector_type(8)));
typedef float f32x4 __attribute__((ext_vector_type(4)));
typedef unsigned u32x4 __attribute__((ext_vector_type(4)));
constexpr int BM = 256, BK = 64, HALF = 128, HTB = HALF * BK * 2  , STAGE_BYTES = 8 * HTB, NXCD = 8, WGM = 8;

__host__ __device__ __forceinline__ int lds_byte(int r, int c) { const int st = (r >> 4) * 2 + (c >> 5), rr = r & 15, cc = c & 31, ob = rr * 64 + cc * 2; return st * 1024 + (ob ^ (((ob >> 9) & 1) << 5)); }
__host__ __device__ __forceinline__ void stage_rc(int b, int& R, int& C) { const int st = b / 1024, sb = b % 1024, swz = sb ^ (((sb >> 9) & 1) << 5); R = (st >> 1) * 16 + swz / 64; C = (st & 1) * 32 + (swz % 64) / 2; }
__host__ __device__ __forceinline__ int perm32(int rho) { const int n = rho >> 4, i = rho & 15; return 8 * (i >> 2) + 4 * n + (i & 3); }
struct Unit { int pa, pb, pr, pc, ak; };
struct Gemm { const bf16_t* A; const bf16_t* Bt; int K, lda, ldb; };

__device__ __forceinline__ void grid_order(int L, int nM, int nN, int& pm, int& pn) {
    const int nwg = nM * nN; int wgid = L;
    { const int q = nwg / NXCD, r = nwg % NXCD, xcd = wgid % NXCD, off = wgid / NXCD; wgid = (xcd < r ? xcd * (q + 1) : r * (q + 1) + (xcd - r) * q) + off; }
    const int nig = WGM * nN, gid = wgid / nig, fm = gid * WGM, gsz = (nM - fm) < WGM ? (nM - fm) : WGM;
    pm = fm + ((wgid % nig) % gsz); pn = (wgid % nig) / gsz;
}
struct GridOrder {
    int nM, nN, G, c, akmul;
    __device__ __forceinline__ bool next(int i, Unit& u) const {
        const int L = i * G + c; if (L >= nM * nN) return false;
        int pm, pn; grid_order(L, nM, nN, pm, pn);
        u.pa = pm; u.pb = pn; u.pr = pm; u.pc = pn; u.ak = akmul * pn; return true;
    }
    __device__ __forceinline__ void a_ready(const Unit&) const {}
    __device__ __forceinline__ void done(const Unit&) const {}
};
struct QkvOrder {
    int G, c;
    __device__ __forceinline__ bool next(int i, Unit& u) const {
        const int L = i * G + c; if (L >= 772) return false;
        int pm, pn;
        if (L < 768) grid_order(L, 128, 6, pm, pn); else { pm = 128 + ((L - 768) >> 1); pn = 4 + ((L - 768) & 1); }
        u.pa = pm; u.pb = pn; u.pr = pm; u.pc = pn; u.ak = 0; return true;
    }
    __device__ __forceinline__ void a_ready(const Unit&) const {}
    __device__ __forceinline__ void done(const Unit&) const {}
};
struct MoeOrder {
    int nM, nN, G, c, lo, a_rel; const int* pexp;
    __device__ __forceinline__ bool next(int i, Unit& u) const {
        const int L = i * G + c; if (L >= nM * nN) return false;
        int pm, pn; grid_order(L, nM, nN, pm, pn);
        const int e = __builtin_amdgcn_readfirstlane(pexp[lo + pm]);
        u.pa = a_rel ? pm : lo + pm; u.pb = e * nN + pn; u.pr = a_rel ? lo + pm : pm; u.pc = pn; u.ak = 0; return true;
    }
    __device__ __forceinline__ void a_ready(const Unit&) const {}
    __device__ __forceinline__ void done(const Unit&) const {}
};

__device__ __forceinline__ unsigned cvt_pk_bf16(float lo, float hi) { unsigned r; asm volatile("v_cvt_pk_bf16_f32 %0, %1, %2" : "=v"(r) : "v"(lo), "v"(hi)); return r; }
__device__ __forceinline__ float silu_f(float a) { return a * __builtin_amdgcn_rcpf(1.0f + __builtin_amdgcn_exp2f(-1.4426950408889634f * a)); }

struct EpiBf16 {
    static constexpr bool PERM = true, AFTER_DRAIN = false;
    bf16_t* O; int ldc;
    __device__ __forceinline__ void operator()(const f32x4 (&acc)[2][2][4][2], const Unit& u, int wr, int wc, int fr, int fq) const {
        const int row0 = u.pr * BM + wr * 64 + fr, col0 = u.pc * BM + wc * 32 + 8 * fq;
#pragma unroll
        for (int ai = 0; ai < 2; ++ai)
#pragma unroll
            for (int m = 0; m < 4; ++m) { bf16_t* rowp = O + (size_t)(row0 + ai * HALF + m * 16) * ldc + col0;
#pragma unroll
                for (int bj = 0; bj < 2; ++bj) { const f32x4 v0 = acc[ai][bj][m][0], v1 = acc[ai][bj][m][1];
                    u32x4 w; w.x = cvt_pk_bf16(v0[0], v0[1]); w.y = cvt_pk_bf16(v0[2], v0[3]); w.z = cvt_pk_bf16(v1[0], v1[1]); w.w = cvt_pk_bf16(v1[2], v1[3]);
                    *(u32x4*)(rowp + bj * HALF) = w; } }
    }
};
struct EpiQKV {
    static constexpr bool PERM = true, AFTER_DRAIN = false;
    bf16_t* Q; bf16_t* Kb; bf16_t* Vb;
    __device__ __forceinline__ void operator()(const f32x4 (&acc)[2][2][4][2], const Unit& u, int wr, int wc, int fr, int fq) const {
        bf16_t* base; int ldc;
        if (u.pc < 4) { base = Q + (size_t)u.pr * BM * 1024 + u.pc * BM; ldc = 1024; }
        else { const int krow0 = u.pr < 128 ? (u.pr >> 6) * 16640 + (u.pr & 63) * 256 : (u.pr - 128) * 16640 + 16384; base = (u.pc == 4 ? Kb : Vb) + (size_t)krow0 * 256; ldc = 256; }
        const int row0 = wr * 64 + fr, col0 = wc * 32 + 8 * fq;
#pragma unroll
        for (int ai = 0; ai < 2; ++ai)
#pragma unroll
            for (int m = 0; m < 4; ++m) { bf16_t* rowp = base + (size_t)(row0 + ai * HALF + m * 16) * ldc + col0;
#pragma unroll
                for (int bj = 0; bj < 2; ++bj) { const f32x4 v0 = acc[ai][bj][m][0], v1 = acc[ai][bj][m][1];
                    u32x4 w; w.x = cvt_pk_bf16(v0[0], v0[1]); w.y = cvt_pk_bf16(v0[2], v0[3]); w.z = cvt_pk_bf16(v1[0], v1[1]); w.w = cvt_pk_bf16(v1[2], v1[3]);
                    *(u32x4*)(rowp + bj * HALF) = w; } }
    }
};
struct EpiSwiGLU {
    static constexpr bool PERM = true, AFTER_DRAIN = false;
    bf16_t* H; int ldh;
    __device__ __forceinline__ void operator()(const f32x4 (&acc)[2][2][4][2], const Unit& u, int wr, int wc, int fr, int fq) const {
        const int row0 = u.pr * BM + wr * 64 + fr, col0 = u.pc * HALF + wc * 32 + 8 * fq;
#pragma unroll
        for (int ai = 0; ai < 2; ++ai)
#pragma unroll
            for (int m = 0; m < 4; ++m) { bf16_t* rowp = H + (size_t)(row0 + ai * HALF + m * 16) * ldh + col0;
                const f32x4 a0 = acc[ai][0][m][0], a1 = acc[ai][0][m][1], b0 = acc[ai][1][m][0], b1 = acc[ai][1][m][1];
                u32x4 w;
                w.x = cvt_pk_bf16(silu_f(a0[0]) * b0[0], silu_f(a0[1]) * b0[1]); w.y = cvt_pk_bf16(silu_f(a0[2]) * b0[2], silu_f(a0[3]) * b0[3]);
                w.z = cvt_pk_bf16(silu_f(a1[0]) * b1[0], silu_f(a1[1]) * b1[1]); w.w = cvt_pk_bf16(silu_f(a1[2]) * b1[2], silu_f(a1[3]) * b1[3]);
                *(u32x4*)rowp = w; }
    }
};
struct EpiRes {
    static constexpr bool PERM = false, AFTER_DRAIN = false;
    const float* baseX; const float* baseC; float* outX; float* outC; const float* mods; int gidx; const float* gate2;
    __device__ __forceinline__ void operator()(const f32x4 (&acc)[2][2][4][2], const Unit& u, int wr, int wc, int fr, int fq) const {
        const int pr = u.pr; const bool isx = pr < 128; const int mi = pr < 64 ? 0 : (pr < 128 ? 1 : 2);
        const float* base = isx ? baseX + (size_t)pr * BM * 1024 : baseC + (size_t)(pr - 128) * BM * 1024;
        float* out = isx ? outX + (size_t)pr * BM * 1024 : outC + (size_t)(pr - 128) * BM * 1024;
        const float* gv = mods + (mi * 6 + gidx) * 1024;
        const int col0 = u.pc * BM + wc * 32 + 4 * fq;
        f32x4 g[2][2];
#pragma unroll
        for (int bj = 0; bj < 2; ++bj)
#pragma unroll
            for (int n = 0; n < 2; ++n) { g[bj][n] = *(const f32x4*)(gv + col0 + bj * HALF + n * 16); if (gate2) g[bj][n] = g[bj][n] * *(const f32x4*)(gate2 + col0 + bj * HALF + n * 16); }
#pragma unroll
        for (int ai = 0; ai < 2; ++ai)
#pragma unroll
            for (int m = 0; m < 4; ++m) { const size_t off = (size_t)(ai * HALF + wr * 64 + m * 16 + fr) * 1024 + col0;
#pragma unroll
                for (int bj = 0; bj < 2; ++bj)
#pragma unroll
                    for (int n = 0; n < 2; ++n) { const f32x4 bs = *(const f32x4*)(base + off + bj * HALF + n * 16); *(f32x4*)(out + off + bj * HALF + n * 16) = bs + g[bj][n] * acc[ai][bj][m][n]; }
                if (m & 1) asm volatile("" ::: "memory"); }
    }
};

template <class Epi, class Sched, bool ALIGN_EPI = false, bool SP2 = false>
__device__ __forceinline__ void gemm_phase(PG8_LAS unsigned char* lds, const Gemm g, const Sched& S, const Epi& E) {
    const int tid = threadIdx.x, wid = __builtin_amdgcn_readfirstlane(tid >> 6), lane = tid & 63, wr = wid >> 2, wc = wid & 3, fr = lane & 15, fq = lane >> 4;
    const int K = g.K, nt = K / BK;
    unsigned voffA[2], voffB[2];
#pragma unroll
    for (int i = 0; i < 2; ++i) { int R, C; stage_rc(tid * 16 + i * 8192, R, C); const int Rb = Epi::PERM ? ((R & ~31) + perm32(R & 31)) : R;
        voffA[i] = (unsigned)(R * g.lda + C) * 2u; voffB[i] = (unsigned)(Rb * g.ldb + C) * 2u; }
    const size_t kstep = (size_t)(BK * 2);
    const size_t hstepA = (size_t)HALF * g.lda * 2, hstepB = (size_t)HALF * g.ldb * 2;
    const size_t tstepA = 2 * hstepA, tstepB = 2 * hstepB;
    const unsigned ldsw = (unsigned)wid * 1024u;
    const int aoff = lds_byte(wr * 64 + fr, fq * 8), boff = lds_byte(wc * 32 + fr, fq * 8);
#define PG8_SA(b, h) (((b) * 2 + (h)) * HTB)
#define PG8_SB(b, h) ((4 + (b) * 2 + (h)) * HTB)
#define PG8_STAGE(bufoff, gbase, voff) do { _Pragma("unroll") for (int _i = 0; _i < 2; ++_i) \
        __builtin_amdgcn_global_load_lds((const unsigned*)((const char*)(gbase) + (voff)[_i]), (PG8_LAS unsigned*)(lds + (bufoff) + ldsw + _i * 8192), 16, 0, 0); } while (0)
#define PG8_LDA(dst, b, h) do { _Pragma("unroll") for (int m = 0; m < 4; ++m) _Pragma("unroll") for (int k = 0; k < 2; ++k) dst[m][k] = *(const PG8_LAS bf16x8*)(lds + PG8_SA(b, h) + aoff + m * 2048 + k * 1024); } while (0)
#define PG8_LDB(dst, b, h) do { _Pragma("unroll") for (int n = 0; n < 2; ++n) _Pragma("unroll") for (int k = 0; k < 2; ++k) dst[n][k] = *(const PG8_LAS bf16x8*)(lds + PG8_SB(b, h) + boff + n * 2048 + k * 1024); } while (0)
#define PG8_MMA(ai, bj, At, Bt) do { __builtin_amdgcn_s_setprio(1); _Pragma("unroll") for (int m = 0; m < 4; ++m) _Pragma("unroll") for (int n = 0; n < 2; ++n) _Pragma("unroll") for (int k = 0; k < 2; ++k) \
        acc[ai][bj][m][n] = __builtin_amdgcn_mfma_f32_16x16x32_bf16(Bt[n][k], At[m][k], acc[ai][bj][m][n], 0, 0, 0); __builtin_amdgcn_s_setprio(0); } while (0)
#define PG8_WAIT_V(n) asm volatile("s_waitcnt vmcnt(" #n ")" ::: "memory")
#define PG8_WAIT_L(n) asm volatile("s_waitcnt lgkmcnt(" #n ")" ::: "memory")
#define PG8_BAR __builtin_amdgcn_s_barrier()
#define PG8_SCHED __builtin_amdgcn_sched_barrier(0)
    Unit cur, nxt; int ui = 0;
    if (!S.next(0, cur)) return;
    f32x4 acc[2][2][4][2];
#pragma unroll
    for (int a = 0; a < 2; ++a)
#pragma unroll
        for (int b = 0; b < 2; ++b)
#pragma unroll
            for (int m = 0; m < 4; ++m)
#pragma unroll
                for (int n = 0; n < 2; ++n) acc[a][b][m][n] = (f32x4){0.f, 0.f, 0.f, 0.f};
    bf16x8 At[4][2], B0[2][2], B1[2][2];
    const char* cA = (const char*)g.A + (size_t)cur.pa * tstepA + (size_t)cur.ak * 2; const char* cB = (const char*)g.Bt + (size_t)cur.pb * tstepB;
    S.a_ready(cur);
    if constexpr (SP2) {
        PG8_STAGE(PG8_SB(0, 0), cB, voffB); PG8_STAGE(PG8_SB(0, 1), cB + hstepB, voffB); PG8_STAGE(PG8_SA(0, 0), cA, voffA); PG8_STAGE(PG8_SA(0, 1), cA + hstepA, voffA);
        if (wr == 1) PG8_BAR;
        PG8_WAIT_V(2); PG8_BAR;
        PG8_STAGE(PG8_SB(1, 0), cB + kstep, voffB); PG8_STAGE(PG8_SA(1, 0), cA + kstep, voffA); PG8_STAGE(PG8_SB(1, 1), cB + hstepB + kstep, voffB);
        PG8_WAIT_V(6); PG8_BAR;
    } else {
        PG8_STAGE(PG8_SB(0, 0), cB, voffB); PG8_STAGE(PG8_SA(0, 0), cA, voffA); PG8_STAGE(PG8_SB(0, 1), cB + hstepB, voffB); PG8_STAGE(PG8_SA(0, 1), cA + hstepA, voffA);
        if (wr == 1) PG8_BAR;
        PG8_WAIT_V(4); PG8_BAR;
        PG8_STAGE(PG8_SB(1, 0), cB + kstep, voffB); PG8_STAGE(PG8_SA(1, 0), cA + kstep, voffA); PG8_STAGE(PG8_SB(1, 1), cB + hstepB + kstep, voffB);
        PG8_WAIT_V(6); PG8_BAR;
    }
    for (;;) {
        const bool has_next = S.next(ui + 1, nxt);
        const char* nA = has_next ? (const char*)g.A + (size_t)nxt.pa * tstepA + (size_t)nxt.ak * 2 : cA; const char* nB = has_next ? (const char*)g.Bt + (size_t)nxt.pb * tstepB : cB;
        for (int t = 0; t < nt; t += 2) {
            const bool last = (t == nt - 2);
            const char* a1 = cA + (size_t)(t + 1) * kstep;
            const char* a2 = last ? nA : cA + (size_t)(t + 2) * kstep; const char* b2 = last ? nB : cB + (size_t)(t + 2) * kstep;
            const char* a3 = a2 + kstep; const char* b3 = b2 + kstep;
            if (last && has_next) S.a_ready(nxt);
            if constexpr (SP2) {
            PG8_LDB(B0, 0, 0); PG8_LDB(B1, 0, 1); PG8_SCHED; PG8_LDA(At, 0, 0); PG8_STAGE(PG8_SA(1, 1), a1 + hstepA, voffA);
            PG8_WAIT_V(8); PG8_WAIT_L(0); PG8_BAR; PG8_MMA(0, 0, At, B0); PG8_MMA(0, 1, At, B1); PG8_BAR; PG8_SCHED;
            PG8_LDA(At, 0, 1); PG8_STAGE(PG8_SB(0, 0), b2, voffB); PG8_STAGE(PG8_SB(0, 1), b2 + hstepB, voffB); PG8_STAGE(PG8_SA(0, 0), a2, voffA);
            PG8_WAIT_V(8); PG8_WAIT_L(0); PG8_BAR; PG8_MMA(1, 0, At, B0); PG8_MMA(1, 1, At, B1); PG8_BAR; PG8_SCHED;
            PG8_LDB(B0, 1, 0); PG8_LDB(B1, 1, 1); PG8_SCHED; PG8_LDA(At, 1, 0); PG8_STAGE(PG8_SA(0, 1), a2 + hstepA, voffA);
            PG8_WAIT_V(8); PG8_WAIT_L(0); PG8_BAR; PG8_MMA(0, 0, At, B0); PG8_MMA(0, 1, At, B1); PG8_BAR; PG8_SCHED;
            PG8_LDA(At, 1, 1); PG8_STAGE(PG8_SB(1, 0), b3, voffB); PG8_STAGE(PG8_SB(1, 1), b3 + hstepB, voffB); PG8_STAGE(PG8_SA(1, 0), a3, voffA);
            PG8_WAIT_V(8); PG8_WAIT_L(0); PG8_BAR; PG8_MMA(1, 0, At, B0); PG8_MMA(1, 1, At, B1); PG8_BAR; PG8_SCHED;
            } else {
            PG8_LDB(B0, 0, 0); PG8_SCHED; PG8_LDA(At, 0, 0); PG8_STAGE(PG8_SA(1, 1), a1 + hstepA, voffA);
            PG8_WAIT_L(8); PG8_BAR; PG8_WAIT_L(0); PG8_MMA(0, 0, At, B0); PG8_BAR; PG8_SCHED;
            PG8_LDB(B1, 0, 1); PG8_STAGE(PG8_SB(0, 0), b2, voffB);
            PG8_BAR; PG8_WAIT_L(0); PG8_MMA(0, 1, At, B1); PG8_BAR;
            PG8_LDA(At, 0, 1); PG8_STAGE(PG8_SA(0, 0), a2, voffA);
            PG8_BAR; PG8_WAIT_L(0); PG8_MMA(1, 0, At, B0); PG8_BAR; PG8_SCHED;
            PG8_STAGE(PG8_SB(0, 1), b2 + hstepB, voffB);
            PG8_WAIT_V(6); PG8_BAR; PG8_MMA(1, 1, At, B1); PG8_BAR;
            PG8_LDB(B0, 1, 0); PG8_SCHED; PG8_LDA(At, 1, 0); PG8_STAGE(PG8_SA(0, 1), a2 + hstepA, voffA);
            PG8_WAIT_L(8); PG8_BAR; PG8_WAIT_L(0); PG8_MMA(0, 0, At, B0); PG8_BAR; PG8_SCHED;
            PG8_LDB(B1, 1, 1); PG8_STAGE(PG8_SB(1, 0), b3, voffB);
            PG8_BAR; PG8_WAIT_L(0); PG8_MMA(0, 1, At, B1); PG8_BAR;
            PG8_LDA(At, 1, 1); PG8_STAGE(PG8_SA(1, 0), a3, voffA);
            PG8_BAR; PG8_WAIT_L(0); PG8_MMA(1, 0, At, B0); PG8_BAR; PG8_SCHED;
            PG8_STAGE(PG8_SB(1, 1), b3 + hstepB, voffB);
            PG8_WAIT_V(6); PG8_BAR; PG8_MMA(1, 1, At, B1); PG8_BAR;
            }
        }
        if constexpr (ALIGN_EPI) { if (wr == 0) PG8_BAR; }
        if constexpr (!Epi::AFTER_DRAIN) { E(acc, cur, wr, wc, fr, fq); S.done(cur); }
        if (!has_next) break;
#pragma unroll
        for (int a = 0; a < 2; ++a)
#pragma unroll
            for (int b = 0; b < 2; ++b)
#pragma unroll
                for (int m = 0; m < 4; ++m)
#pragma unroll
                    for (int n = 0; n < 2; ++n) acc[a][b][m][n] = (f32x4){0.f, 0.f, 0.f, 0.f};
        cur = nxt; cA = nA; cB = nB; ++ui;
        if constexpr (ALIGN_EPI) { if (wr == 1) PG8_BAR; }
    }
    PG8_WAIT_V(0);
    if constexpr (!ALIGN_EPI) { if (wr == 0) PG8_BAR; }
    PG8_BAR;
    if constexpr (Epi::AFTER_DRAIN) { E.fused(acc, cur, wr, wc, fr, fq, lds, wid, lane); S.done(cur); }
#undef PG8_SA
#undef PG8_SB
#undef PG8_STAGE
#undef PG8_LDA
#undef PG8_LDB
#undef PG8_MMA
#undef PG8_WAIT_V
#undef PG8_WAIT_L
#undef PG8_BAR
#undef PG8_SCHED
}
}

#include <hip/hip_bf16.h>
#include <cmath>
namespace attn_body {
using bf16=__hip_bfloat16;
using bf16x8=__attribute__((ext_vector_type(8)))short;
using s16x4=__attribute__((ext_vector_type(4)))short;
using f32x16=__attribute__((ext_vector_type(16)))float;
using u32x4=__attribute__((ext_vector_type(4)))unsigned;
constexpr int BATCH=2,NHEAD=16,SEQ=16384,D=64,DM=NHEAD*D,KVP=256,LKV=16640;
constexpr int NW=8,QBLK=32,QB=QBLK*NW,KVBLK=64,NQB=SEQ/QB;
constexpr int ATTN_PITCH=DM, ATTN_UNIT_ROWS=QB;
__device__ __forceinline__ int crow(int r,int hi){return (r&3)+8*(r>>2)+4*hi;}
#define SBAR() __builtin_amdgcn_sched_barrier(0)
__device__ __forceinline__ void cmask(f32x16&p0,f32x16&p1,int jb,int qrel,int hi){
  const float NEG=-INFINITY; int kb=64*jb+4*hi;
  #pragma unroll
  for(int r=0;r<16;++r){int kv=kb+(r&3)+8*(r>>2); if(kv>qrel)p0[r]=NEG; if(kv+32>qrel)p1[r]=NEG;}
}

constexpr int NSLOT=3, SLOTB=8192;
constexpr int LDS_K=0, LDS_V=NSLOT*SLOTB, LDS_WS=2*NSLOT*SLOTB, LDS_OST=LDS_WS+NW*64*4, LDS_BYTES=LDS_OST+NW*4096;
constexpr float C2=0.125f*1.4426950408889634f;
__device__ __forceinline__ void glds16(const void*gsrc,unsigned lds_dst){unsigned keep;
  asm volatile("s_mov_b32 %0, m0\n\ts_mov_b32 m0, %2\n\ts_nop 0\n\tglobal_load_lds_dwordx4 %1, off\n\ts_mov_b32 m0, %0":"=&s"(keep):"v"(gsrc),"s"(lds_dst):"memory");}
__device__ __forceinline__ float max3f(float a,float b,float c){float r;asm("v_max3_f32 %0, %1, %2, %3":"=v"(r):"v"(a),"v"(b),"v"(c));return r;}
__device__ __forceinline__ float max2f(float a,float b){float r;asm("v_max_f32_e32 %0, %1, %2":"=v"(r):"v"(a),"v"(b));return r;}
__device__ __forceinline__ float fadd_s(float a,float b){float r;asm("v_add_f32_e32 %0, %1, %2":"=v"(r):"v"(a),"v"(b));return r;}
__device__ __forceinline__ float fsub_s(float a,float b){float r;asm("v_sub_f32_e32 %0, %1, %2":"=v"(r):"v"(a),"v"(b));return r;}
typedef float f32x2_t __attribute__((ext_vector_type(2))); typedef __bf16 bf16x2_t __attribute__((ext_vector_type(2)));
__device__ __forceinline__ unsigned cvtpk_s(float lo,float hi){f32x2_t v={lo,hi};bf16x2_t b=__builtin_convertvector(v,bf16x2_t);return __builtin_bit_cast(unsigned,b);}
#define WAIT_BAR(N) asm volatile("s_waitcnt vmcnt(" #N ") lgkmcnt(0)\n\ts_barrier":::"memory")

__device__ __forceinline__ void qkt(f32x16&p0,f32x16&p1,const char*Kslot,const bf16x8*qr,const f32x16&negm,int r32,int hi){
  const char*kb=Kslot+hi*1024+r32*16;
  #pragma unroll
  for(int d0=0;d0<4;++d0){
    const bf16x8 b0=*reinterpret_cast<const bf16x8*>(kb+d0*2048);
    const bf16x8 b1=*reinterpret_cast<const bf16x8*>(kb+d0*2048+512);
    if(d0==0){p0=__builtin_amdgcn_mfma_f32_32x32x16_bf16(b0,qr[0],negm,0,0,0);p1=__builtin_amdgcn_mfma_f32_32x32x16_bf16(b1,qr[0],negm,0,0,0);}
    else{p0=__builtin_amdgcn_mfma_f32_32x32x16_bf16(b0,qr[d0],p0,0,0,0);p1=__builtin_amdgcn_mfma_f32_32x32x16_bf16(b1,qr[d0],p1,0,0,0);}}
}
typedef __attribute__((address_space(3))) const char* lds_cptr;
typedef short v4i16_t __attribute__((ext_vector_type(4)));
__device__ __forceinline__ void kload8(bf16x8*kf,lds_cptr kp){
  kf[0]=*(const __attribute__((address_space(3))) bf16x8*)(kp);      kf[1]=*(const __attribute__((address_space(3))) bf16x8*)(kp+512);
  kf[2]=*(const __attribute__((address_space(3))) bf16x8*)(kp+2048); kf[3]=*(const __attribute__((address_space(3))) bf16x8*)(kp+2560);
  kf[4]=*(const __attribute__((address_space(3))) bf16x8*)(kp+4096); kf[5]=*(const __attribute__((address_space(3))) bf16x8*)(kp+4608);
  kf[6]=*(const __attribute__((address_space(3))) bf16x8*)(kp+6144); kf[7]=*(const __attribute__((address_space(3))) bf16x8*)(kp+6656);
}
__device__ __forceinline__ void kload2(bf16x8*kf,lds_cptr kp,int j){ kf[2*j]=*(const __attribute__((address_space(3))) bf16x8*)(kp+j*2048); kf[2*j+1]=*(const __attribute__((address_space(3))) bf16x8*)(kp+j*2048+512); }
__device__ __forceinline__ s16x4 vtr(lds_cptr p){ return __builtin_bit_cast(s16x4,__builtin_amdgcn_ds_read_tr16_b64_v4i16((__attribute__((address_space(3))) v4i16_t*)p)); }
__device__ __forceinline__ float rowmax(const f32x16&p0,const f32x16&p1){
  float a=max3f(p0[0],p0[1],p1[0]),b=max3f(p0[2],p0[3],p1[1]);a=max3f(a,p1[2],p1[3]);
  #pragma unroll
  for(int r=4;r<16;r+=4){a=max3f(a,p0[r],p0[r+1]);b=max3f(b,p0[r+2],p0[r+3]);a=max3f(a,p1[r],p1[r+1]);b=max3f(b,p1[r+2],p1[r+3]);}
  const float m=max2f(a,b);
  auto rr=__builtin_amdgcn_permlane32_swap(__float_as_uint(m),__float_as_uint(m),false,false);
  return max2f(__uint_as_float(rr[0]),__uint_as_float(rr[1]));
}
__device__ __forceinline__ void pv(f32x16*o,int vb,bf16x8 pa0,bf16x8 pa1,bf16x8 pa2,bf16x8 pa3){
  #pragma unroll
  for(int d0=0;d0<2;++d0){s16x4 lo[4],hi[4];
    #pragma unroll
    for(int ks=0;ks<4;++ks){
      asm volatile("ds_read_b64_tr_b16 %0,%1 offset:%c2":"=&v"(lo[ks]):"v"(vb),"i"(d0*4096+ks*1024):"memory");
      asm volatile("ds_read_b64_tr_b16 %0,%1 offset:%c2":"=&v"(hi[ks]):"v"(vb),"i"(d0*4096+ks*1024+512):"memory");}
    asm volatile("s_waitcnt lgkmcnt(0)":::"memory");SBAR();
    #define PK(k) (bf16x8){lo[k][0],lo[k][1],lo[k][2],lo[k][3],hi[k][0],hi[k][1],hi[k][2],hi[k][3]}
    o[d0]=__builtin_amdgcn_mfma_f32_32x32x16_bf16(pa0,PK(0),o[d0],0,0,0);
    o[d0]=__builtin_amdgcn_mfma_f32_32x32x16_bf16(pa1,PK(1),o[d0],0,0,0);
    o[d0]=__builtin_amdgcn_mfma_f32_32x32x16_bf16(pa2,PK(2),o[d0],0,0,0);
    o[d0]=__builtin_amdgcn_mfma_f32_32x32x16_bf16(pa3,PK(3),o[d0],0,0,0);
    #undef PK
  }
}

#ifndef ATTN_STORE16
#define ATTN_STORE16(p,v) (*(u32x4*)(p)=(v))
#endif
template<int THRL> __device__ __forceinline__ void attn_unit(int b,int h,int qb,const bf16*Q,const bf16*__restrict__ K,const bf16*__restrict__ V,bf16*O,char*shm){
  const int tid=threadIdx.x,lane=tid&63,r32=lane&31,hi=lane>>5; const int wid=__builtin_amdgcn_readfirstlane(tid>>6);
  const long rowbase=(long)b*SEQ; const long rowk=(long)b*LKV; const int q0=qb*QB;
  const bf16*Qw=Q+(rowbase+q0+wid*QBLK)*DM+h*D;
  const bf16*Kh=K+rowk*KVP+(h>>2)*D,*Vh=V+rowk*KVP+(h>>2)*D;
  const unsigned lds0=(unsigned)(uintptr_t)shm;
  float*wsf=(float*)(shm+LDS_WS)+wid*64;
  const bf16*ksrc=Kh+(long)lane*KVP+wid*8;
  const bf16*vsrc=Vh+(long)(16*(wid&3)+(lane>>2))*KVP+(wid>>2)*32+(lane&3)*8;
  const unsigned kdst=lds0+LDS_K+wid*1024, vdst=lds0+LDS_V+wid*1024;
  #define DMA_K(t,slot) glds16(ksrc+(long)(t)*KVBLK*KVP,(unsigned)__builtin_amdgcn_readfirstlane(kdst+(slot)))
  #define DMA_V(t,slot) glds16(vsrc+(long)(t)*KVBLK*KVP,(unsigned)__builtin_amdgcn_readfirstlane(vdst+(slot)))
  const int vb0=(int)(lds0+LDS_V)+((lane>>4)&1)*32+(lane&3)*8+(4*hi+((lane&15)>>2))*64;
  const char*Kbase=shm+LDS_K; bf16x8 kf[8];
  const lds_cptr shm3=(lds_cptr)shm; const lds_cptr kp0=shm3+LDS_K+hi*1024+r32*16; const lds_cptr vp0=shm3+LDS_V+((lane>>4)&1)*32+(lane&3)*8+(4*hi+((lane&15)>>2))*64;
  constexpr int NT=LKV/KVBLK;
  DMA_K(0,0);DMA_V(0,0);DMA_K(1,SLOTB);
  bf16x8 qr[4];
  #pragma unroll
  for(int d0=0;d0<4;++d0)qr[d0]=*reinterpret_cast<const bf16x8*>(&Qw[(long)r32*DM+d0*16+hi*8]);
  float mhat=0.f,l_reg=0.f;f32x16 o[2];o[0]=f32x16{};o[1]=f32x16{};f32x16 negm=f32x16{};asm volatile("":"+v"(negm));

  #define CMASK(P0,P1,t) do{}while(0)
  bool resc=false;
  #define START(P0,P1) do{ const float rm=rowmax(P0,P1); resc=false; \
    { const float dl=rm; mhat=fadd_s(mhat,dl); \
      _Pragma("unroll") for(int r=0;r<16;++r){P0[r]=fsub_s(P0[r],dl);P1[r]=fsub_s(P1[r],dl);} \
      _Pragma("unroll") for(int r=0;r<16;++r)negm[r]=-mhat; asm volatile("":"+v"(negm)); } \
    _Pragma("unroll") for(int r=0;r<16;++r)P0[r]=__builtin_amdgcn_exp2f(P0[r]); }while(0)
  #define RESC() do{ if(resc){ asm volatile("s_waitcnt lgkmcnt(0)":::"memory"); \
      _Pragma("unroll") for(int d_=0;d_<2;++d_) _Pragma("unroll") for(int r=0;r<16;++r)o[d_][r]*=wsf[crow(r,hi)]; } }while(0)
  f32x16 pA0,pA1,pB0,pB1;
  int sl_prev=0,sl_cur=0,sl_next=SLOTB;
  #define ROT() do{sl_prev=sl_cur;sl_cur=sl_next;sl_next=(sl_next==(NSLOT-1)*SLOTB)?0:sl_next+SLOTB;}while(0)
  DMA_K(2,2*SLOTB);
  WAIT_BAR(3);
  qkt(pA0,pA1,Kbase,qr,negm,r32,hi);asm volatile("s_nop 15\n\ts_nop 7":"+v"(pA0),"+v"(pA1));CMASK(pA0,pA1,0);
  START(pA0,pA1);
  _Pragma("unroll") for(int r=0;r<16;++r)pA1[r]=__builtin_amdgcn_exp2f(pA1[r]);
  WAIT_BAR(0);
  DMA_K(3,0);DMA_V(1,SLOTB);
  ROT();
  kload8(kf,kp0+sl_cur);
  WAIT_BAR(2);
  s16x4 vlo[8],vhi[8]; u32x4 pw0,pw1,pw2,pw3;
  #define PKW(P,B) cvtpk_s(P[B],P[B+1])
  #define PAF(k) __builtin_bit_cast(bf16x8,pw##k)
  #define VFR(i) (bf16x8){vlo[i][0],vlo[i][1],vlo[i][2],vlo[i][3],vhi[i][0],vhi[i][1],vhi[i][2],vhi[i][3]}
  #define PIN(x) asm volatile("":"+v"(x))
  #define MX3(a,b,c) __builtin_fmaxf(__builtin_fmaxf((a),(b)),(c))
  #define GAPA(MF,A0,A1,A2,A3,W0,W1,PW) do{ MF; sacc+=A0; sacc+=A1; sacc+=A2; sacc+=A3; PIN(sacc); W0; W1; PIN(PW); SBAR(); }while(0)
  #define EX(v) __builtin_amdgcn_exp2f(v)
  #define GAPB(MF,X,B) do{ MF; X[B]=EX(X[B]); X[B+1]=EX(X[B+1]); X[B+2]=EX(X[B+2]); X[B+3]=EX(X[B+3]); PIN(X); SBAR(); }while(0)
  #define VRD(i) do{ vlo[i]=vtr(vp_+(((i)>>2)*4096+((i)&3)*1024)); vhi[i]=vtr(vp_+(((i)>>2)*4096+((i)&3)*1024+512)); }while(0)
  #define KRD(G,j) do{ if(G){ kload2(kf,kp0+sl_next,j); SBAR(); } }while(0)
  #define STEP(C0,C1,P0,P1,t,GK,GV,GL) do{ SBAR(); \
    const lds_cptr vp_=vp0+sl_prev; \
    VRD(0); SBAR(); float sacc=(P0[0]+P0[1]); \
    GAPA(C0=__builtin_amdgcn_mfma_f32_32x32x16_bf16(kf[0],qr[0],negm,0,0,0), P0[2],P0[3],P0[4],P0[5],     pw0[0]=PKW(P0,0), pw0[1]=PKW(P0,2), pw0); \
    VRD(4); SBAR(); GAPA(C1=__builtin_amdgcn_mfma_f32_32x32x16_bf16(kf[1],qr[0],negm,0,0,0), P0[6],P0[7],P0[8],P0[9],     pw0[2]=PKW(P0,4), pw0[3]=PKW(P0,6), pw0); \
    VRD(1); SBAR(); GAPA(C0=__builtin_amdgcn_mfma_f32_32x32x16_bf16(kf[2],qr[1],C0,0,0,0),   P0[10],P0[11],P0[12],P0[13], pw1[0]=PKW(P0,8), pw1[1]=PKW(P0,10), pw1); \
    VRD(5); SBAR(); GAPA(C1=__builtin_amdgcn_mfma_f32_32x32x16_bf16(kf[3],qr[1],C1,0,0,0),   P0[14],P0[15],P1[0],P1[1],   pw1[2]=PKW(P0,12),pw1[3]=PKW(P0,14), pw1); \
    VRD(2); SBAR(); GAPA(C0=__builtin_amdgcn_mfma_f32_32x32x16_bf16(kf[4],qr[2],C0,0,0,0),   P1[2],P1[3],P1[4],P1[5],     pw2[0]=PKW(P1,0), pw2[1]=PKW(P1,2), pw2); \
    VRD(6); SBAR(); GAPA(C1=__builtin_amdgcn_mfma_f32_32x32x16_bf16(kf[5],qr[2],C1,0,0,0),   P1[6],P1[7],P1[8],P1[9],     pw2[2]=PKW(P1,4), pw2[3]=PKW(P1,6), pw2); \
    VRD(3); SBAR(); GAPA(C0=__builtin_amdgcn_mfma_f32_32x32x16_bf16(kf[6],qr[3],C0,0,0,0),   P1[10],P1[11],P1[12],P1[13], pw3[0]=PKW(P1,8), pw3[1]=PKW(P1,10), pw3); \
    VRD(7); SBAR(); GAPA(C1=__builtin_amdgcn_mfma_f32_32x32x16_bf16(kf[7],qr[3],C1,0,0,0),   P1[14],P1[15],0.f,0.f,       pw3[2]=PKW(P1,12),pw3[3]=PKW(P1,14), pw3); \
    l_reg+=sacc; \
    if(GK){DMA_K((t)+3,sl_cur);} if(GV){DMA_V((t)+1,sl_next);} \
    CMASK(C0,C1,t); \
    { float a=MX3(C0[0],C0[1],C1[0]),b=MX3(C0[2],C0[3],C1[1]); a=MX3(a,C1[2],C1[3]); \
      _Pragma("unroll") for(int r=4;r<16;r+=4){a=MX3(a,C0[r],C0[r+1]);b=MX3(b,C0[r+2],C0[r+3]);a=MX3(a,C1[r],C1[r+1]);b=MX3(b,C1[r+2],C1[r+3]);} \
      float rm=__builtin_fmaxf(a,b); { auto rr=__builtin_amdgcn_permlane32_swap(__float_as_uint(rm),__float_as_uint(rm),false,false); rm=__builtin_fmaxf(__uint_as_float(rr[0]),__uint_as_float(rr[1])); } \
      resc=false; \
      if(__builtin_expect(__any(rm>(float)THRL),0)){ const float dl=__builtin_fmaxf(rm,0.f); mhat+=dl; \
        _Pragma("unroll") for(int r=0;r<16;++r){C0[r]-=dl;C1[r]-=dl;} \
        _Pragma("unroll") for(int r=0;r<16;++r)negm[r]=-mhat; asm volatile("":"+v"(negm)); \
        const float f=__builtin_amdgcn_exp2f(-dl); l_reg*=f; if(hi==0)wsf[r32]=f; resc=true; } } \
    SBAR(); \
    GAPB(o[0]=__builtin_amdgcn_mfma_f32_32x32x16_bf16(PAF(0),VFR(0),o[0],0,0,0), C0,0); \
    GAPB(o[1]=__builtin_amdgcn_mfma_f32_32x32x16_bf16(PAF(0),VFR(4),o[1],0,0,0), C0,4); \
    KRD(GL,0); GAPB(o[0]=__builtin_amdgcn_mfma_f32_32x32x16_bf16(PAF(1),VFR(1),o[0],0,0,0), C0,8); \
    KRD(GL,1); GAPB(o[1]=__builtin_amdgcn_mfma_f32_32x32x16_bf16(PAF(1),VFR(5),o[1],0,0,0), C0,12); \
    KRD(GL,2); GAPB(o[0]=__builtin_amdgcn_mfma_f32_32x32x16_bf16(PAF(2),VFR(2),o[0],0,0,0), C1,0); \
    KRD(GL,3); GAPB(o[1]=__builtin_amdgcn_mfma_f32_32x32x16_bf16(PAF(2),VFR(6),o[1],0,0,0), C1,4); \
    GAPB(o[0]=__builtin_amdgcn_mfma_f32_32x32x16_bf16(PAF(3),VFR(3),o[0],0,0,0), C1,8); \
    GAPB(o[1]=__builtin_amdgcn_mfma_f32_32x32x16_bf16(PAF(3),VFR(7),o[1],0,0,0), C1,12); \
    }while(0)
  int t=1;
  #undef CMASK
  #define CMASK(P0,P1,t) do{}while(0)
  for(;t+5<NT;t+=2){
    STEP(pB0,pB1,pA0,pA1,t,true,true,true);     WAIT_BAR(2); RESC(); ROT();
    STEP(pA0,pA1,pB0,pB1,t+1,true,true,true);   WAIT_BAR(2); RESC(); ROT();
  }
  #undef CMASK
  #define CMASK(P0,P1,t) do{}while(0)
  #define ENDW(tt) do{ if((tt)+3<NT){WAIT_BAR(2);} else if((tt)+2<NT){WAIT_BAR(1);} else {WAIT_BAR(0);} }while(0)
  for(;t+1<NT;t+=2){
    STEP(pB0,pB1,pA0,pA1,t,(t+3<NT),(t+1<NT),(t+1<NT));       ENDW(t);   RESC(); ROT();
    STEP(pA0,pA1,pB0,pB1,t+1,(t+4<NT),(t+2<NT),(t+2<NT));     ENDW(t+1); RESC(); ROT();
  }
  STEP(pB0,pB1,pA0,pA1,NT-1,false,false,false); RESC();
  { float sacc=pB0[0]+pB0[1]; _Pragma("unroll") for(int r=2;r<16;++r)sacc+=pB0[r]; _Pragma("unroll") for(int r=0;r<16;++r)sacc+=pB1[r]; l_reg+=sacc;
    pw0=(u32x4){PKW(pB0,0),PKW(pB0,2),PKW(pB0,4),PKW(pB0,6)};pw1=(u32x4){PKW(pB0,8),PKW(pB0,10),PKW(pB0,12),PKW(pB0,14)};pw2=(u32x4){PKW(pB1,0),PKW(pB1,2),PKW(pB1,4),PKW(pB1,6)};pw3=(u32x4){PKW(pB1,8),PKW(pB1,10),PKW(pB1,12),PKW(pB1,14)};
    SBAR(); pv(o,vb0+sl_cur,PAF(0),PAF(1),PAF(2),PAF(3)); }
  #undef PKW
  #undef PAF
  #undef VFR
  #undef PIN
  #undef MX3
  #undef GAPA
  #undef GAPB
  #undef EX
  #undef VRD
  #undef KRD
  #undef STEP
  #undef ENDW
  {auto rr=__builtin_amdgcn_permlane32_swap(__float_as_uint(l_reg),__float_as_uint(l_reg),false,false);l_reg=__uint_as_float(rr[0])+__uint_as_float(rr[1]);}
  if(hi==0)wsf[32+r32]=l_reg;asm volatile("s_waitcnt lgkmcnt(0)":::"memory");
  float rli[16];
  #pragma unroll
  for(int r=0;r<16;++r)rli[r]=__builtin_amdgcn_rcpf(wsf[32+crow(r,hi)]);
  bf16*Ow=O+(rowbase+q0+wid*QBLK)*DM+h*D;
  { bf16*stg=(bf16*)(shm+LDS_OST)+wid*2048;
    #pragma unroll
    for(int r=0;r<16;++r){const int orow=crow(r,hi);
      #pragma unroll
      for(int d0=0;d0<2;++d0)stg[orow*64+d0*32+r32]=__float2bfloat16(o[d0][r]*rli[r]);}
    asm volatile("s_waitcnt lgkmcnt(0)":::"memory");
    #pragma unroll
    for(int i=0;i<4;++i){const int row=i*8+(lane>>3),ch=lane&7; const u32x4 v=*(const u32x4*)(stg+row*64+ch*8); ATTN_STORE16(Ow+(long)row*DM+ch*8,v);} }
  asm volatile("s_waitcnt lgkmcnt(0)\n\ts_barrier":::"memory");
  #undef DMA_K
  #undef DMA_V
  #undef CMASK
  #undef START
  #undef RESC
  #undef ROT
}
constexpr int ATTN_LDS_BYTES=LDS_BYTES;
struct AttnTensors { const bf16* Q; const bf16* K; const bf16* V; bf16* O; };
struct AttnUnit { int bh; int qb; };
struct StaticOrder {
  int vcu, G;
  __device__ __forceinline__ explicit StaticOrder(int grid,int block):vcu((grid%8==0)?(block%8)*(grid/8)+block/8:block),G(grid){}
  __device__ __forceinline__ bool next(int i,AttnUnit&u)const{
    if(G==256){ if(i>=8)return false; const int bkv=vcu>>5,j=vcu&31,un=i*32+j; u.bh=(bkv>>2)*16+(bkv&3)*4+(un>>6); u.qb=un&63; return true; }
    const int un=i*G+vcu; if(un>=BATCH*NHEAD*NQB)return false; u.bh=un/NQB; u.qb=un%NQB; return true; }
  __device__ __forceinline__ void a_ready(const AttnUnit&)const{}
  __device__ __forceinline__ void done(const AttnUnit&)const{}
};
template<class Sched,int THRL=8> __device__ __forceinline__ void attn_phase(char*lds,const AttnTensors&T,const Sched&S){
  AttnUnit u;
  for(int i=0;S.next(i,u);++i){ S.a_ready(u); attn_unit<THRL>(u.bh/NHEAD,u.bh%NHEAD,u.qb,T.Q,T.K,T.V,T.O,lds); S.done(u); }
}
#undef SBAR
#undef WAIT_BAR
}
constexpr int NWAVES = 8;
#ifndef MK_N_LAUNCHES
#define MK_N_LAUNCHES 19
#endif
constexpr int PER_PHASE = 19;
constexpr int N_LAUNCHES = MK_N_LAUNCHES;

constexpr int D = 1024, LSEQ = 16384, NBATCH = 2, TT = NBATCH * LSEQ, CTXL = 256, NCTX = NBATCH * CTXL, MT = TT + NCTX;
constexpr int FF = 2816, NE = 8, NQKV = 1536, LKV = LSEQ + CTXL;
constexpr int NPX = TT / 256, NPT = MT / 256;
constexpr int CAPP = (2 * TT) / 256 + NE, CHP = CAPP / 2;
constexpr float NORM_EPS = 1e-6f;
constexpr float QSCALE = 0.125f * 1.4426950408889634f;

constexpr size_t MiB = 1u << 20, KiB = 1u << 10;
constexpr size_t WS_CTL = 0, CTL_ZERO_BYTES = 1 * MiB;
constexpr size_t WS_PART = 1 * MiB;
constexpr size_t WS_MODS = 3 * MiB;
constexpr size_t WS_RSTD = 3 * MiB + 256 * KiB;
constexpr size_t WS_ROPE = 3 * MiB + 512 * KiB;
constexpr size_t WS_EID = 4 * MiB, WS_GATE = 4 * MiB + 256 * KiB, WS_SLOT = 4 * MiB + 512 * KiB, WS_PEXP = 4 * MiB + 768 * KiB;
constexpr size_t WS_CTXB = 6 * MiB;
constexpr size_t WS_W13M = 8 * MiB, WS_W2M = 96 * MiB;
constexpr size_t WS_W13F = 140 * MiB, WS_W2F = 151 * MiB;
constexpr size_t WS_WQKV = 157 * MiB, WS_WO = 160 * MiB, WS_POOL = 162 * MiB;
constexpr size_t WS_XS = 164 * MiB;
constexpr size_t WS_BIG = 296 * MiB;
constexpr size_t WS_Q = WS_BIG, WS_K = WS_BIG + 64 * MiB, WS_V = WS_BIG + 81 * MiB;
constexpr size_t WS_END = 478 * MiB;
static_assert(WS_W13M + (size_t)NE * 5632 * 1024 * 2 <= WS_W2M && WS_W2M + (size_t)NE * 1024 * 2816 * 2 <= WS_W13F && WS_W13F + (size_t)5632 * 1024 * 2 <= WS_W2F && WS_W2F + (size_t)1024 * 2816 * 2 <= WS_WQKV, "ws map 1");
static_assert(WS_XS + (size_t)CAPP * 256 * 1024 * 2 <= WS_BIG && WS_BIG + (size_t)CHP * 256 * 2816 * 2 <= WS_END && WS_BIG + (size_t)MT * FF * 2 <= WS_END, "ws map 2");
static_assert(WS_K + (size_t)NBATCH * LKV * 256 * 2 <= WS_V && WS_Q + (size_t)TT * 1024 * 2 <= WS_K, "ws map 3");
constexpr int CW_TMO = 0, CW_CODE = 1;
constexpr int CW_BAR = 4096;
constexpr int CW_CNT = 16384, CW_FILL = 16384 + 64 * 8;

constexpr int RING_OFF = 0, RING_BYTES = 131072;
constexpr int LDSCTL_OFF = RING_BYTES, MISC_OFF = LDSCTL_OFF + 320;
constexpr int LDS_BYTES = 147456;
static_assert(MISC_OFF + 128 <= LDS_BYTES, "LDS map");

#define GAS __attribute__((address_space(1)))
#define LAS __attribute__((address_space(3)))
typedef unsigned short bf16;
typedef unsigned v4u __attribute__((ext_vector_type(4)));
typedef float f32x4 __attribute__((ext_vector_type(4)));
typedef short bf16x8 __attribute__((ext_vector_type(8)));
typedef GAS unsigned gu32;
typedef GAS unsigned long long gu64;
#define RLX_AGENT __ATOMIC_RELAXED, __HIP_MEMORY_SCOPE_AGENT
#define LDS_WAIT() asm volatile("s_waitcnt lgkmcnt(0)" ::: "memory")
#define VM_WAIT() asm volatile("s_waitcnt vmcnt(0)" ::: "memory")
__device__ __forceinline__ unsigned long long rt() { return __builtin_amdgcn_s_memrealtime(); }
__device__ __forceinline__ unsigned f2bf(float f) { unsigned u = __builtin_bit_cast(unsigned, f); return (u + 0x7fffu + ((u >> 16) & 1u)) >> 16; }
__device__ __forceinline__ unsigned pk2(float lo, float hi) { return f2bf(lo) | (f2bf(hi) << 16); }

#define XB_TMO      128
#define XB_XCNT(j)  (256  + 64 * (j))
#define XB_XSUB(j)  (1280 + 64 * (j))
#define XB_XGEN(j)  (2304 + 64 * (j))
#define XB_TOP      3328
#define XB_TOPGEN   3392
#define XCD_BAR_WORDS 3456
#define XB_SPIN_CAP (1u << 18)

__device__ __forceinline__ unsigned xb_ld(unsigned* p)              { return __hip_atomic_load(p, __ATOMIC_RELAXED, __HIP_MEMORY_SCOPE_AGENT); }
__device__ __forceinline__ unsigned xb_add(unsigned* p, unsigned v) { return __hip_atomic_fetch_add(p, v, __ATOMIC_RELAXED, __HIP_MEMORY_SCOPE_AGENT); }
__device__ __forceinline__ unsigned xb_xcc_id() { return (unsigned)__builtin_amdgcn_s_getreg((3 << 11) | 20) & 0xFu; }
#define XB_SPIN(cond, bar) do { unsigned _sp = 0; while (cond) { __builtin_amdgcn_s_sleep(1); \
    if ((++_sp & 255u) == 0u) { if (xb_ld(&(bar)[XB_TMO])) break; if (_sp > XB_SPIN_CAP) { atomicAdd(&(bar)[XB_TMO], 1u); break; } } } } while (0)

struct XcdBarrier {
    unsigned* bar; unsigned x;
    volatile LAS unsigned* st;
};

__device__ __forceinline__ XcdBarrier xcd_barrier_post(unsigned* bar, volatile LAS unsigned* st) {
    XcdBarrier b; b.bar = bar; b.x = xb_xcc_id(); b.st = st;
    if (threadIdx.x == 0) (void)xb_add(&bar[XB_XCNT(b.x)], 1u);
    return b;
}
__device__ __forceinline__ void xcd_barrier_complete(unsigned* bar, unsigned x, unsigned& nloc, unsigned& nx) {
    const unsigned G = gridDim.x * gridDim.y * gridDim.z;
    unsigned sum, cnt, mine, sp = 0u;
    for (;;) {
        sum = 0u; cnt = 0u; mine = 0u;
#pragma unroll
        for (unsigned j = 0; j < 16; ++j) { const unsigned c = xb_ld(&bar[XB_XCNT(j)]); sum += c; cnt += (c > 0u) ? 1u : 0u; mine = (j == x) ? c : mine; }
        if (sum == G) break;
        __builtin_amdgcn_s_sleep(1);
        if ((++sp & 255u) == 0u) { if (xb_ld(&bar[XB_TMO])) break; if (sp > XB_SPIN_CAP) { atomicAdd(&bar[XB_TMO], 1u); break; } }
    }
    nloc = mine > 0u ? mine : 1u; nx = cnt > 0u ? cnt : 1u;
}

__device__ __forceinline__ void xcd_barrier(const XcdBarrier& b) {
    asm volatile("s_waitcnt vmcnt(0)" ::: "memory");
    __syncthreads();
    if (threadIdx.x == 0) {
        unsigned* bar = b.bar;
        __builtin_amdgcn_s_waitcnt(0);
        unsigned nloc = b.st[0], nx = b.st[1];
        if (nloc == 0u) { xcd_barrier_complete(bar, b.x, nloc, nx); b.st[0] = nloc; b.st[1] = nx; }
        const unsigned old = xb_add(&bar[XB_XSUB(b.x)], 1u);
        const unsigned gen = old / nloc;
        if (old + 1u == (gen + 1u) * nloc) {
            __builtin_amdgcn_fence(__ATOMIC_RELEASE, "agent");
            asm volatile("s_waitcnt vmcnt(0)" ::: "memory");
            const unsigned og = xb_add(&bar[XB_TOP], 1u);
            const unsigned tg = og / nx;
            if (og + 1u == (tg + 1u) * nx) xb_add(&bar[XB_TOPGEN], 1u);
            else XB_SPIN(xb_ld(&bar[XB_TOPGEN]) == tg, bar);
            __builtin_amdgcn_fence(__ATOMIC_ACQUIRE, "agent");
            xb_add(&bar[XB_XGEN(b.x)], 1u);
            asm volatile("s_waitcnt vmcnt(0)" ::: "memory");
        } else {
            XB_SPIN(xb_ld(&bar[XB_XGEN(b.x)]) == gen, bar);
            __builtin_amdgcn_fence(__ATOMIC_ACQUIRE, "agent");
            asm volatile("s_waitcnt vmcnt(0)" ::: "memory");
        }
    }
    __syncthreads();
}

struct Frame {
    LAS unsigned char* lds;
    volatile LAS unsigned* MISC;
    gu32* ctl;
    int tid, lane, wave;
    int vcu, G;
    unsigned char* ws;
    const float* in[21]; float* out;
};
__device__ __forceinline__ float wave_sum(float v) {
#pragma unroll
    for (int o = 1; o < 64; o <<= 1) v += __shfl_xor(v, o);
    return v;
}
__device__ __forceinline__ float silu_acc(float a) { return a / (1.0f + expf(-a)); }
__device__ __forceinline__ const float* row_src(const float* xs, const float* cs, int r) { return r < TT ? xs + (size_t)r * D : cs + (size_t)(r - TT) * D; }
__device__ __forceinline__ int row_kind(int r) { return r < LSEQ ? 0 : (r < TT ? 1 : 2); }

__device__ __forceinline__ void tr_item(const float* W, int N, int k0, int n0, bf16* WT, int ldt, int drow0, LAS float* scr, int lane) {
#pragma unroll 8
    for (int i = 0; i < 32; ++i) { const int kk = 2 * i + (lane >> 5); scr[kk * 33 + (lane & 31)] = W[(size_t)(k0 + kk) * N + n0 + (lane & 31)]; }
    LDS_WAIT(); asm volatile("" ::: "memory");
    const int c = lane & 7;
#pragma unroll
    for (int j = 0; j < 4; ++j) { const int n = (lane >> 3) + 8 * j; const LAS float* s = scr + (8 * c) * 33 + n;
        v4u o; o.x = pk2(s[0 * 33], s[1 * 33]); o.y = pk2(s[2 * 33], s[3 * 33]); o.z = pk2(s[4 * 33], s[5 * 33]); o.w = pk2(s[6 * 33], s[7 * 33]);
        *(GAS v4u*)(WT + (size_t)(drow0 + n) * ldt + k0 + 8 * c) = o; }
    LDS_WAIT(); asm volatile("" ::: "memory");
}
__device__ __forceinline__ void tr_w13(const float* W, bf16* WT, int which, int q, LAS float* scr, int lane) {
    const int kb = q / 88, nb = q % 88, n0 = 32 * nb;
    tr_item(W, FF, 64 * kb, n0, WT, D, (n0 >> 7) * 256 + (n0 & 127) + which * 128, scr, lane);
}
__device__ __forceinline__ void tr_w2(const float* W, bf16* WT, int q, LAS float* scr, int lane) {
    const int kb = q >> 5, nb = q & 31;
    tr_item(W, D, 64 * kb, 32 * nb, WT, FF, 32 * nb, scr, lane);
}

__device__ __forceinline__ void p0_phase(Frame& F) {
    LAS float* scr = (LAS float*)(F.lds + RING_OFF + F.wave * 16384);
    const int gw = F.vcu * NWAVES + F.wave, NGW = F.G * NWAVES;
    float* PART = (float*)(F.ws + WS_PART);
    for (int task = gw; task < 2 * 96 * 8; task += NGW) {
        const int ks = task & 7, cg = (task >> 3) % 96, layer = task / 768, k0 = ks * 128, col = cg * 64 + F.lane;
        float sa[3][2];
#pragma unroll
        for (int v = 0; v < 3; ++v)
#pragma unroll
            for (int h = 0; h < 2; ++h) { const float* cv = v < 2 ? F.in[1] + v * D : F.in[3]; sa[v][h] = silu_acc(cv[k0 + h * 64 + F.lane]); }
        const float* W = F.in[4] + (size_t)layer * D * 6144 + (size_t)k0 * 6144 + col;
        float a0 = 0.f, a1 = 0.f, a2 = 0.f;
#pragma unroll
        for (int h = 0; h < 2; ++h)
#pragma unroll 8
            for (int kk = 0; kk < 64; ++kk) { const float w = W[(size_t)(h * 64 + kk) * 6144];
                a0 += __shfl(sa[0][h], kk) * w; a1 += __shfl(sa[1][h], kk) * w; a2 += __shfl(sa[2][h], kk) * w; }
        float* P = PART + (size_t)((layer * 8 + ks) * 3) * 6144 + col;
        P[0] = a0; P[6144] = a1; P[2 * 6144] = a2;
    }
    constexpr int I_POOL = 4 * 4 * 8, I_13 = 16 * 88, I_2 = 44 * 32, I_QKV = 16 * 48, I_O = 16 * 32;
    constexpr int NITEMS = I_POOL + 2 * I_13 + I_2 + I_QKV + I_O;
    for (int it = gw; it < NITEMS; it += NGW) {
        int r = it;
        if (r < I_POOL) { const int g = r >> 5, q = r & 31; tr_item(F.in[7] + (size_t)g * 65536, 256, 64 * (q >> 3), 32 * (q & 7), (bf16*)(F.ws + WS_POOL) + (size_t)g * 65536, 256, 32 * (q & 7), scr, F.lane); continue; } r -= I_POOL;
        if (r < I_13) { tr_w13(F.in[9], (bf16*)(F.ws + WS_W13F), 0, r, scr, F.lane); continue; } r -= I_13;
        if (r < I_13) { tr_w13(F.in[10], (bf16*)(F.ws + WS_W13F), 1, r, scr, F.lane); continue; } r -= I_13;
        if (r < I_2) { tr_w2(F.in[11], (bf16*)(F.ws + WS_W2F), r, scr, F.lane); continue; } r -= I_2;
        if (r < I_QKV) { const int kb = r / 48, nb = r % 48; tr_item(F.in[12], NQKV, 64 * kb, 32 * nb, (bf16*)(F.ws + WS_WQKV), D, 32 * nb, scr, F.lane); continue; } r -= I_QKV;
        { const int kb = r >> 5, nb = r & 31; tr_item(F.in[13], D, 64 * kb, 32 * nb, (bf16*)(F.ws + WS_WO), D, 32 * nb, scr, F.lane); }
    }
    float* RS = (float*)(F.ws + WS_RSTD);
    for (int r = gw; r < MT; r += NGW) {
        const GAS f32x4* xr = (const GAS f32x4*)row_src(F.in[0], F.in[2], r) + F.lane; float s = 0.f;
#pragma unroll
        for (int j = 0; j < 4; ++j) { const f32x4 v = xr[64 * j]; s += (v.x * v.x + v.y * v.y) + (v.z * v.z + v.w * v.w); }
        s = wave_sum(s);
        if (F.lane == 0) RS[r] = 1.0f / sqrtf(s * (1.0f / D) + NORM_EPS);
    }
    { const int gt = (F.vcu * NWAVES + F.wave) * 64 + F.lane;
      if (gt < 4096) { const int pos = gt >> 4, i = gt & 15; const float fr = powf(10000.0f, -(float)i * (1.0f / 16.0f)); const float ang = (float)pos * fr;
          float2* RT = (float2*)(F.ws + WS_ROPE); RT[gt] = make_float2(cosf(ang), sinf(ang)); } }
}
__device__ __forceinline__ void p1_phase(Frame& F) {
    LAS float* scr = (LAS float*)(F.lds + RING_OFF + F.wave * 16384);
    const int gw = F.vcu * NWAVES + F.wave, NGW = F.G * NWAVES;
    { const int gt = gw * 64 + F.lane;
      if (gt < 2 * 3 * 6144) { const int layer = gt / 18432, v = (gt % 18432) / 6144, n = gt % 6144; const float* PART = (const float*)(F.ws + WS_PART);
          float s = F.in[5][layer * 6144 + n];
#pragma unroll
          for (int ks = 0; ks < 8; ++ks) s += PART[(size_t)((layer * 8 + ks) * 3 + v) * 6144 + n];
          ((float*)(F.ws + WS_MODS))[gt] = s; } }
    for (int it = gw; it < NE * 4224; it += NGW) {
        const int e = it / 4224, r = it % 4224, m = r / 1408, q = r % 1408;
        if (m < 2) tr_w13((m == 0 ? F.in[17] : F.in[18]) + (size_t)e * D * FF, (bf16*)(F.ws + WS_W13M) + (size_t)e * 5632 * D, m, q, scr, F.lane);
        else tr_w2(F.in[19] + (size_t)e * FF * D, (bf16*)(F.ws + WS_W2M) + (size_t)e * D * FF, q, scr, F.lane);
    }
}
__device__ __forceinline__ void p2_pooldiff(Frame& F) {
    const int gw = F.vcu * NWAVES + F.wave, NGW = F.G * NWAVES;
    const float* RS = (const float*)(F.ws + WS_RSTD); const float* MODS = (const float*)(F.ws + WS_MODS);
    bf16* Dm = (bf16*)(F.ws + WS_XS);
    for (int task = gw; task < MT / 8; task += NGW) {
        const int r0 = task * 8;
        int s0, Ls; if (r0 < LSEQ) { s0 = 0; Ls = LSEQ; } else if (r0 < TT) { s0 = LSEQ; Ls = LSEQ; } else if (r0 < TT + CTXL) { s0 = TT; Ls = CTXL; } else { s0 = TT + CTXL; Ls = CTXL; }
        const int mi = row_kind(r0);
        f32x4 gm[4];
#pragma unroll
        for (int j = 0; j < 4; ++j) { const f32x4 g = ((const GAS f32x4*)(F.in[6]))[64 * j + F.lane]; const f32x4 sc = ((const GAS f32x4*)(MODS + (mi * 6 + 1) * D))[64 * j + F.lane]; gm[j] = g * (sc + 1.0f); }
        for (int rr = 0; rr < 8; ++rr) {
            const int r = r0 + rr, t = r - s0; const float rs = RS[r];
            const GAS f32x4* xr = (const GAS f32x4*)row_src(F.in[0], F.in[2], r) + F.lane;
            GAS unsigned long long* o8 = (GAS unsigned long long*)(Dm + (size_t)r * D) + F.lane;
#pragma unroll
            for (int j = 0; j < 4; ++j) {
                const int h = 1 << j; const int lo = t - h < 0 ? 0 : t - h, hi = t + h > Ls ? Ls : t + h;
                f32x4 acc = {0.f, 0.f, 0.f, 0.f};
                for (int tt = lo; tt < hi; ++tt) { const int r2 = s0 + tt; const f32x4 v = ((const GAS f32x4*)row_src(F.in[0], F.in[2], r2))[64 * j + F.lane]; acc = acc + v * RS[r2]; }
                const f32x4 own = xr[64 * j] * rs;
                const f32x4 d = (acc * (1.0f / (float)(hi - lo)) - own) * gm[j];
                o8[64 * j] = (unsigned long long)pk2(d.x, d.y) | ((unsigned long long)pk2(d.z, d.w) << 32);
            }
        }
    }
}
__device__ __forceinline__ void normmod_phase(Frame& F, const float* xs, const float* cs, bf16* HX, const float* ng, const float* mods, int ish, int isc, int nrows) {
    const int gw = F.vcu * NWAVES + F.wave, NGW = F.G * NWAVES;
    for (int task = gw; task < nrows / 16; task += NGW) {
        const int r0 = task * 16, mi = row_kind(r0);
        f32x4 gm[4], sh[4];
#pragma unroll
        for (int j = 0; j < 4; ++j) { const f32x4 g = ((const GAS f32x4*)ng)[64 * j + F.lane]; const f32x4 sc = ((const GAS f32x4*)(mods + (mi * 6 + isc) * D))[64 * j + F.lane]; gm[j] = g * (sc + 1.0f);
            sh[j] = ((const GAS f32x4*)(mods + (mi * 6 + ish) * D))[64 * j + F.lane]; }
        for (int rr = 0; rr < 16; ++rr) {
            const int r = r0 + rr;
            const GAS f32x4* xr = (const GAS f32x4*)row_src(xs, cs, r) + F.lane;
            f32x4 v[4]; float s = 0.f;
#pragma unroll
            for (int j = 0; j < 4; ++j) { v[j] = xr[64 * j]; s += (v[j].x * v[j].x + v[j].y * v[j].y) + (v[j].z * v[j].z + v[j].w * v[j].w); }
            const float rstd = 1.0f / sqrtf(wave_sum(s) * (1.0f / D) + NORM_EPS);
            GAS unsigned long long* o8 = (GAS unsigned long long*)(HX + (size_t)r * D) + F.lane;
#pragma unroll
            for (int j = 0; j < 4; ++j) { const f32x4 o = v[j] * rstd * gm[j] + sh[j]; o8[64 * j] = (unsigned long long)pk2(o.x, o.y) | ((unsigned long long)pk2(o.z, o.w) << 32); }
        }
    }
}
__device__ __forceinline__ float bf_lo(unsigned w) { return __builtin_bit_cast(float, w << 16); }
__device__ __forceinline__ float bf_hi(unsigned w) { return __builtin_bit_cast(float, w & 0xffff0000u); }
__device__ __forceinline__ void qk_norm_rope(float (&v)[16], const f32x4 (&gn)[4], const float2* RT, int qt, int pos, bool rope, float scale) {
    float ss = 0.f;
#pragma unroll
    for (int i = 0; i < 16; ++i) ss += v[i] * v[i];
    ss += __shfl_xor(ss, 1); ss += __shfl_xor(ss, 2);
    const float rstd = 1.0f / sqrtf(ss * (1.0f / 64.0f) + NORM_EPS);
#pragma unroll
    for (int i = 0; i < 16; ++i) v[i] = v[i] * rstd * gn[i >> 2][i & 3];
    const float2* rt = RT + pos * 16;
#pragma unroll
    for (int i = 0; i < 16; ++i) { const float p = __shfl_xor(v[i], 1); const float2 cs = rt[i]; const float r = v[i] * cs.x + ((qt & 1) ? p : -p) * cs.y; v[i] = (rope ? r : v[i]) * scale; }
}
__device__ __forceinline__ void p9_qknorm(Frame& F) {
    const int gw = F.vcu * NWAVES + F.wave, NGW = F.G * NWAVES, lane = F.lane;
    const float2* RT = (const float2*)(F.ws + WS_ROPE);
    const int qt = lane & 3;
    f32x4 gq[4], gk[4];
#pragma unroll
    for (int i = 0; i < 4; ++i) { gq[i] = ((const GAS f32x4*)(F.in[14]))[qt * 4 + i]; gk[i] = ((const GAS f32x4*)(F.in[15]))[qt * 4 + i]; }
    constexpr int NQT = TT, NKT = (NBATCH * LKV) / 4;
    for (int task = gw; task < NQT + NKT; task += NGW) {
        GAS v4u* p; int pos; bool rope; float scale;
        if (task < NQT) { const int t = task & (LSEQ - 1); pos = qt < 2 ? (t >> 6) : (t & 63); rope = true; scale = QSCALE; p = (GAS v4u*)((bf16*)(F.ws + WS_Q) + (size_t)task * D + 16 * lane); }
        else { const int kr = (task - NQT) * 4 + (lane >> 4), t = kr % LKV; rope = t < LSEQ; const int tc = rope ? t : 0; pos = qt < 2 ? (tc >> 6) : (tc & 63); scale = 1.0f; p = (GAS v4u*)((bf16*)(F.ws + WS_K) + (size_t)kr * 256 + 16 * (lane & 15)); }
        const v4u w0 = p[0], w1 = p[1]; float v[16];
        v[0] = bf_lo(w0.x); v[1] = bf_hi(w0.x); v[2] = bf_lo(w0.y); v[3] = bf_hi(w0.y); v[4] = bf_lo(w0.z); v[5] = bf_hi(w0.z); v[6] = bf_lo(w0.w); v[7] = bf_hi(w0.w);
        v[8] = bf_lo(w1.x); v[9] = bf_hi(w1.x); v[10] = bf_lo(w1.y); v[11] = bf_hi(w1.y); v[12] = bf_lo(w1.z); v[13] = bf_hi(w1.z); v[14] = bf_lo(w1.w); v[15] = bf_hi(w1.w);
        if (task < NQT) qk_norm_rope(v, gq, RT, qt, pos, rope, scale); else qk_norm_rope(v, gk, RT, qt, pos, rope, scale);
        v4u o0, o1; o0.x = pk2(v[0], v[1]); o0.y = pk2(v[2], v[3]); o0.z = pk2(v[4], v[5]); o0.w = pk2(v[6], v[7]); o1.x = pk2(v[8], v[9]); o1.y = pk2(v[10], v[11]); o1.z = pk2(v[12], v[13]); o1.w = pk2(v[14], v[15]);
        p[0] = o0; p[1] = o1;
    }
}
__device__ __forceinline__ void p12_router(Frame& F) {
    const int gw = F.vcu * NWAVES + F.wave, NGW = F.G * NWAVES, lane = F.lane;
    LAS float* RW = (LAS float*)(F.lds + RING_OFF);
    for (int c = F.tid; c < D; c += NWAVES * 64) { const f32x4 a = ((const GAS f32x4*)(F.in[16]))[2 * c], b = ((const GAS f32x4*)(F.in[16]))[2 * c + 1];
        RW[0 * D + c] = a.x; RW[1 * D + c] = a.y; RW[2 * D + c] = a.z; RW[3 * D + c] = a.w; RW[4 * D + c] = b.x; RW[5 * D + c] = b.y; RW[6 * D + c] = b.z; RW[7 * D + c] = b.w; }
    __syncthreads();
    const float* MODS = (const float*)(F.ws + WS_MODS) + 3 * 6 * D;
    const float* ng = F.in[6] + 3 * D;
    bf16* HX = (bf16*)(F.ws + WS_BIG); int* EID = (int*)(F.ws + WS_EID); float* GATE = (float*)(F.ws + WS_GATE);
    int cnt0 = 0, cnt1 = 0, cnt2 = 0, cnt3 = 0, cnt4 = 0, cnt5 = 0, cnt6 = 0, cnt7 = 0;
    for (int task = gw; task < TT / 16; task += NGW) {
        const int r0 = task * 16, mi = row_kind(r0);
        f32x4 gm[4], sh[4];
#pragma unroll
        for (int j = 0; j < 4; ++j) { const f32x4 g = ((const GAS f32x4*)ng)[64 * j + lane]; const f32x4 sc = ((const GAS f32x4*)(MODS + (mi * 6 + 4) * D))[64 * j + lane]; gm[j] = g * (sc + 1.0f);
            sh[j] = ((const GAS f32x4*)(MODS + (mi * 6 + 3) * D))[64 * j + lane]; }
        for (int rr = 0; rr < 16; ++rr) {
            const int r = r0 + rr;
            const GAS f32x4* xr = (const GAS f32x4*)(F.out + (size_t)r * D) + lane;
            f32x4 v[4]; float s = 0.f;
#pragma unroll
            for (int j = 0; j < 4; ++j) { v[j] = xr[64 * j]; s += (v[j].x * v[j].x + v[j].y * v[j].y) + (v[j].z * v[j].z + v[j].w * v[j].w); }
            const float rstd = 1.0f / sqrtf(wave_sum(s) * (1.0f / D) + NORM_EPS);
            GAS unsigned long long* o8 = (GAS unsigned long long*)(HX + (size_t)r * D) + lane;
            float lg[8];
#pragma unroll
            for (int e = 0; e < 8; ++e) lg[e] = 0.f;
#pragma unroll
            for (int j = 0; j < 4; ++j) { const f32x4 o = v[j] * rstd * gm[j] + sh[j]; o8[64 * j] = (unsigned long long)pk2(o.x, o.y) | ((unsigned long long)pk2(o.z, o.w) << 32);
#pragma unroll
                for (int e = 0; e < 8; ++e) { const f32x4 w = *(const LAS f32x4*)(RW + e * D + 256 * j + 4 * lane); lg[e] += (o.x * w.x + o.y * w.y) + (o.z * w.z + o.w * w.w); } }
#pragma unroll
            for (int e = 0; e < 8; ++e) lg[e] = wave_sum(lg[e]);
            int e1 = 0; float l1 = lg[0];
#pragma unroll
            for (int e = 1; e < 8; ++e) if (lg[e] > l1) { l1 = lg[e]; e1 = e; }
            int e2 = -1; float l2 = -INFINITY;
#pragma unroll
            for (int e = 0; e < 8; ++e) if (e != e1 && lg[e] > l2) { l2 = lg[e]; e2 = e; }
            const float dd = expf(l2 - l1), g1 = 1.0f / (1.0f + dd), g2 = dd / (1.0f + dd);
            if (lane == 0) { EID[2 * r] = e1; EID[2 * r + 1] = e2; GATE[2 * r] = g1; GATE[2 * r + 1] = g2; }
            cnt0 += (e1 == 0) + (e2 == 0); cnt1 += (e1 == 1) + (e2 == 1); cnt2 += (e1 == 2) + (e2 == 2); cnt3 += (e1 == 3) + (e2 == 3);
            cnt4 += (e1 == 4) + (e2 == 4); cnt5 += (e1 == 5) + (e2 == 5); cnt6 += (e1 == 6) + (e2 == 6); cnt7 += (e1 == 7) + (e2 == 7);
        }
    }
    { const int mine = lane == 0 ? cnt0 : lane == 1 ? cnt1 : lane == 2 ? cnt2 : lane == 3 ? cnt3 : lane == 4 ? cnt4 : lane == 5 ? cnt5 : lane == 6 ? cnt6 : cnt7;
      if (lane < 8 && mine > 0) __hip_atomic_fetch_add((unsigned*)(F.ctl + CW_CNT + 64 * lane), (unsigned)mine, __ATOMIC_RELAXED, __HIP_MEMORY_SCOPE_AGENT); }
    __syncthreads();
}
__device__ __forceinline__ void p13_slots(Frame& F) {
    const int gw = F.vcu * NWAVES + F.wave, NGW = F.G * NWAVES, lane = F.lane;
    int pstart[8]; int ends[8];
    { int run = 0;
#pragma unroll
      for (int e = 0; e < 8; ++e) { const int c = (int)__hip_atomic_load((unsigned*)(F.ctl + CW_CNT + 64 * e), __ATOMIC_RELAXED, __HIP_MEMORY_SCOPE_AGENT); pstart[e] = run; run += (c + 255) & ~255; ends[e] = run; } }
    int* PEXP = (int*)(F.ws + WS_PEXP);
    if (gw == 0) {
        for (int p = lane; p < CAPP; p += 64) { int e = 0;
#pragma unroll
            for (int j = 0; j < 8; ++j) e += (ends[j] <= p * 256) ? 1 : 0;
            PEXP[p] = e > 7 ? 7 : e; }
        if (lane == 0) PEXP[512] = ends[7] >> 8;
    }
    const int* EID = (const int*)(F.ws + WS_EID); int* SLOT = (int*)(F.ws + WS_SLOT);
    const bf16* HX = (const bf16*)(F.ws + WS_BIG); bf16* XS = (bf16*)(F.ws + WS_XS);
    for (int task = gw; task < TT / 32; task += NGW) {
        const int r0 = task * 32; const int e = EID[2 * r0 + lane]; int slot = 0;
#pragma unroll
        for (int ee = 0; ee < 8; ++ee) {
            const unsigned long long mask = __ballot(e == ee); const int n = __popcll(mask);
            if (n) { unsigned base = 0; if (lane == 0) base = __hip_atomic_fetch_add((unsigned*)(F.ctl + CW_FILL + 64 * ee), (unsigned)n, __ATOMIC_RELAXED, __HIP_MEMORY_SCOPE_AGENT);
                base = (unsigned)__builtin_amdgcn_readfirstlane((int)base);
                if (e == ee) slot = pstart[ee] + (int)base + __popcll(mask & ((1ull << lane) - 1ull)); }
        }
        SLOT[2 * r0 + lane] = slot;
#pragma unroll 4
        for (int i = 0; i < 64; ++i) { const int s = __shfl(slot, i);
            const GAS v4u* src = (const GAS v4u*)(HX + (size_t)(r0 + (i >> 1)) * D) + lane; GAS v4u* dst = (GAS v4u*)(XS + (size_t)s * D) + lane;
            const v4u a = src[0], b = src[64]; dst[0] = a; dst[64] = b; }
    }
}
__device__ __forceinline__ void p18_combine(Frame& F) {
    const int gw = F.vcu * NWAVES + F.wave, NGW = F.G * NWAVES, lane = F.lane;
    const float* MODS = (const float*)(F.ws + WS_MODS) + 3 * 6 * D;
    const int* SLOT = (const int*)(F.ws + WS_SLOT); const float* GATE = (const float*)(F.ws + WS_GATE); const bf16* Y = (const bf16*)(F.ws + WS_XS);
    for (int task = gw; task < TT / 16; task += NGW) {
        const int r0 = task * 16, mi = row_kind(r0);
        f32x4 g2[4], fg[4];
#pragma unroll
        for (int j = 0; j < 4; ++j) { g2[j] = ((const GAS f32x4*)(MODS + (mi * 6 + 5) * D))[64 * j + lane]; fg[j] = ((const GAS f32x4*)(F.in[20]))[64 * j + lane]; }
        for (int rr = 0; rr < 16; ++rr) {
            const int r = r0 + rr; const int s0 = SLOT[2 * r], s1 = SLOT[2 * r + 1]; const float ga = GATE[2 * r], gb = GATE[2 * r + 1];
            GAS f32x4* xr = (GAS f32x4*)(F.out + (size_t)r * D) + lane;
            const GAS unsigned long long* y0 = (const GAS unsigned long long*)(Y + (size_t)s0 * D) + lane; const GAS unsigned long long* y1 = (const GAS unsigned long long*)(Y + (size_t)s1 * D) + lane;
            f32x4 v[4]; float s = 0.f;
#pragma unroll
            for (int j = 0; j < 4; ++j) { const unsigned long long a = y0[64 * j], b = y1[64 * j];
                const f32x4 ya = {bf_lo((unsigned)a), bf_hi((unsigned)a), bf_lo((unsigned)(a >> 32)), bf_hi((unsigned)(a >> 32))};
                const f32x4 yb = {bf_lo((unsigned)b), bf_hi((unsigned)b), bf_lo((unsigned)(b >> 32)), bf_hi((unsigned)(b >> 32))};
                v[j] = xr[64 * j] + g2[j] * (ya * ga + yb * gb); s += (v[j].x * v[j].x + v[j].y * v[j].y) + (v[j].z * v[j].z + v[j].w * v[j].w); }
            const float rstd = 1.0f / sqrtf(wave_sum(s) * (1.0f / D) + NORM_EPS);
#pragma unroll
            for (int j = 0; j < 4; ++j) xr[64 * j] = v[j] * rstd * fg[j];
        }
    }
}

struct Args { const float* in[21]; float* out; unsigned char* ws; int ph_lo, ph_hi; };
__global__ void __launch_bounds__(NWAVES * 64, 2) mk_fwd(Args args) {
    extern __shared__ __attribute__((aligned(16))) unsigned char lds[];
    Frame F;
    F.lds = (LAS unsigned char*)lds;
    F.MISC = (volatile LAS unsigned*)(F.lds + MISC_OFF);
    F.tid = threadIdx.x; F.lane = F.tid & 63; F.wave = __builtin_amdgcn_readfirstlane(F.tid >> 6);
    F.G = gridDim.x; { const int bx = blockIdx.x; F.vcu = (F.G % 8 == 0) ? (bx % 8) * (F.G / 8) + bx / 8 : bx; }
    F.ws = args.ws; F.ctl = (gu32*)(args.ws + WS_CTL); F.out = args.out;
#pragma unroll
    for (int i = 0; i < 21; ++i) F.in[i] = args.in[i];
    for (int u = F.tid; u < (LDS_BYTES - LDSCTL_OFF) / 4; u += NWAVES * 64) ((LAS unsigned*)(F.lds + LDSCTL_OFF))[u] = 0u;
    __syncthreads();
    XcdBarrier bar; bar.bar = (unsigned*)(F.ctl + CW_BAR); bar.x = 0; bar.st = nullptr;
    if (N_LAUNCHES != PER_PHASE) bar = xcd_barrier_post((unsigned*)(F.ctl + CW_BAR), F.MISC + 8);
#define GRID_BAR(seam) do { if (N_LAUNCHES == PER_PHASE) { if (F.tid == 0) __hip_atomic_store(F.ctl + CW_TMO, 0xBADBA0u | (unsigned)(seam), RLX_AGENT); } else { xcd_barrier(bar); } } while (0)
    const int lo = args.ph_lo, hi = args.ph_hi;
#define IN(k) (lo <= (k) && (k) < hi)
#define BOTH(k) (IN(k) && IN((k) + 1))
    const int bx = (int)blockIdx.x;
    const float* MODS0 = (const float*)(F.ws + WS_MODS); const float* MODS1 = MODS0 + 3 * 6 * D;
    bf16* HXB = (bf16*)(F.ws + WS_XS); float* CTXB = (float*)(F.ws + WS_CTXB); bf16* HB = (bf16*)(F.ws + WS_BIG);

    if (IN(0)) { p0_phase(F); if (BOTH(0)) GRID_BAR(0); }
    if (IN(1)) { p1_phase(F); if (BOTH(1)) GRID_BAR(1); }
    if (IN(2)) { p2_pooldiff(F); if (BOTH(2)) GRID_BAR(2); }
    if (IN(3)) {
        pg8::Gemm g{HXB, (const bf16*)(F.ws + WS_POOL), 256, D, 256}; pg8::GridOrder S{NPT, 4, F.G, bx, 256};
        pg8::EpiRes E{F.in[0], F.in[2], F.out, CTXB, MODS0, 2, F.in[8]};
        pg8::gemm_phase<pg8::EpiRes, pg8::GridOrder, true, true>(F.lds + RING_OFF, g, S, E);
        if (BOTH(3)) GRID_BAR(3);
    }
    if (IN(4)) { normmod_phase(F, F.out, CTXB, HXB, F.in[6] + D, MODS0, 3, 4, MT); if (BOTH(4)) GRID_BAR(4); }
    if (IN(5)) {
        pg8::Gemm g{HXB, (const bf16*)(F.ws + WS_W13F), D, D, D}; pg8::GridOrder S{NPT, 22, F.G, bx, 0};
        pg8::EpiSwiGLU E{HB, FF};
        pg8::gemm_phase<pg8::EpiSwiGLU, pg8::GridOrder, true, true>(F.lds + RING_OFF, g, S, E);
        if (BOTH(5)) GRID_BAR(5);
    }
    if (IN(6)) {
        pg8::Gemm g{HB, (const bf16*)(F.ws + WS_W2F), FF, FF, FF}; pg8::GridOrder S{NPT, 4, F.G, bx, 0};
        pg8::EpiRes E{F.out, CTXB, F.out, CTXB, MODS0, 5, nullptr};
        pg8::gemm_phase<pg8::EpiRes, pg8::GridOrder, true, true>(F.lds + RING_OFF, g, S, E);
        if (BOTH(6)) GRID_BAR(6);
    }
    if (IN(7)) { normmod_phase(F, F.out, CTXB, HXB, F.in[6] + 2 * D, MODS1, 0, 1, MT); if (BOTH(7)) GRID_BAR(7); }
    if (IN(8)) {
        pg8::Gemm g{HXB, (const bf16*)(F.ws + WS_WQKV), D, D, D}; pg8::QkvOrder S{F.G, bx};
        pg8::EpiQKV E{(bf16*)(F.ws + WS_Q), (bf16*)(F.ws + WS_K), (bf16*)(F.ws + WS_V)};
        pg8::gemm_phase<pg8::EpiQKV, pg8::QkvOrder, true, true>(F.lds + RING_OFF, g, S, E);
        if (BOTH(8)) GRID_BAR(8);
    }
    if (IN(9)) { p9_qknorm(F); if (BOTH(9)) GRID_BAR(9); }
    if (IN(10)) {
        const attn_body::AttnTensors AT{(const attn_body::bf16*)(F.ws + WS_Q), (const attn_body::bf16*)(F.ws + WS_K), (const attn_body::bf16*)(F.ws + WS_V), (attn_body::bf16*)(F.ws + WS_Q)};
        const attn_body::StaticOrder S((int)F.G, bx);
        attn_body::attn_phase<attn_body::StaticOrder>((char*)lds + RING_OFF, AT, S);
        if (BOTH(10)) GRID_BAR(10);
    }
    if (IN(11)) {
        pg8::Gemm g{(const bf16*)(F.ws + WS_Q), (const bf16*)(F.ws + WS_WO), D, D, D}; pg8::GridOrder S{NPX, 4, F.G, bx, 0};
        pg8::EpiRes E{F.out, CTXB, F.out, CTXB, MODS1, 2, nullptr};
        pg8::gemm_phase<pg8::EpiRes, pg8::GridOrder, true, true>(F.lds + RING_OFF, g, S, E);
        if (BOTH(11)) GRID_BAR(11);
    }
    if (IN(12)) { p12_router(F); if (BOTH(12)) GRID_BAR(12); }
    if (IN(13)) { p13_slots(F); if (BOTH(13)) GRID_BAR(13); }
    for (int ch = 0; ch < 2; ++ch) {
        const int* PEXP = (const int*)(F.ws + WS_PEXP);
        if (IN(14 + 2 * ch)) {
            const int np = __builtin_amdgcn_readfirstlane(PEXP[512]); const int clo = ch * CHP; int n = np - clo; n = n < 0 ? 0 : (n > CHP ? CHP : n);
            pg8::Gemm g{(const bf16*)(F.ws + WS_XS), (const bf16*)(F.ws + WS_W13M), D, D, D}; pg8::MoeOrder S{n, 22, F.G, bx, clo, 0, PEXP};
            pg8::EpiSwiGLU E{HB, FF};
            pg8::gemm_phase<pg8::EpiSwiGLU, pg8::MoeOrder, true, true>(F.lds + RING_OFF, g, S, E);
            if (BOTH(14 + 2 * ch)) GRID_BAR(14 + 2 * ch);
        }
        if (IN(15 + 2 * ch)) {
            const int np = __builtin_amdgcn_readfirstlane(PEXP[512]); const int clo = ch * CHP; int n = np - clo; n = n < 0 ? 0 : (n > CHP ? CHP : n);
            pg8::Gemm g{HB, (const bf16*)(F.ws + WS_W2M), FF, FF, FF}; pg8::MoeOrder S{n, 4, F.G, bx, clo, 1, PEXP};
            pg8::EpiBf16 E{(bf16*)(F.ws + WS_XS), D};
            pg8::gemm_phase<pg8::EpiBf16, pg8::MoeOrder, true, true>(F.lds + RING_OFF, g, S, E);
            if (BOTH(15 + 2 * ch)) GRID_BAR(15 + 2 * ch);
        }
    }
    if (IN(18)) p18_combine(F);
#undef IN
#undef BOTH
}

extern "C" void kernel_launch(void* const* d_in, const int* in_sizes, int n_in, void* d_out, int out_size, void* d_ws, size_t ws_size, hipStream_t stream) {
    static int grid = 0;
    if (grid == 0) {
        if (n_in != 21 || in_sizes[0] != TT * D || out_size != TT * D || ws_size < WS_END) { fprintf(stderr, "kernel_launch: unexpected shapes (n_in %d, in0 %d, out %d, ws %zu); nothing launched\n", n_in, n_in > 0 ? in_sizes[0] : -1, out_size, ws_size); grid = -1; return; }
        int dev = 0, cus = 0, per_cu = 0;
        if (hipGetDevice(&dev) != hipSuccess || hipDeviceGetAttribute(&cus, hipDeviceAttributeMultiprocessorCount, dev) != hipSuccess) { grid = -1; return; }
        if (hipFuncSetAttribute((const void*)mk_fwd, hipFuncAttributeMaxDynamicSharedMemorySize, LDS_BYTES) != hipSuccess) { fprintf(stderr, "kernel_launch: hipFuncSetAttribute failed\n"); grid = -1; return; }
        if (hipOccupancyMaxActiveBlocksPerMultiprocessor(&per_cu, (const void*)mk_fwd, NWAVES * 64, LDS_BYTES) != hipSuccess || per_cu < 1)
            fprintf(stderr, "kernel_launch: note: occupancy query reports %d workgroups per CU\n", per_cu);
        (void)hipGetLastError();
        grid = cus;
    }
    if (grid < 0) return;
    if (hipMemsetAsync((char*)d_ws + WS_CTL, 0, CTL_ZERO_BYTES, stream) != hipSuccess) return;
    Args a{};
    for (int i = 0; i < 21; ++i) a.in[i] = (const float*)d_in[i];
    a.out = (float*)d_out; a.ws = (unsigned char*)d_ws;
    if (N_LAUNCHES == 1) { a.ph_lo = 0; a.ph_hi = PER_PHASE; hipLaunchKernelGGL(mk_fwd, dim3(grid), dim3(NWAVES * 64), LDS_BYTES, stream, a); }
    else for (int li = 0; li < PER_PHASE; ++li) { a.ph_lo = li; a.ph_hi = li + 1; hipLaunchKernelGGL(mk_fwd, dim3(grid), dim3(NWAVES * 64), LDS_BYTES, stream, a); }
}
```

```cpp
#include <hip/hip_runtime.h>
#include <hip/hip_bf16.h>
#include <cstdio>
#include <cstdint>
#include <cmath>
__device__ __forceinline__ int mk_lane() { int l; asm volatile("v_mbcnt_lo_u32_b32 %0, -1, 0\n\tv_mbcnt_hi_u32_b32 %0, -1, %0" : "=v"(l)); return l; }

namespace pg8 {
#define PG8_LAS __attribute__((address_space(3)))
typedef unsigned short bf16_t;
typedef short bf16x8 __attribute__((ext_vector_type(8)));
typedef float f32x4 __attribute__((ext_vector_type(4)));
typedef unsigned u32x4 __attribute__((ext_vector_type(4)));
constexpr int BM = 256, BK = 64, HALF = 128, HTB = HALF * BK * 2  , STAGE_BYTES = 8 * HTB, NXCD = 8, WGM = 8;

__host__ __device__ __forceinline__ int lds_byte(int r, int c) { const int st = (r >> 4) * 2 + (c >> 5), rr = r & 15, cc = c & 31, ob = rr * 64 + cc * 2; return st * 1024 + (ob ^ (((ob >> 9) & 1) << 5)); }
__host__ __device__ __forceinline__ void stage_rc(int b, int& R, int& C) { const int st = b / 1024, sb = b % 1024, swz = sb ^ (((sb >> 9) & 1) << 5); R = (st >> 1) * 16 + swz / 64; C = (st & 1) * 32 + (swz % 64) / 2; }
__host__ __device__ __forceinline__ int perm32(int rho) { const int n = rho >> 4, i = rho & 15; return 8 * (i >> 2) + 4 * n + (i & 3); }
__device__ __forceinline__ void glds_s(const char* sbase, unsigned voff, unsigned lds_dst) {
    unsigned keep;
    asm volatile("s_mov_b32 %0, m0\n\ts_mov_b32 m0, %1\n\ts_nop 0\n\tglobal_load_lds_dwordx4 %2, %3\n\ts_mov_b32 m0, %0" : "=&s"(keep) : "s"(lds_dst), "v"(voff), "s"(sbase) : "memory");
}
struct Unit { int pa, pb, pr, pc, ak, rp; };
struct Gemm { const bf16_t* A; const bf16_t* Bt; int K, lda, ldb; };

__device__ __forceinline__ void grid_order(int L, int nM, int nN, int& pm, int& pn) {
    const int nwg = nM * nN; int wgid = L;
    { const int q = nwg / NXCD, r = nwg % NXCD, xcd = wgid % NXCD, off = wgid / NXCD; wgid = (xcd < r ? xcd * (q + 1) : r * (q + 1) + (xcd - r) * q) + off; }
    const int nig = WGM * nN, gid = wgid / nig, fm = gid * WGM, gsz = (nM - fm) < WGM ? (nM - fm) : WGM;
    pm = fm + ((wgid % nig) % gsz); pn = (wgid % nig) / gsz;
}
struct GridOrder {
    int nM, nN, G, c, akmul, rep;
    __device__ __forceinline__ bool next(int i, Unit& u) const {
        int L = i * G + c; if (L >= nM * nN * rep) return false; u.rp = L / (nM * nN); L %= nM * nN;
        int pm, pn; grid_order(L, nM, nN, pm, pn);
        u.pa = pm; u.pb = pn; u.pr = pm; u.pc = pn; u.ak = akmul * pn; return true;
    }
    __device__ __forceinline__ void a_ready(const Unit&) const {}
    __device__ __forceinline__ void done(const Unit&) const {}
};
struct QkvOrder {
    int G, c, rep;
    __device__ __forceinline__ bool next(int i, Unit& u) const {
        int L = i * G + c; if (L >= 772 * rep) return false; L %= 772;
        int pm, pn;
        if (L < 768) grid_order(L, 128, 6, pm, pn); else { pm = 128 + ((L - 768) >> 1); pn = 4 + ((L - 768) & 1); }
        u.pa = pm; u.pb = pn; u.pr = pm; u.pc = pn; u.ak = 0; u.rp = 0; return true;
    }
    __device__ __forceinline__ void a_ready(const Unit&) const {}
    __device__ __forceinline__ void done(const Unit&) const {}
};
struct MoeOrder {
    int nM, nN, G, c, lo, a_rel, rep; const int* pexp;
    __device__ __forceinline__ bool next(int i, Unit& u) const {
        int L = i * G + c; if (L >= nM * nN * rep) return false; L %= nM * nN;
        int pm, pn; grid_order(L, nM, nN, pm, pn);
        const int e = __builtin_amdgcn_readfirstlane(pexp[lo + pm]);
        u.pa = a_rel ? pm : lo + pm; u.pb = e * nN + pn; u.pr = a_rel ? lo + pm : pm; u.pc = pn; u.ak = 0; u.rp = 0; return true;
    }
    __device__ __forceinline__ void a_ready(const Unit&) const {}
    __device__ __forceinline__ void done(const Unit&) const {}
};

__device__ __forceinline__ unsigned cvt_pk_bf16(float lo, float hi) { unsigned r; asm volatile("v_cvt_pk_bf16_f32 %0, %1, %2" : "=v"(r) : "v"(lo), "v"(hi)); return r; }
typedef int v8i __attribute__((ext_vector_type(8)));
typedef short s16x16 __attribute__((ext_vector_type(16)));
__device__ __forceinline__ v8i cat8(bf16x8 a, bf16x8 b) { const s16x16 t = __builtin_shufflevector(a, b, 0, 1, 2, 3, 4, 5, 6, 7, 8, 9, 10, 11, 12, 13, 14, 15); return __builtin_bit_cast(v8i, t); }
__device__ __forceinline__ unsigned pk4_fp8(float a, float b, float c, float d) {
    a = __builtin_fminf(__builtin_fmaxf(a, -448.f), 448.f); b = __builtin_fminf(__builtin_fmaxf(b, -448.f), 448.f); c = __builtin_fminf(__builtin_fmaxf(c, -448.f), 448.f); d = __builtin_fminf(__builtin_fmaxf(d, -448.f), 448.f);
    int w = 0; w = __builtin_amdgcn_cvt_pk_fp8_f32(a, b, w, false); w = __builtin_amdgcn_cvt_pk_fp8_f32(c, d, w, true); return (unsigned)w; }
__device__ __forceinline__ float silu_f(float a) { return a * __builtin_amdgcn_rcpf(1.0f + __builtin_amdgcn_exp2f(-1.4426950408889634f * a)); }

struct EpiBf16 {
    static constexpr bool PERM = true, AFTER_DRAIN = false;
    bf16_t* O; int ldc; float sc;
    __device__ __forceinline__ void operator()(const f32x4 (&acc)[2][2][4][2], const Unit& u, int wr, int wc, int fr, int fq) const {
        const int row0 = u.pr * BM + wr * 64 + fr, col0 = u.pc * BM + wc * 32 + 8 * fq;
#pragma unroll
        for (int ai = 0; ai < 2; ++ai)
#pragma unroll
            for (int m = 0; m < 4; ++m) { bf16_t* rowp = O + (size_t)(row0 + ai * HALF + m * 16) * ldc + col0;
#pragma unroll
                for (int bj = 0; bj < 2; ++bj) { const f32x4 v0 = acc[ai][bj][m][0] * sc, v1 = acc[ai][bj][m][1] * sc;
                    u32x4 w; w.x = cvt_pk_bf16(v0[0], v0[1]); w.y = cvt_pk_bf16(v0[2], v0[3]); w.z = cvt_pk_bf16(v1[0], v1[1]); w.w = cvt_pk_bf16(v1[2], v1[3]);
                    *(u32x4*)(rowp + bj * HALF) = w; } }
    }
};
struct EpiQKV {
    static constexpr bool PERM = true, AFTER_DRAIN = false;
    bf16_t* Q; bf16_t* Kb; bf16_t* Vb; float sc;
    __device__ __forceinline__ void operator()(const f32x4 (&acc)[2][2][4][2], const Unit& u, int wr, int wc, int fr, int fq) const {
        bf16_t* base; int ldc;
        if (u.pc < 4) { base = Q + (size_t)u.pr * BM * 1024 + u.pc * BM; ldc = 1024; }
        else { const int krow0 = u.pr < 128 ? (u.pr >> 6) * 16640 + (u.pr & 63) * 256 : (u.pr - 128) * 16640 + 16384; base = (u.pc == 4 ? Kb : Vb) + (size_t)krow0 * 256; ldc = 256; }
        const int row0 = wr * 64 + fr, col0 = wc * 32 + 8 * fq;
#pragma unroll
        for (int ai = 0; ai < 2; ++ai)
#pragma unroll
            for (int m = 0; m < 4; ++m) { bf16_t* rowp = base + (size_t)(row0 + ai * HALF + m * 16) * ldc + col0;
#pragma unroll
                for (int bj = 0; bj < 2; ++bj) { const f32x4 v0 = acc[ai][bj][m][0] * sc, v1 = acc[ai][bj][m][1] * sc;
                    u32x4 w; w.x = cvt_pk_bf16(v0[0], v0[1]); w.y = cvt_pk_bf16(v0[2], v0[3]); w.z = cvt_pk_bf16(v1[0], v1[1]); w.w = cvt_pk_bf16(v1[2], v1[3]);
                    *(u32x4*)(rowp + bj * HALF) = w; } }
    }
};
struct EpiSwiGLU {
    static constexpr bool PERM = true, AFTER_DRAIN = false;
    bf16_t* H; int ldh;
    __device__ __forceinline__ void operator()(const f32x4 (&acc)[2][2][4][2], const Unit& u, int wr, int wc, int fr, int fq) const {
        const int row0 = u.pr * BM + wr * 64 + fr, col0 = u.pc * HALF + wc * 32 + 8 * fq;
#pragma unroll
        for (int ai = 0; ai < 2; ++ai)
#pragma unroll
            for (int m = 0; m < 4; ++m) { bf16_t* rowp = H + (size_t)(row0 + ai * HALF + m * 16) * ldh + col0;
                const f32x4 a0 = acc[ai][0][m][0], a1 = acc[ai][0][m][1], b0 = acc[ai][1][m][0], b1 = acc[ai][1][m][1];
                u32x4 w;
                w.x = cvt_pk_bf16(silu_f(a0[0]) * b0[0], silu_f(a0[1]) * b0[1]); w.y = cvt_pk_bf16(silu_f(a0[2]) * b0[2], silu_f(a0[3]) * b0[3]);
                w.z = cvt_pk_bf16(silu_f(a1[0]) * b1[0], silu_f(a1[1]) * b1[1]); w.w = cvt_pk_bf16(silu_f(a1[2]) * b1[2], silu_f(a1[3]) * b1[3]);
                *(u32x4*)rowp = w; }
    }
};
struct EpiSwiGLU8 {
    static constexpr bool PERM = true, AFTER_DRAIN = false;
    unsigned char* H; int ldh; float sin, sout;
    __device__ __forceinline__ void operator()(const f32x4 (&acc)[2][2][4][2], const Unit& u, int wr, int wc, int fr, int fq) const {
        const int row0 = u.pr * BM + wr * 64 + fr, col0 = u.pc * HALF + wc * 32 + 8 * fq;
#pragma unroll
        for (int ai = 0; ai < 2; ++ai)
#pragma unroll
            for (int m = 0; m < 4; ++m) { unsigned char* rowp = H + (size_t)(row0 + ai * HALF + m * 16) * ldh + col0;
                const f32x4 a0 = acc[ai][0][m][0] * sin, a1 = acc[ai][0][m][1] * sin, b0 = acc[ai][1][m][0] * (sin * sout), b1 = acc[ai][1][m][1] * (sin * sout);
                unsigned long long w = (unsigned long long)pk4_fp8(silu_f(a0[0]) * b0[0], silu_f(a0[1]) * b0[1], silu_f(a0[2]) * b0[2], silu_f(a0[3]) * b0[3])
                                     | ((unsigned long long)pk4_fp8(silu_f(a1[0]) * b1[0], silu_f(a1[1]) * b1[1], silu_f(a1[2]) * b1[2], silu_f(a1[3]) * b1[3]) << 32);
                *(unsigned long long*)rowp = w; }
    }
};
struct EpiResB {
    static constexpr bool PERM = true, AFTER_DRAIN = false;
    const unsigned char* baseX; const float* baseC; bf16_t* outX; float* outC; const float* mods; const float* gate2; int gidx; int base_bf; float sc;
    __device__ __forceinline__ void operator()(const f32x4 (&acc)[2][2][4][2], const Unit& u, int wr, int wc, int fr, int fq) const {
        const int pr = u.pr; const bool isx = pr < 128; const int mi = pr < 64 ? 0 : (pr < 128 ? 1 : 2);
        const float* gv = mods + (mi * 6 + gidx) * 1024;
        const int col0 = u.pc * BM + wc * 32 + 8 * fq;
        f32x4 g[2][2];
#pragma unroll
        for (int bj = 0; bj < 2; ++bj)
#pragma unroll
            for (int n = 0; n < 2; ++n) { g[bj][n] = *(const f32x4*)(gv + col0 + bj * HALF + n * 4) * sc; if (gate2) g[bj][n] = g[bj][n] * *(const f32x4*)(gate2 + col0 + bj * HALF + n * 4); }
        if (isx) {
            const size_t rb = (size_t)pr * BM;
#pragma unroll
            for (int ai = 0; ai < 2; ++ai)
#pragma unroll
                for (int m = 0; m < 4; ++m) { const size_t off = (rb + ai * HALF + wr * 64 + m * 16 + fr) * 1024 + col0;
#pragma unroll
                    for (int bj = 0; bj < 2; ++bj) { f32x4 b0, b1;
                        if (base_bf) { const u32x4 w = *(const u32x4*)((const bf16_t*)baseX + off + bj * HALF);
                            b0 = (f32x4){__builtin_bit_cast(float, w.x << 16), __builtin_bit_cast(float, w.x & 0xffff0000u), __builtin_bit_cast(float, w.y << 16), __builtin_bit_cast(float, w.y & 0xffff0000u)};
                            b1 = (f32x4){__builtin_bit_cast(float, w.z << 16), __builtin_bit_cast(float, w.z & 0xffff0000u), __builtin_bit_cast(float, w.w << 16), __builtin_bit_cast(float, w.w & 0xffff0000u)}; }
                        else { b0 = *(const f32x4*)((const float*)baseX + off + bj * HALF); b1 = *(const f32x4*)((const float*)baseX + off + bj * HALF + 4); }
                        const f32x4 v0 = b0 + g[bj][0] * acc[ai][bj][m][0], v1 = b1 + g[bj][1] * acc[ai][bj][m][1];
                        u32x4 o; o.x = cvt_pk_bf16(v0[0], v0[1]); o.y = cvt_pk_bf16(v0[2], v0[3]); o.z = cvt_pk_bf16(v1[0], v1[1]); o.w = cvt_pk_bf16(v1[2], v1[3]);
                        *(u32x4*)(outX + off + bj * HALF) = o; }
                    if (m & 1) asm volatile("" ::: "memory"); }
        } else {
            const size_t rb = (size_t)(pr - 128) * BM;
#pragma unroll
            for (int ai = 0; ai < 2; ++ai)
#pragma unroll
                for (int m = 0; m < 4; ++m) { const size_t off = (rb + ai * HALF + wr * 64 + m * 16 + fr) * 1024 + col0;
#pragma unroll
                    for (int bj = 0; bj < 2; ++bj)
#pragma unroll
                        for (int n = 0; n < 2; ++n) { const f32x4 bs = *(const f32x4*)(baseC + off + bj * HALF + n * 4); *(f32x4*)(outC + off + bj * HALF + n * 4) = bs + g[bj][n] * acc[ai][bj][m][n]; }
                    if (m & 1) asm volatile("" ::: "memory"); }
        }
    }
};
struct EpiRes {
    static constexpr bool PERM = false, AFTER_DRAIN = false;
    const float* baseX; const float* baseC; float* outX; float* outC; const float* mods; int gidx; const float* gate2; float sc;
    __device__ __forceinline__ void operator()(const f32x4 (&acc)[2][2][4][2], const Unit& u, int wr, int wc, int fr, int fq) const {
        const int pr = u.pr; const bool isx = pr < 128; const int mi = pr < 64 ? 0 : (pr < 128 ? 1 : 2);
        const float* base = isx ? baseX + (size_t)pr * BM * 1024 : baseC + (size_t)(pr - 128) * BM * 1024;
        float* out = isx ? outX + (size_t)pr * BM * 1024 : outC + (size_t)(pr - 128) * BM * 1024;
        const float* gv = mods + (mi * 6 + gidx) * 1024;
        const int col0 = u.pc * BM + wc * 32 + 4 * fq;
        f32x4 g[2][2];
#pragma unroll
        for (int bj = 0; bj < 2; ++bj)
#pragma unroll
            for (int n = 0; n < 2; ++n) { g[bj][n] = *(const f32x4*)(gv + col0 + bj * HALF + n * 16) * sc; if (gate2) g[bj][n] = g[bj][n] * *(const f32x4*)(gate2 + col0 + bj * HALF + n * 16); }
#pragma unroll
        for (int ai = 0; ai < 2; ++ai)
#pragma unroll
            for (int m = 0; m < 4; ++m) { const size_t off = (size_t)(ai * HALF + wr * 64 + m * 16 + fr) * 1024 + col0;
#pragma unroll
                for (int bj = 0; bj < 2; ++bj)
#pragma unroll
                    for (int n = 0; n < 2; ++n) { const f32x4 bs = *(const f32x4*)(base + off + bj * HALF + n * 16); *(f32x4*)(out + off + bj * HALF + n * 16) = bs + g[bj][n] * acc[ai][bj][m][n]; }
                if (m & 1) asm volatile("" ::: "memory"); }
    }
};

__device__ __forceinline__ float row_rstd(const float* ssq, int row, float eps) {
    const f32x4* p = (const f32x4*)(ssq + (size_t)row * 16); const f32x4 a = p[0], b = p[1], c = p[2], d = p[3];
    const float s = (((a[0] + a[1]) + (a[2] + a[3])) + ((b[0] + b[1]) + (b[2] + b[3]))) + (((c[0] + c[1]) + (c[2] + c[3])) + ((d[0] + d[1]) + (d[2] + d[3])));
    return 1.0f / sqrtf(s * (1.0f / 1024.0f) + eps);
}
template <bool FP8A> struct EpiResN {
    static constexpr bool PERM = false, AFTER_DRAIN = false;
    const float* baseX; const float* baseC; float* outX; float* outC; const float* mods; const float* gate2;
    const float* ng; const float* nmods; unsigned char* aout; float* ssq; int gidx, nsc; float sc, a_scale;
    __device__ __forceinline__ void operator()(const f32x4 (&acc)[2][2][4][2], const Unit& u, int wr, int wc, int fr, int fq) const {
        const int pr = u.pr; const bool isx = pr < 128; const int mi = pr < 64 ? 0 : (pr < 128 ? 1 : 2);
        const float* base = isx ? baseX + (size_t)pr * BM * 1024 : baseC + (size_t)(pr - 128) * BM * 1024;
        float* out = isx ? outX + (size_t)pr * BM * 1024 : outC + (size_t)(pr - 128) * BM * 1024;
        const float* gv = mods + (mi * 6 + gidx) * 1024; const float* nsv = nmods + (mi * 6 + nsc) * 1024;
        const int col0 = u.pc * BM + wc * 32 + 4 * fq;
        f32x4 g[2][2], gm[2][2];
#pragma unroll
        for (int bj = 0; bj < 2; ++bj)
#pragma unroll
            for (int n = 0; n < 2; ++n) { g[bj][n] = *(const f32x4*)(gv + col0 + bj * HALF + n * 16) * sc; if (gate2) g[bj][n] = g[bj][n] * *(const f32x4*)(gate2 + col0 + bj * HALF + n * 16);
                gm[bj][n] = *(const f32x4*)(ng + col0 + bj * HALF + n * 16) * (*(const f32x4*)(nsv + col0 + bj * HALF + n * 16) + 1.0f) * a_scale; }
#pragma unroll
        for (int ai = 0; ai < 2; ++ai)
#pragma unroll
            for (int m = 0; m < 4; ++m) { const int rl = ai * HALF + wr * 64 + m * 16 + fr; const size_t off = (size_t)rl * 1024 + col0; const size_t rowg = (size_t)pr * BM + rl; float ss = 0.f;
#pragma unroll
                for (int bj = 0; bj < 2; ++bj)
#pragma unroll
                    for (int n = 0; n < 2; ++n) { const f32x4 bs = *(const f32x4*)(base + off + bj * HALF + n * 16); const f32x4 o = bs + g[bj][n] * acc[ai][bj][m][n]; *(f32x4*)(out + off + bj * HALF + n * 16) = o;
                        ss += (o[0] * o[0] + o[1] * o[1]) + (o[2] * o[2] + o[3] * o[3]); const f32x4 a = o * gm[bj][n];
                        if (FP8A) *(unsigned*)(aout + rowg * 1024 + col0 + bj * HALF + n * 16) = pk4_fp8(a[0], a[1], a[2], a[3]);
                        else { unsigned long long w = (unsigned long long)cvt_pk_bf16(a[0], a[1]) | ((unsigned long long)cvt_pk_bf16(a[2], a[3]) << 32); *(unsigned long long*)(aout + (rowg * 1024 + col0 + bj * HALF + n * 16) * 2) = w; } }
                ss += __shfl_xor(ss, 16); ss += __shfl_xor(ss, 32);
                if (fq == 0) ssq[rowg * 16 + u.pc * 4 + wc] = ss;
                if (m & 1) asm volatile("" ::: "memory"); }
    }
};
struct EpiSwiGLU8N {
    static constexpr bool PERM = true, AFTER_DRAIN = false;
    unsigned char* H; int ldh; float sin, sout; const float* ssq; const float* bias; float eps;
    __device__ __forceinline__ void operator()(const f32x4 (&acc)[2][2][4][2], const Unit& u, int wr, int wc, int fr, int fq) const {
        const int row0 = u.pr * BM + wr * 64 + fr, col0 = u.pc * HALF + wc * 32 + 8 * fq; const int mi = u.pr < 64 ? 0 : (u.pr < 128 ? 1 : 2);
        const float* bp = bias + (size_t)mi * 5632 + u.pc * BM + wc * 32 + 8 * fq;
        const f32x4 b1a = *(const f32x4*)(bp), b1b = *(const f32x4*)(bp + 4), b3a = *(const f32x4*)(bp + HALF), b3b = *(const f32x4*)(bp + HALF + 4);
#pragma unroll
        for (int ai = 0; ai < 2; ++ai)
#pragma unroll
            for (int m = 0; m < 4; ++m) { const int row = row0 + ai * HALF + m * 16; unsigned char* rowp = H + (size_t)row * ldh + col0; const float rs = row_rstd(ssq, row, eps) * sin;
                const f32x4 a0 = acc[ai][0][m][0] * rs + b1a, a1 = acc[ai][0][m][1] * rs + b1b, b0 = (acc[ai][1][m][0] * rs + b3a) * sout, b1 = (acc[ai][1][m][1] * rs + b3b) * sout;
                unsigned long long w = (unsigned long long)pk4_fp8(silu_f(a0[0]) * b0[0], silu_f(a0[1]) * b0[1], silu_f(a0[2]) * b0[2], silu_f(a0[3]) * b0[3])
                                     | ((unsigned long long)pk4_fp8(silu_f(a1[0]) * b1[0], silu_f(a1[1]) * b1[1], silu_f(a1[2]) * b1[2], silu_f(a1[3]) * b1[3]) << 32);
                *(unsigned long long*)rowp = w; }
    }
};
struct EpiQKVN {
    static constexpr bool PERM = true, AFTER_DRAIN = false;
    bf16_t* Q; bf16_t* Kb; bf16_t* Vb; float sc; const float* ssq; const float* bias; float eps;
    __device__ __forceinline__ void operator()(const f32x4 (&acc)[2][2][4][2], const Unit& u, int wr, int wc, int fr, int fq) const {
        bf16_t* base; int ldc; const int mi = u.pr < 64 ? 0 : (u.pr < 128 ? 1 : 2);
        if (u.pc < 4) { base = Q + (size_t)u.pr * BM * 1024 + u.pc * BM; ldc = 1024; }
        else { const int krow0 = u.pr < 128 ? (u.pr >> 6) * 16640 + (u.pr & 63) * 256 : (u.pr - 128) * 16640 + 16384; base = (u.pc == 4 ? Kb : Vb) + (size_t)krow0 * 256; ldc = 256; }
        const int row0 = wr * 64 + fr, col0 = wc * 32 + 8 * fq;
        const float* bp = bias + (size_t)mi * 1536 + u.pc * BM + col0; f32x4 bv[2][2];
#pragma unroll
        for (int bj = 0; bj < 2; ++bj)
#pragma unroll
            for (int n = 0; n < 2; ++n) bv[bj][n] = *(const f32x4*)(bp + bj * HALF + 4 * n);
#pragma unroll
        for (int ai = 0; ai < 2; ++ai)
#pragma unroll
            for (int m = 0; m < 4; ++m) { const int rl = row0 + ai * HALF + m * 16; bf16_t* rowp = base + (size_t)rl * ldc + col0; const float rs = row_rstd(ssq, u.pr * BM + rl, eps) * sc;
#pragma unroll
                for (int bj = 0; bj < 2; ++bj) { const f32x4 v0 = acc[ai][bj][m][0] * rs + bv[bj][0], v1 = acc[ai][bj][m][1] * rs + bv[bj][1];
                    u32x4 w; w.x = cvt_pk_bf16(v0[0], v0[1]); w.y = cvt_pk_bf16(v0[2], v0[3]); w.z = cvt_pk_bf16(v1[0], v1[1]); w.w = cvt_pk_bf16(v1[2], v1[3]);
                    *(u32x4*)(rowp + bj * HALF) = w; } }
    }
};

template <class Epi, class Sched, bool ALIGN_EPI = false, bool SP2 = false, bool FP8 = false>
__device__ __forceinline__ void gemm_phase(PG8_LAS unsigned char* lds, const Gemm g, const Sched& S, const Epi& E, const int wid) {
    const int lane = mk_lane(), tid = wid * 64 + lane, wr = wid >> 2, wc = wid & 3, fr = lane & 15, fq = lane >> 4;
    const int K = g.K, nt = K / BK;
    unsigned voffA[2], voffB[2];
#pragma unroll
    for (int i = 0; i < 2; ++i) { int R, C; stage_rc(tid * 16 + i * 8192, R, C); const int Rb = Epi::PERM ? ((R & ~31) + perm32(R & 31)) : R;
        voffA[i] = (unsigned)(R * g.lda + C) * 2u; voffB[i] = (unsigned)(Rb * g.ldb + C) * 2u; }
    const size_t kstep = (size_t)(BK * 2);
    const size_t hstepA = (size_t)HALF * g.lda * 2, hstepB = (size_t)HALF * g.ldb * 2;
    const size_t tstepA = 2 * hstepA, tstepB = 2 * hstepB;
    const unsigned ldsw = (unsigned)wid * 1024u; const unsigned lds32 = (unsigned)(uintptr_t)lds; const int sc1_ = 0x7f7f7f7f;
    const int aoff = lds_byte(wr * 64 + fr, fq * 8), boff = lds_byte(wc * 32 + fr, fq * 8);
#define PG8_SA(b, h) (((b) * 2 + (h)) * HTB)
#define PG8_SB(b, h) ((4 + (b) * 2 + (h)) * HTB)
#define PG8_STAGE(bufoff, gbase, voff) do { _Pragma("unroll") for (int _i = 0; _i < 2; ++_i) \
        glds_s((const char*)(gbase), (voff)[_i], (unsigned)__builtin_amdgcn_readfirstlane((int)(lds32 + (unsigned)(bufoff) + ldsw + _i * 8192))); } while (0)
#define PG8_LDF(dst, i_, k_, addr_) do { const u32x4 t_ = *(const PG8_LAS u32x4*)(addr_); \
        if constexpr (FP8) { dst##8[i_][4 * (k_)] = (int)t_.x; dst##8[i_][4 * (k_) + 1] = (int)t_.y; dst##8[i_][4 * (k_) + 2] = (int)t_.z; dst##8[i_][4 * (k_) + 3] = (int)t_.w; } \
        else dst[i_][k_] = __builtin_bit_cast(bf16x8, t_); } while (0)
#define PG8_LDA(dst, b, h) do { _Pragma("unroll") for (int m = 0; m < 4; ++m) _Pragma("unroll") for (int k = 0; k < 2; ++k) PG8_LDF(dst, m, k, lds + PG8_SA(b, h) + aoff + m * 2048 + k * 1024); } while (0)
#define PG8_LDB(dst, b, h) do { _Pragma("unroll") for (int n = 0; n < 2; ++n) _Pragma("unroll") for (int k = 0; k < 2; ++k) PG8_LDF(dst, n, k, lds + PG8_SB(b, h) + boff + n * 2048 + k * 1024); } while (0)
#define PG8_MMA(ai, bj, At, Bt) do { __builtin_amdgcn_s_setprio(1); \
        if constexpr (FP8) { _Pragma("unroll") for (int m = 0; m < 4; ++m) _Pragma("unroll") for (int n = 0; n < 2; ++n) \
            asm volatile("v_mfma_scale_f32_16x16x128_f8f6f4 %0, %1, %2, %0, %3, %3 op_sel_hi:[0,0,0]" : "+v"(acc[ai][bj][m][n]) : "v"(Bt##8[n]), "v"(At##8[m]), "v"(sc1_)); } \
        else { _Pragma("unroll") for (int m = 0; m < 4; ++m) _Pragma("unroll") for (int n = 0; n < 2; ++n) _Pragma("unroll") for (int k = 0; k < 2; ++k) \
            acc[ai][bj][m][n] = __builtin_amdgcn_mfma_f32_16x16x32_bf16(Bt[n][k], At[m][k], acc[ai][bj][m][n], 0, 0, 0); } \
        __builtin_amdgcn_s_setprio(0); } while (0)
#define PG8_WAIT_V(n) asm volatile("s_waitcnt vmcnt(" #n ")" ::: "memory")
#define PG8_WAIT_L(n) asm volatile("s_waitcnt lgkmcnt(" #n ")" ::: "memory")
#define PG8_BAR __builtin_amdgcn_s_barrier()
#define PG8_SCHED __builtin_amdgcn_sched_barrier(0)
    Unit cur, nxt; int ui = 0;
    if (!S.next(0, cur)) return;
    f32x4 acc[2][2][4][2];
#pragma unroll
    for (int a = 0; a < 2; ++a)
#pragma unroll
        for (int b = 0; b < 2; ++b)
#pragma unroll
            for (int m = 0; m < 4; ++m)
#pragma unroll
                for (int n = 0; n < 2; ++n) acc[a][b][m][n] = (f32x4){0.f, 0.f, 0.f, 0.f};
    bf16x8 At[4][2], B0[2][2], B1[2][2]; v8i At8[4], B08[2], B18[2];
    const char* cA = (const char*)g.A + (size_t)cur.pa * tstepA + (size_t)cur.ak * 2; const char* cB = (const char*)g.Bt + (size_t)cur.pb * tstepB;
    S.a_ready(cur);
    if constexpr (SP2) {
        PG8_STAGE(PG8_SB(0, 0), cB, voffB); PG8_STAGE(PG8_SB(0, 1), cB + hstepB, voffB); PG8_STAGE(PG8_SA(0, 0), cA, voffA); PG8_STAGE(PG8_SA(0, 1), cA + hstepA, voffA);
        if (wr == 1) PG8_BAR;
        PG8_WAIT_V(2); PG8_BAR;
        PG8_STAGE(PG8_SB(1, 0), cB + kstep, voffB); PG8_STAGE(PG8_SA(1, 0), cA + kstep, voffA); PG8_STAGE(PG8_SB(1, 1), cB + hstepB + kstep, voffB);
        PG8_WAIT_V(6); PG8_BAR;
    } else {
        PG8_STAGE(PG8_SB(0, 0), cB, voffB); PG8_STAGE(PG8_SA(0, 0), cA, voffA); PG8_STAGE(PG8_SB(0, 1), cB + hstepB, voffB); PG8_STAGE(PG8_SA(0, 1), cA + hstepA, voffA);
        if (wr == 1) PG8_BAR;
        PG8_WAIT_V(4); PG8_BAR;
        PG8_STAGE(PG8_SB(1, 0), cB + kstep, voffB); PG8_STAGE(PG8_SA(1, 0), cA + kstep, voffA); PG8_STAGE(PG8_SB(1, 1), cB + hstepB + kstep, voffB);
        PG8_WAIT_V(6); PG8_BAR;
    }
    for (;;) {
        const bool has_next = S.next(ui + 1, nxt);
        const char* nA = has_next ? (const char*)g.A + (size_t)nxt.pa * tstepA + (size_t)nxt.ak * 2 : cA; const char* nB = has_next ? (const char*)g.Bt + (size_t)nxt.pb * tstepB : cB;
        asm volatile(".p2align 6\n\t.rept 2\n\ts_nop 0\n\t.endr");
#pragma nounroll
        for (int t = 0; t < nt; t += 2) {
            const bool last = (t == nt - 2);
            const char* a1 = cA + (size_t)(t + 1) * kstep;
            const char* a2 = last ? nA : cA + (size_t)(t + 2) * kstep; const char* b2 = last ? nB : cB + (size_t)(t + 2) * kstep;
            const char* a3 = a2 + kstep; const char* b3 = b2 + kstep;
            if (last && has_next) S.a_ready(nxt);
            if constexpr (SP2) {
            PG8_LDB(B0, 0, 0); PG8_LDB(B1, 0, 1); PG8_SCHED; PG8_LDA(At, 0, 0); PG8_STAGE(PG8_SA(1, 1), a1 + hstepA, voffA);
            PG8_WAIT_V(8); PG8_WAIT_L(0); PG8_BAR; PG8_MMA(0, 0, At, B0); PG8_MMA(0, 1, At, B1); PG8_BAR; PG8_SCHED;
            PG8_LDA(At, 0, 1); PG8_STAGE(PG8_SB(0, 0), b2, voffB); PG8_STAGE(PG8_SB(0, 1), b2 + hstepB, voffB); PG8_STAGE(PG8_SA(0, 0), a2, voffA);
            PG8_WAIT_V(8); PG8_WAIT_L(0); PG8_BAR; PG8_MMA(1, 0, At, B0); PG8_MMA(1, 1, At, B1); PG8_BAR; PG8_SCHED;
            PG8_LDB(B0, 1, 0); PG8_LDB(B1, 1, 1); PG8_SCHED; PG8_LDA(At, 1, 0); PG8_STAGE(PG8_SA(0, 1), a2 + hstepA, voffA);
            PG8_WAIT_V(8); PG8_WAIT_L(0); PG8_BAR; PG8_MMA(0, 0, At, B0); PG8_MMA(0, 1, At, B1); PG8_BAR; PG8_SCHED;
            PG8_LDA(At, 1, 1); PG8_STAGE(PG8_SB(1, 0), b3, voffB); PG8_STAGE(PG8_SB(1, 1), b3 + hstepB, voffB); PG8_STAGE(PG8_SA(1, 0), a3, voffA);
            PG8_WAIT_V(8); PG8_WAIT_L(0); PG8_BAR; PG8_MMA(1, 0, At, B0); PG8_MMA(1, 1, At, B1); PG8_BAR; PG8_SCHED;
            } else {
            PG8_LDB(B0, 0, 0); PG8_SCHED; PG8_LDA(At, 0, 0); PG8_STAGE(PG8_SA(1, 1), a1 + hstepA, voffA);
            PG8_WAIT_L(8); PG8_BAR; PG8_WAIT_L(0); PG8_MMA(0, 0, At, B0); PG8_BAR; PG8_SCHED;
            PG8_LDB(B1, 0, 1); PG8_STAGE(PG8_SB(0, 0), b2, voffB);
            PG8_BAR; PG8_WAIT_L(0); PG8_MMA(0, 1, At, B1); PG8_BAR;
            PG8_LDA(At, 0, 1); PG8_STAGE(PG8_SA(0, 0), a2, voffA);
            PG8_BAR; PG8_WAIT_L(0); PG8_MMA(1, 0, At, B0); PG8_BAR; PG8_SCHED;
            PG8_STAGE(PG8_SB(0, 1), b2 + hstepB, voffB);
            PG8_WAIT_V(6); PG8_BAR; PG8_MMA(1, 1, At, B1); PG8_BAR;
            PG8_LDB(B0, 1, 0); PG8_SCHED; PG8_LDA(At, 1, 0); PG8_STAGE(PG8_SA(0, 1), a2 + hstepA, voffA);
            PG8_WAIT_L(8); PG8_BAR; PG8_WAIT_L(0); PG8_MMA(0, 0, At, B0); PG8_BAR; PG8_SCHED;
            PG8_LDB(B1, 1, 1); PG8_STAGE(PG8_SB(1, 0), b3, voffB);
            PG8_BAR; PG8_WAIT_L(0); PG8_MMA(0, 1, At, B1); PG8_BAR;
            PG8_LDA(At, 1, 1); PG8_STAGE(PG8_SA(1, 0), a3, voffA);
            PG8_BAR; PG8_WAIT_L(0); PG8_MMA(1, 0, At, B0); PG8_BAR; PG8_SCHED;
            PG8_STAGE(PG8_SB(1, 1), b3 + hstepB, voffB);
            PG8_WAIT_V(6); PG8_BAR; PG8_MMA(1, 1, At, B1); PG8_BAR;
            }
        }
        if constexpr (ALIGN_EPI) { if (wr == 0) PG8_BAR; }
        if constexpr (FP8) asm volatile("s_nop 15\n\ts_nop 15" ::: "memory");
        if constexpr (!Epi::AFTER_DRAIN) { const int l2_ = mk_lane(); E(acc, cur, wid >> 2, wid & 3, l2_ & 15, l2_ >> 4); S.done(cur); }
        if (!has_next) break;
#pragma unroll
        for (int a = 0; a < 2; ++a)
#pragma unroll
            for (int b = 0; b < 2; ++b)
#pragma unroll
                for (int m = 0; m < 4; ++m)
#pragma unroll
                    for (int n = 0; n < 2; ++n) acc[a][b][m][n] = (f32x4){0.f, 0.f, 0.f, 0.f};
        cur = nxt; cA = nA; cB = nB; ++ui;
        if constexpr (ALIGN_EPI) { if (wr == 1) PG8_BAR; }
    }
    PG8_WAIT_V(0);
    if constexpr (!ALIGN_EPI) { if (wr == 0) PG8_BAR; }
    PG8_BAR;
    if constexpr (Epi::AFTER_DRAIN) { E.fused(acc, cur, wr, wc, fr, fq, lds, wid, lane); S.done(cur); }
#undef PG8_SA
#undef PG8_SB
#undef PG8_STAGE
#undef PG8_LDF
#undef PG8_LDA
#undef PG8_LDB
#undef PG8_MMA
#undef PG8_WAIT_V
#undef PG8_WAIT_L
#undef PG8_BAR
#undef PG8_SCHED
}
}

#include <hip/hip_bf16.h>
#include <cmath>
namespace attn_body {
using bf16=__hip_bfloat16;
using bf16x8=__attribute__((ext_vector_type(8)))short;
using s16x4=__attribute__((ext_vector_type(4)))short;
using f32x16=__attribute__((ext_vector_type(16)))float;
using u32x4=__attribute__((ext_vector_type(4)))unsigned;
using v8i_t=__attribute__((ext_vector_type(8)))int;
using f32x4v=__attribute__((ext_vector_type(4)))float;
constexpr float QF8=16.0f,KF8=4.0f,VF8=8.0f; constexpr int QSC8=0x7B7B7B7B,KSC8=0x7D7D7D7D,VSC8=0x7C7C7C7C;
constexpr int BATCH=2,NHEAD=16,SEQ=16384,D=64,DM=NHEAD*D,KVP=256,LKV=16640;
constexpr int NW=8,QBLK=32,QB=QBLK*NW,KVBLK=64,NQB=SEQ/QB;
constexpr int ATTN_PITCH=DM, ATTN_UNIT_ROWS=QB;
__device__ __forceinline__ int crow(int r,int hi){return (r&3)+8*(r>>2)+4*hi;}
#define SBAR() __builtin_amdgcn_sched_barrier(0)
__device__ __forceinline__ void cmask(f32x16&p0,f32x16&p1,int jb,int qrel,int hi){
  const float NEG=-INFINITY; int kb=64*jb+4*hi;
  #pragma unroll
  for(int r=0;r<16;++r){int kv=kb+(r&3)+8*(r>>2); if(kv>qrel)p0[r]=NEG; if(kv+32>qrel)p1[r]=NEG;}
}

constexpr int NSLOT=3, SLOTB=8192;
constexpr int LDS_K=0, LDS_V=NSLOT*SLOTB, LDS_WS=2*NSLOT*SLOTB, LDS_OST=LDS_WS+NW*64*4, LDS_BYTES=LDS_OST+NW*4096;
constexpr float C2=0.125f*1.4426950408889634f;
__device__ __forceinline__ void glds16(const void*gsrc,unsigned lds_dst){unsigned keep;
  asm volatile("s_mov_b32 %0, m0\n\ts_mov_b32 m0, %2\n\ts_nop 0\n\tglobal_load_lds_dwordx4 %1, off\n\ts_mov_b32 m0, %0":"=&s"(keep):"v"(gsrc),"s"(lds_dst):"memory");}
__device__ __forceinline__ float max3f(float a,float b,float c){float r;asm("v_max3_f32 %0, %1, %2, %3":"=v"(r):"v"(a),"v"(b),"v"(c));return r;}
__device__ __forceinline__ float max2f(float a,float b){float r;asm("v_max_f32_e32 %0, %1, %2":"=v"(r):"v"(a),"v"(b));return r;}
__device__ __forceinline__ float fadd_s(float a,float b){float r;asm("v_add_f32_e32 %0, %1, %2":"=v"(r):"v"(a),"v"(b));return r;}
__device__ __forceinline__ float fsub_s(float a,float b){float r;asm("v_sub_f32_e32 %0, %1, %2":"=v"(r):"v"(a),"v"(b));return r;}
typedef float f32x2_t __attribute__((ext_vector_type(2))); typedef __bf16 bf16x2_t __attribute__((ext_vector_type(2)));
__device__ __forceinline__ unsigned cvtpk_s(float lo,float hi){f32x2_t v={lo,hi};bf16x2_t b=__builtin_convertvector(v,bf16x2_t);return __builtin_bit_cast(unsigned,b);}
#define WAIT_BAR(N) asm volatile("s_waitcnt vmcnt(" #N ") lgkmcnt(0)\n\ts_barrier":::"memory")

__device__ __forceinline__ void qkt(f32x16&p0,f32x16&p1,const char*Kslot,const bf16x8*qr,const f32x16&negm,int r32,int hi){
  const char*kb=Kslot+hi*1024+r32*16;
  #pragma unroll
  for(int d0=0;d0<4;++d0){
    const bf16x8 b0=*reinterpret_cast<const bf16x8*>(kb+d0*2048);
    const bf16x8 b1=*reinterpret_cast<const bf16x8*>(kb+d0*2048+512);
    if(d0==0){p0=__builtin_amdgcn_mfma_f32_32x32x16_bf16(b0,qr[0],negm,0,0,0);p1=__builtin_amdgcn_mfma_f32_32x32x16_bf16(b1,qr[0],negm,0,0,0);}
    else{p0=__builtin_amdgcn_mfma_f32_32x32x16_bf16(b0,qr[d0],p0,0,0,0);p1=__builtin_amdgcn_mfma_f32_32x32x16_bf16(b1,qr[d0],p1,0,0,0);}}
}
typedef __attribute__((address_space(3))) const char* lds_cptr;
typedef short v4i16_t __attribute__((ext_vector_type(4)));
__device__ __forceinline__ void kload8(bf16x8*kf,lds_cptr kp){
  kf[0]=*(const __attribute__((address_space(3))) bf16x8*)(kp);      kf[1]=*(const __attribute__((address_space(3))) bf16x8*)(kp+512);
  kf[2]=*(const __attribute__((address_space(3))) bf16x8*)(kp+2048); kf[3]=*(const __attribute__((address_space(3))) bf16x8*)(kp+2560);
  kf[4]=*(const __attribute__((address_space(3))) bf16x8*)(kp+4096); kf[5]=*(const __attribute__((address_space(3))) bf16x8*)(kp+4608);
  kf[6]=*(const __attribute__((address_space(3))) bf16x8*)(kp+6144); kf[7]=*(const __attribute__((address_space(3))) bf16x8*)(kp+6656);
}
__device__ __forceinline__ void kload2(bf16x8*kf,lds_cptr kp,int j){ kf[2*j]=*(const __attribute__((address_space(3))) bf16x8*)(kp+j*2048); kf[2*j+1]=*(const __attribute__((address_space(3))) bf16x8*)(kp+j*2048+512); }
__device__ __forceinline__ s16x4 vtr(lds_cptr p){ return __builtin_bit_cast(s16x4,__builtin_amdgcn_ds_read_tr16_b64_v4i16((__attribute__((address_space(3))) v4i16_t*)p)); }
__device__ __forceinline__ float rowmax(const f32x16&p0,const f32x16&p1){
  float a=max3f(p0[0],p0[1],p1[0]),b=max3f(p0[2],p0[3],p1[1]);a=max3f(a,p1[2],p1[3]);
  #pragma unroll
  for(int r=4;r<16;r+=4){a=max3f(a,p0[r],p0[r+1]);b=max3f(b,p0[r+2],p0[r+3]);a=max3f(a,p1[r],p1[r+1]);b=max3f(b,p1[r+2],p1[r+3]);}
  const float m=max2f(a,b);
  auto rr=__builtin_amdgcn_permlane32_swap(__float_as_uint(m),__float_as_uint(m),false,false);
  return max2f(__uint_as_float(rr[0]),__uint_as_float(rr[1]));
}
__device__ __forceinline__ void pv(f32x16*o,int vb,bf16x8 pa0,bf16x8 pa1,bf16x8 pa2,bf16x8 pa3){
  #pragma unroll
  for(int d0=0;d0<2;++d0){s16x4 lo[4],hi[4];
    #pragma unroll
    for(int ks=0;ks<4;++ks){
      asm volatile("ds_read_b64_tr_b16 %0,%1 offset:%c2":"=&v"(lo[ks]):"v"(vb),"i"(d0*4096+ks*1024):"memory");
      asm volatile("ds_read_b64_tr_b16 %0,%1 offset:%c2":"=&v"(hi[ks]):"v"(vb),"i"(d0*4096+ks*1024+512):"memory");}
    asm volatile("s_waitcnt lgkmcnt(0)":::"memory");SBAR();
    #define PK(k) (bf16x8){lo[k][0],lo[k][1],lo[k][2],lo[k][3],hi[k][0],hi[k][1],hi[k][2],hi[k][3]}
    o[d0]=__builtin_amdgcn_mfma_f32_32x32x16_bf16(pa0,PK(0),o[d0],0,0,0);
    o[d0]=__builtin_amdgcn_mfma_f32_32x32x16_bf16(pa1,PK(1),o[d0],0,0,0);
    o[d0]=__builtin_amdgcn_mfma_f32_32x32x16_bf16(pa2,PK(2),o[d0],0,0,0);
    o[d0]=__builtin_amdgcn_mfma_f32_32x32x16_bf16(pa3,PK(3),o[d0],0,0,0);
    #undef PK
  }
}

#ifndef ATTN_STORE16
#define ATTN_STORE16(p,v) (*(u32x4*)(p)=(v))
#endif
template<int THRL> __device__ __forceinline__ void attn_unit(int wv,int b,int h,int qb,const bf16*Q,const bf16*__restrict__ K,const bf16*__restrict__ V,bf16*O,char*shm){
  const int lane=mk_lane(),r32=lane&31,hi=lane>>5; const int wid=wv;
  const long rowbase=(long)b*SEQ; const long rowk=(long)b*LKV; const int q0=qb*QB;
  const bf16*Qw=Q+(rowbase+q0+wid*QBLK)*DM+h*D;
  const bf16*Kh=K+rowk*KVP+(h>>2)*D,*Vh=V+rowk*KVP+(h>>2)*D;
  const unsigned lds0=(unsigned)(uintptr_t)shm;
  float*wsf=(float*)(shm+LDS_WS)+wid*64;
  const bf16*ksrc=Kh+(long)lane*KVP+wid*8;
  const bf16*vsrc=Vh+(long)(16*(wid&3)+(lane>>2))*KVP+(wid>>2)*32+(lane&3)*8;
  const unsigned kdst=lds0+LDS_K+wid*1024, vdst=lds0+LDS_V+wid*1024;
  #define DMA_K(t,slot) glds16(ksrc+(long)(t)*KVBLK*KVP,(unsigned)__builtin_amdgcn_readfirstlane(kdst+(slot)))
  #define DMA_V(t,slot) glds16(vsrc+(long)(t)*KVBLK*KVP,(unsigned)__builtin_amdgcn_readfirstlane(vdst+(slot)))
  const int vb0=(int)(lds0+LDS_V)+((lane>>4)&1)*32+(lane&3)*8+(4*hi+((lane&15)>>2))*64;
  const char*Kbase=shm+LDS_K; bf16x8 kf[8];
  const lds_cptr shm3=(lds_cptr)shm; const lds_cptr kp0=shm3+LDS_K+hi*1024+r32*16; const lds_cptr vp0=shm3+LDS_V+((lane>>4)&1)*32+(lane&3)*8+(4*hi+((lane&15)>>2))*64;
  constexpr int NT=LKV/KVBLK;
  DMA_K(0,0);DMA_V(0,0);DMA_K(1,SLOTB);
  bf16x8 qr[4];
  #pragma unroll
  for(int d0=0;d0<4;++d0)qr[d0]=*reinterpret_cast<const bf16x8*>(&Qw[(long)r32*DM+d0*16+hi*8]);
  float mhat=0.f,l_reg=0.f;f32x16 o[2];o[0]=f32x16{};o[1]=f32x16{};f32x16 negm=f32x16{};asm volatile("":"+v"(negm));

  #define CMASK(P0,P1,t) do{}while(0)
  bool resc=false;
  #define START(P0,P1) do{ const float rm=rowmax(P0,P1); resc=false; \
    { const float dl=rm; mhat=fadd_s(mhat,dl); \
      _Pragma("unroll") for(int r=0;r<16;++r){P0[r]=fsub_s(P0[r],dl);P1[r]=fsub_s(P1[r],dl);} \
      _Pragma("unroll") for(int r=0;r<16;++r)negm[r]=-mhat; asm volatile("":"+v"(negm)); } \
    _Pragma("unroll") for(int r=0;r<16;++r)P0[r]=__builtin_amdgcn_exp2f(P0[r]); }while(0)
  #define RESC() do{ if(resc){ asm volatile("s_waitcnt lgkmcnt(0)":::"memory"); \
      _Pragma("unroll") for(int d_=0;d_<2;++d_) _Pragma("unroll") for(int r=0;r<16;++r)o[d_][r]*=wsf[crow(r,hi)]; } }while(0)
  f32x16 pA0,pA1,pB0,pB1;
  int sl_prev=0,sl_cur=0,sl_next=SLOTB;
  #define ROT() do{sl_prev=sl_cur;sl_cur=sl_next;sl_next=(sl_next==(NSLOT-1)*SLOTB)?0:sl_next+SLOTB;}while(0)
  DMA_K(2,2*SLOTB);
  WAIT_BAR(3);
  qkt(pA0,pA1,Kbase,qr,negm,r32,hi);asm volatile("s_nop 15\n\ts_nop 7":"+v"(pA0),"+v"(pA1));CMASK(pA0,pA1,0);
  START(pA0,pA1);
  _Pragma("unroll") for(int r=0;r<16;++r)pA1[r]=__builtin_amdgcn_exp2f(pA1[r]);
  WAIT_BAR(0);
  DMA_K(3,0);DMA_V(1,SLOTB);
  ROT();
  kload8(kf,kp0+sl_cur);
  WAIT_BAR(2);
  s16x4 vlo[8],vhi[8]; u32x4 pw0,pw1,pw2,pw3;
  #define PKW(P,B) cvtpk_s(P[B],P[B+1])
  #define PAF(k) __builtin_bit_cast(bf16x8,pw##k)
  #define VFR(i) (bf16x8){vlo[i][0],vlo[i][1],vlo[i][2],vlo[i][3],vhi[i][0],vhi[i][1],vhi[i][2],vhi[i][3]}
  #define PIN(x) asm volatile("":"+v"(x))
  #define MX3(a,b,c) __builtin_fmaxf(__builtin_fmaxf((a),(b)),(c))
  #define GAPA(MF,A0,A1,A2,A3,W0,W1,PW) do{ MF; sacc+=A0; sacc+=A1; sacc+=A2; sacc+=A3; PIN(sacc); W0; W1; PIN(PW); SBAR(); }while(0)
  #define EX(v) __builtin_amdgcn_exp2f(v)
  #define GAPB(MF,X,B) do{ MF; X[B]=EX(X[B]); X[B+1]=EX(X[B+1]); X[B+2]=EX(X[B+2]); X[B+3]=EX(X[B+3]); PIN(X); SBAR(); }while(0)
  #define VRD(i) do{ vlo[i]=vtr(vp_+(((i)>>2)*4096+((i)&3)*1024)); vhi[i]=vtr(vp_+(((i)>>2)*4096+((i)&3)*1024+512)); }while(0)
  #define KRD(G,j) do{ if(G){ kload2(kf,kp0+sl_next,j); SBAR(); } }while(0)
  #define STEP(C0,C1,P0,P1,t,GK,GV,GL) do{ SBAR(); \
    const lds_cptr vp_=vp0+sl_prev; \
    VRD(0); SBAR(); float sacc=(P0[0]+P0[1]); \
    GAPA(C0=__builtin_amdgcn_mfma_f32_32x32x16_bf16(kf[0],qr[0],negm,0,0,0), P0[2],P0[3],P0[4],P0[5],     pw0[0]=PKW(P0,0), pw0[1]=PKW(P0,2), pw0); \
    VRD(4); SBAR(); GAPA(C1=__builtin_amdgcn_mfma_f32_32x32x16_bf16(kf[1],qr[0],negm,0,0,0), P0[6],P0[7],P0[8],P0[9],     pw0[2]=PKW(P0,4), pw0[3]=PKW(P0,6), pw0); \
    VRD(1); SBAR(); GAPA(C0=__builtin_amdgcn_mfma_f32_32x32x16_bf16(kf[2],qr[1],C0,0,0,0),   P0[10],P0[11],P0[12],P0[13], pw1[0]=PKW(P0,8), pw1[1]=PKW(P0,10), pw1); \
    VRD(5); SBAR(); GAPA(C1=__builtin_amdgcn_mfma_f32_32x32x16_bf16(kf[3],qr[1],C1,0,0,0),   P0[14],P0[15],P1[0],P1[1],   pw1[2]=PKW(P0,12),pw1[3]=PKW(P0,14), pw1); \
    VRD(2); SBAR(); GAPA(C0=__builtin_amdgcn_mfma_f32_32x32x16_bf16(kf[4],qr[2],C0,0,0,0),   P1[2],P1[3],P1[4],P1[5],     pw2[0]=PKW(P1,0), pw2[1]=PKW(P1,2), pw2); \
    VRD(6); SBAR(); GAPA(C1=__builtin_amdgcn_mfma_f32_32x32x16_bf16(kf[5],qr[2],C1,0,0,0),   P1[6],P1[7],P1[8],P1[9],     pw2[2]=PKW(P1,4), pw2[3]=PKW(P1,6), pw2); \
    VRD(3); SBAR(); GAPA(C0=__builtin_amdgcn_mfma_f32_32x32x16_bf16(kf[6],qr[3],C0,0,0,0),   P1[10],P1[11],P1[12],P1[13], pw3[0]=PKW(P1,8), pw3[1]=PKW(P1,10), pw3); \
    VRD(7); SBAR(); GAPA(C1=__builtin_amdgcn_mfma_f32_32x32x16_bf16(kf[7],qr[3],C1,0,0,0),   P1[14],P1[15],0.f,0.f,       pw3[2]=PKW(P1,12),pw3[3]=PKW(P1,14), pw3); \
    l_reg+=sacc; \
    if(GK){DMA_K((t)+3,sl_cur);} if(GV){DMA_V((t)+1,sl_next);} \
    CMASK(C0,C1,t); \
    { float a=MX3(C0[0],C0[1],C1[0]),b=MX3(C0[2],C0[3],C1[1]); a=MX3(a,C1[2],C1[3]); \
      _Pragma("unroll") for(int r=4;r<16;r+=4){a=MX3(a,C0[r],C0[r+1]);b=MX3(b,C0[r+2],C0[r+3]);a=MX3(a,C1[r],C1[r+1]);b=MX3(b,C1[r+2],C1[r+3]);} \
      float rm=__builtin_fmaxf(a,b); { auto rr=__builtin_amdgcn_permlane32_swap(__float_as_uint(rm),__float_as_uint(rm),false,false); rm=__builtin_fmaxf(__uint_as_float(rr[0]),__uint_as_float(rr[1])); } \
      resc=false; \
      if(__builtin_expect(__any(rm>(float)THRL),0)){ const float dl=__builtin_fmaxf(rm,0.f); mhat+=dl; \
        _Pragma("unroll") for(int r=0;r<16;++r){C0[r]-=dl;C1[r]-=dl;} \
        _Pragma("unroll") for(int r=0;r<16;++r)negm[r]=-mhat; asm volatile("":"+v"(negm)); \
        const float f=__builtin_amdgcn_exp2f(-dl); l_reg*=f; if(hi==0)wsf[r32]=f; resc=true; } } \
    SBAR(); \
    GAPB(o[0]=__builtin_amdgcn_mfma_f32_32x32x16_bf16(PAF(0),VFR(0),o[0],0,0,0), C0,0); \
    GAPB(o[1]=__builtin_amdgcn_mfma_f32_32x32x16_bf16(PAF(0),VFR(4),o[1],0,0,0), C0,4); \
    KRD(GL,0); GAPB(o[0]=__builtin_amdgcn_mfma_f32_32x32x16_bf16(PAF(1),VFR(1),o[0],0,0,0), C0,8); \
    KRD(GL,1); GAPB(o[1]=__builtin_amdgcn_mfma_f32_32x32x16_bf16(PAF(1),VFR(5),o[1],0,0,0), C0,12); \
    KRD(GL,2); GAPB(o[0]=__builtin_amdgcn_mfma_f32_32x32x16_bf16(PAF(2),VFR(2),o[0],0,0,0), C1,0); \
    KRD(GL,3); GAPB(o[1]=__builtin_amdgcn_mfma_f32_32x32x16_bf16(PAF(2),VFR(6),o[1],0,0,0), C1,4); \
    GAPB(o[0]=__builtin_amdgcn_mfma_f32_32x32x16_bf16(PAF(3),VFR(3),o[0],0,0,0), C1,8); \
    GAPB(o[1]=__builtin_amdgcn_mfma_f32_32x32x16_bf16(PAF(3),VFR(7),o[1],0,0,0), C1,12); \
    }while(0)
  int t=1;
  #undef CMASK
  #define CMASK(P0,P1,t) do{}while(0)
  for(;t+5<NT;t+=2){
    STEP(pB0,pB1,pA0,pA1,t,true,true,true);     WAIT_BAR(2); RESC(); ROT();
    STEP(pA0,pA1,pB0,pB1,t+1,true,true,true);   WAIT_BAR(2); RESC(); ROT();
  }
  #undef CMASK
  #define CMASK(P0,P1,t) do{}while(0)
  #define ENDW(tt) do{ if((tt)+3<NT){WAIT_BAR(2);} else if((tt)+2<NT){WAIT_BAR(1);} else {WAIT_BAR(0);} }while(0)
  for(;t+1<NT;t+=2){
    STEP(pB0,pB1,pA0,pA1,t,(t+3<NT),(t+1<NT),(t+1<NT));       ENDW(t);   RESC(); ROT();
    STEP(pA0,pA1,pB0,pB1,t+1,(t+4<NT),(t+2<NT),(t+2<NT));     ENDW(t+1); RESC(); ROT();
  }
  STEP(pB0,pB1,pA0,pA1,NT-1,false,false,false); RESC();
  { float sacc=pB0[0]+pB0[1]; _Pragma("unroll") for(int r=2;r<16;++r)sacc+=pB0[r]; _Pragma("unroll") for(int r=0;r<16;++r)sacc+=pB1[r]; l_reg+=sacc;
    pw0=(u32x4){PKW(pB0,0),PKW(pB0,2),PKW(pB0,4),PKW(pB0,6)};pw1=(u32x4){PKW(pB0,8),PKW(pB0,10),PKW(pB0,12),PKW(pB0,14)};pw2=(u32x4){PKW(pB1,0),PKW(pB1,2),PKW(pB1,4),PKW(pB1,6)};pw3=(u32x4){PKW(pB1,8),PKW(pB1,10),PKW(pB1,12),PKW(pB1,14)};
    SBAR(); pv(o,vb0+sl_cur,PAF(0),PAF(1),PAF(2),PAF(3)); }
  #undef PKW
  #undef PAF
  #undef VFR
  #undef PIN
  #undef MX3
  #undef GAPA
  #undef GAPB
  #undef EX
  #undef VRD
  #undef KRD
  #undef STEP
  #undef ENDW
  {auto rr=__builtin_amdgcn_permlane32_swap(__float_as_uint(l_reg),__float_as_uint(l_reg),false,false);l_reg=__uint_as_float(rr[0])+__uint_as_float(rr[1]);}
  if(hi==0)wsf[32+r32]=l_reg;asm volatile("s_waitcnt lgkmcnt(0)":::"memory");
  float rli[16];
  #pragma unroll
  for(int r=0;r<16;++r)rli[r]=__builtin_amdgcn_rcpf(wsf[32+crow(r,hi)]);
  bf16*Ow=O+(rowbase+q0+wid*QBLK)*DM+h*D;
  { bf16*stg=(bf16*)(shm+LDS_OST)+wid*2048;
    #pragma unroll
    for(int r=0;r<16;++r){const int orow=crow(r,hi);
      #pragma unroll
      for(int d0=0;d0<2;++d0)stg[orow*64+d0*32+r32]=__float2bfloat16(o[d0][r]*rli[r]);}
    asm volatile("s_waitcnt lgkmcnt(0)":::"memory");
    #pragma unroll
    for(int i=0;i<4;++i){const int row=i*8+(lane>>3),ch=lane&7; const u32x4 v=*(const u32x4*)(stg+row*64+ch*8); ATTN_STORE16(Ow+(long)row*DM+ch*8,v);} }
  asm volatile("s_waitcnt lgkmcnt(0)\n\ts_barrier":::"memory");
  #undef DMA_K
  #undef DMA_V
  #undef CMASK
  #undef START
  #undef RESC
  #undef ROT
}
constexpr int F_LDS_K=0, F_LDS_V=4*SLOTB, F_LDS_OST=8*SLOTB, F_LDS_BYTES=F_LDS_OST+NW*4096;
__device__ __forceinline__ void attn_unit_fast(int wv,int b,int h,int qb,const unsigned char*Q,const unsigned char*__restrict__ K,const unsigned char*__restrict__ VT,bf16*O,char*shm,float cref){
  const int lane=mk_lane(),r32=lane&31,hi=lane>>5; const int wid=wv; const bool kwave=wid<4;
  const long rowbase=(long)b*SEQ; const long rowk=(long)b*LKV; const int q0=qb*QB;
  const unsigned char*Qw=Q+(rowbase+q0+wid*QBLK)*DM+h*D;
  const unsigned char*Kh=K+rowk*KVP+(h>>2)*D;
  const unsigned char*Vh=VT+(long)((b*4+(h>>2))*D)*LKV;
  const unsigned lds0=(unsigned)(uintptr_t)shm;
  const unsigned char*ksrc=Kh+(long)lane*KVP+(wid&3)*16;
  const unsigned char*vsrc=Vh+(long)lane*LKV+(wid&3)*16;
  const unsigned kdst=lds0+F_LDS_K+(wid&3)*1024, vdst=lds0+F_LDS_V+(wid&3)*1024;
  #define SL4(t) (((t)&3)*SLOTB)
  #define DMA_K(t) glds16(ksrc+(long)(t)*KVBLK*KVP,(unsigned)__builtin_amdgcn_readfirstlane(kdst+SL4(t)))
  #define DMA_V(t) glds16(vsrc+(long)(t)*KVBLK,(unsigned)__builtin_amdgcn_readfirstlane(vdst+SL4(t)))
  v8i_t kf0,kf1,vf0,vf1;
  const lds_cptr shm3=(lds_cptr)shm; const lds_cptr kp0=shm3+F_LDS_K+hi*2048+r32*16; const lds_cptr vp0=shm3+F_LDS_V+hi*2048+r32*16;
  constexpr int NT=LKV/KVBLK;
  if(kwave){DMA_K(0);DMA_K(1);DMA_K(2);DMA_K(3);} else {DMA_V(0);DMA_V(1);}
  v8i_t q8; { const u32x4 a_=*reinterpret_cast<const u32x4*>(&Qw[(long)r32*DM+hi*32]),b_=*reinterpret_cast<const u32x4*>(&Qw[(long)r32*DM+hi*32+16]);
    q8=(v8i_t){(int)a_.x,(int)a_.y,(int)a_.z,(int)a_.w,(int)b_.x,(int)b_.y,(int)b_.z,(int)b_.w}; }
  f32x16 o[2];o[0]=f32x16{};o[1]=f32x16{};f32x16 lacc=f32x16{};
  f32x16 negc; { const float nc_=-cref; negc=(f32x16){nc_,nc_,nc_,nc_,nc_,nc_,nc_,nc_,nc_,nc_,nc_,nc_,nc_,nc_,nc_,nc_}; } asm volatile("":"+v"(negc));
  v8i_t ones8; { const int o_=0x38383838; ones8=(v8i_t){o_,o_,o_,o_,o_,o_,o_,o_}; } asm volatile("":"+v"(ones8));
  f32x16 pA0,pA1,pB0,pB1;
  #define KLD8(dst,kp) do{ const u32x4 a_=*(const __attribute__((address_space(3))) u32x4*)(kp),b_=*(const __attribute__((address_space(3))) u32x4*)((kp)+1024); \
    dst=(v8i_t){(int)a_.x,(int)a_.y,(int)a_.z,(int)a_.w,(int)b_.x,(int)b_.y,(int)b_.z,(int)b_.w}; }while(0)
  #define MFQK(a,b) __builtin_amdgcn_mfma_scale_f32_32x32x64_f8f6f4(a,b,negc,0,0,0,KSC8,0,QSC8)
  #define MFPV(p,v,c) __builtin_amdgcn_mfma_scale_f32_32x32x64_f8f6f4(p,v,c,1,0,0,0x7F7F7F7F,0,VSC8)
  #define MFPL(p,c) __builtin_amdgcn_mfma_scale_f32_32x32x64_f8f6f4(p,ones8,c,1,0,0,0x7F7F7F7F,0,0x7F7F7F7F)
  WAIT_BAR(2);
  KLD8(kf0,kp0); KLD8(kf1,kp0+512); pA0=MFQK(kf0,q8); pA1=MFQK(kf1,q8);
  _Pragma("unroll") for(int r=0;r<16;++r){pA0[r]=__builtin_amdgcn_exp2f(pA0[r]);pA1[r]=__builtin_amdgcn_exp2f(pA1[r]);}
  WAIT_BAR(2);
  if(kwave){DMA_K(4);} else {DMA_V(2);}
  WAIT_BAR(2);
  KLD8(kf0,kp0+SL4(1)); KLD8(kf1,kp0+SL4(1)+512);
  v8i_t p8;
  #define PK8(P,B,old,hi_) __builtin_amdgcn_cvt_pk_bf8_f32(P[B],P[B+1],old,hi_)
  #define PIN(x) asm volatile("":"+v"(x))
  #define EX(v) __builtin_amdgcn_exp2f(v)
  #define EXN(X,B,N) do{ _Pragma("unroll") for(int e_=0;e_<(N);++e_) X[(B)+e_]=EX(X[(B)+e_]); PIN(X); }while(0)
  #define UND(w_) asm volatile("":"=v"(w_))
  #define PK4(P,B,d) do{ int w_; UND(w_); w_=PK8(P,B,w_,false); w_=PK8(P,(B)+2,w_,true); p8[d]=w_; }while(0)
  const int sc_one=0x7F7F7F7F, sc_k=KSC8, sc_q=QSC8, sc_v=VSC8;
  #define AQK(C,kf,PT) asm volatile("v_mfma_scale_f32_32x32x64_f8f6f4 %0, %2, %3, %4, %5, %6 op_sel_hi:[0,0,0]" : "=&v"(C), "+v"(PT) : "v"(kf), "v"(q8), "v"(negc), "v"(sc_k), "v"(sc_q))
  #define APV(O,vf,CT) asm volatile("v_mfma_scale_f32_32x32x64_f8f6f4 %0, %2, %3, %0, %4, %5 op_sel_hi:[0,0,0] cbsz:1" : "+v"(O), "+v"(CT) : "v"(p8), "v"(vf), "v"(sc_one), "v"(sc_v))
  #define APL(CT) asm volatile("v_mfma_scale_f32_32x32x64_f8f6f4 %0, %2, %3, %0, %4, %4 op_sel_hi:[0,0,0] cbsz:1" : "+v"(lacc), "+v"(CT) : "v"(p8), "v"(ones8), "v"(sc_one))
  #define STEP(C0,C1,P0,P1,t,GK,GV,GL) do{ SBAR(); \
    AQK(C0,kf0,P0); PK4(P0,0,0); PK4(P0,4,1); PK4(P0,8,2); PK4(P0,12,3); KLD8(vf0,vp0+SL4((t)-1)); PIN(p8); SBAR(); \
    AQK(C1,kf1,P1); PK4(P1,0,4); PK4(P1,4,5); PK4(P1,8,6); PK4(P1,12,7); KLD8(vf1,vp0+SL4((t)-1)+512); PIN(p8); SBAR(); \
    if(kwave){ if(GK){DMA_K((t)+4);} } else { if(GV){DMA_V((t)+2);} } SBAR(); \
    APV(o[0],vf0,C0); EXN(C0,0,8); SBAR(); \
    APV(o[1],vf1,C0); EXN(C0,8,8); if(GL){ KLD8(kf0,kp0+SL4((t)+1)); } SBAR(); \
    APL(C1); EXN(C1,0,8); if(GL){ KLD8(kf1,kp0+SL4((t)+1)+512); } SBAR(); \
    EXN(C1,8,8); SBAR(); \
    }while(0)
  int t=1;
  asm volatile(".p2align 6\n\t.rept 15\n\ts_nop 0\n\t.endr");
  for(;t+5<NT;t+=2){
    STEP(pB0,pB1,pA0,pA1,t,true,true,true);     WAIT_BAR(2);
    STEP(pA0,pA1,pB0,pB1,t+1,true,true,true);   WAIT_BAR(2);
  }
  #define ENDW(i) do{ const int n_=kwave?((((i)+4<NT)?1:0)+(((i)+3<NT)?1:0)):((((i)+2<NT)?1:0)+(((i)+1<NT)?1:0)); if(n_==2){WAIT_BAR(2);} else if(n_==1){WAIT_BAR(1);} else {WAIT_BAR(0);} }while(0)
  for(;t+1<NT;t+=2){
    STEP(pB0,pB1,pA0,pA1,t,(t+4<NT),(t+2<NT),(t+1<NT));       ENDW(t);
    STEP(pA0,pA1,pB0,pB1,t+1,(t+5<NT),(t+3<NT),(t+2<NT));     ENDW(t+1);
  }
  STEP(pB0,pB1,pA0,pA1,NT-1,false,false,false); WAIT_BAR(0);
  { int w_=0; w_=PK8(pB0,0,w_,false); w_=PK8(pB0,2,w_,true); p8[0]=w_; w_=PK8(pB0,4,w_,false); w_=PK8(pB0,6,w_,true); p8[1]=w_; w_=PK8(pB0,8,w_,false); w_=PK8(pB0,10,w_,true); p8[2]=w_; w_=PK8(pB0,12,w_,false); w_=PK8(pB0,14,w_,true); p8[3]=w_;
    w_=PK8(pB1,0,w_,false); w_=PK8(pB1,2,w_,true); p8[4]=w_; w_=PK8(pB1,4,w_,false); w_=PK8(pB1,6,w_,true); p8[5]=w_; w_=PK8(pB1,8,w_,false); w_=PK8(pB1,10,w_,true); p8[6]=w_; w_=PK8(pB1,12,w_,false); w_=PK8(pB1,14,w_,true); p8[7]=w_;
    KLD8(vf0,vp0+SL4(NT-1)); KLD8(vf1,vp0+SL4(NT-1)+512);
    o[0]=MFPV(p8,vf0,o[0]); o[1]=MFPV(p8,vf1,o[1]); lacc=MFPL(p8,lacc); }
  #undef PK8
  #undef PIN
  #undef EX
  #undef EXN
  #undef STEP
  #undef UND
  #undef PK4
  #undef AQK
  #undef APV
  #undef APL
  #undef ENDW
  asm volatile("s_nop 15\n\ts_nop 15":"+v"(o[0]),"+v"(o[1]),"+v"(lacc));
  float rli[16];
  #pragma unroll
  for(int r=0;r<16;++r)rli[r]=__builtin_amdgcn_rcpf(lacc[r]);
  bf16*Ow=O+(rowbase+q0+wid*QBLK)*DM+h*D;
  { bf16*stg=(bf16*)(shm+F_LDS_OST)+wid*2048;
    #pragma unroll
    for(int r=0;r<16;++r){const int orow=crow(r,hi);
      #pragma unroll
      for(int d0=0;d0<2;++d0)stg[orow*64+d0*32+r32]=__float2bfloat16(o[d0][r]*rli[r]);}
    asm volatile("s_waitcnt lgkmcnt(0)":::"memory");
    #pragma unroll
    for(int i=0;i<4;++i){const int row=i*8+(lane>>3),ch=lane&7; const u32x4 v=*(const u32x4*)(stg+row*64+ch*8); ATTN_STORE16(Ow+(long)row*DM+ch*8,v);} }
  asm volatile("s_waitcnt lgkmcnt(0)\n\ts_barrier":::"memory");
  #undef KLD8
  #undef MFQK
  #undef MFPV
  #undef MFPL
  #undef DMA_K
  #undef DMA_V
  #undef SL4
}

constexpr int ATTN_LDS_BYTES=LDS_BYTES;
struct AttnTensors { const bf16* Q; const bf16* K; const bf16* V; bf16* O; const unsigned char* Q8; const unsigned char* K8; const unsigned char* VT8; float cref; };
struct AttnUnit { int bh; int qb; };
struct StaticOrder {
  int vcu, G;
  __device__ __forceinline__ explicit StaticOrder(int grid,int block):vcu((grid%8==0)?(block%8)*(grid/8)+block/8:block),G(grid){}
  __device__ __forceinline__ bool next(int i,AttnUnit&u)const{
    if(G==256){ if(i>=8)return false; const int bkv=vcu>>5,j=vcu&31,un=i*32+j; u.bh=(bkv>>2)*16+(bkv&3)*4+(un>>6); u.qb=un&63; return true; }
    const int un=i*G+vcu; if(un>=BATCH*NHEAD*NQB)return false; u.bh=un/NQB; u.qb=un%NQB; return true; }
  __device__ __forceinline__ void a_ready(const AttnUnit&)const{}
  __device__ __forceinline__ void done(const AttnUnit&)const{}
};
template<class Sched,int THRL=8> __device__ __forceinline__ void attn_phase(char*lds,const AttnTensors&T,const Sched&S,bool fast,int wv){
  AttnUnit u;
  if(fast){ for(int i=0;S.next(i,u);++i){ S.a_ready(u); attn_unit_fast(wv,u.bh/NHEAD,u.bh%NHEAD,u.qb,T.Q8,T.K8,T.VT8,T.O,lds,T.cref); S.done(u); } }
  else{ for(int i=0;S.next(i,u);++i){ S.a_ready(u); attn_unit<THRL>(wv,u.bh/NHEAD,u.bh%NHEAD,u.qb,T.Q,T.K,T.V,T.O,lds); S.done(u); } }
}
#undef SBAR
#undef WAIT_BAR
}
constexpr int NWAVES = 8;
#ifndef MK_REPEAT
#define MK_REPEAT 0
#endif
#ifndef MK_FP8_DENSE
#define MK_FP8_DENSE 1
#endif
#ifndef MK_N_LAUNCHES
#define MK_N_LAUNCHES 1
#endif
constexpr int PER_PHASE = 17;
constexpr int N_LAUNCHES = MK_N_LAUNCHES;

constexpr int D = 1024, LSEQ = 16384, NBATCH = 2, TT = NBATCH * LSEQ, CTXL = 256, NCTX = NBATCH * CTXL, MT = TT + NCTX;
constexpr int FF = 2816, NE = 8, NQKV = 1536, LKV = LSEQ + CTXL;
constexpr int NPX = TT / 256, NPT = MT / 256;
constexpr int CAPP = (2 * TT) / 256 + NE;
constexpr float FP8_SA = 4.0f, FP8_SW = 64.0f, FP8_SH = 4.0f;
constexpr float NORM_EPS = 1e-6f;
constexpr float QSCALE = 0.125f * 1.4426950408889634f;

constexpr size_t MiB = 1u << 20, KiB = 1u << 10;
constexpr size_t WS_CTL = 0, CTL_ZERO_BYTES = 1 * MiB;
constexpr size_t WS_PART = 1 * MiB;
constexpr size_t WS_MODS = 3 * MiB;
constexpr size_t WS_RSTD = 3 * MiB + 256 * KiB;
constexpr size_t WS_ROPE = 3 * MiB + 512 * KiB;
constexpr size_t WS_EID = 3 * MiB + 640 * KiB, WS_GATE = 2 * MiB + 768 * KiB, WS_SLOT = 2 * MiB + 256 * KiB, WS_PEXP = 2 * MiB + 512 * KiB;
constexpr size_t WS_CNTW = 3 * MiB + 896 * KiB;
constexpr size_t WS_CTXB = 4 * MiB;
constexpr size_t WS_W13M = 8 * MiB, WS_W2M = 52 * MiB;
constexpr size_t WS_W13F = 74 * MiB, WS_W2F = 85 * MiB;
constexpr size_t WS_WQKV = 91 * MiB, WS_WO = 94 * MiB, WS_POOL = 96 * MiB;
constexpr size_t WS_XS = 98 * MiB;
constexpr size_t WS_BIG = 230 * MiB;
constexpr size_t WS_Q = WS_BIG, WS_K = WS_BIG + 64 * MiB, WS_V = WS_BIG + 81 * MiB, WS_QN = WS_BIG + 100 * MiB, WS_VT = WS_BIG + 140 * MiB, WS_KN = WS_BIG + 164 * MiB, WS_O = WS_BIG;
constexpr size_t WS_SSQ1 = 412 * MiB, WS_SSQ2 = 415 * MiB, WS_B13 = 418 * MiB, WS_BQ = 418 * MiB + 128 * KiB;
constexpr size_t WS_A1 = WS_XS + 66 * MiB;
constexpr size_t WS_X3B = 419 * MiB;
constexpr size_t WS_END = 483 * MiB;
static_assert(WS_W13M + (size_t)NE * 5632 * 1024 <= WS_W2M && WS_W2M + (size_t)NE * 1024 * 2816 <= WS_W13F && WS_W13F + (size_t)5632 * 1024 * 2 <= WS_W2F && WS_W2F + (size_t)1024 * 2816 * 2 <= WS_WQKV && WS_POOL + 4 * 65536 * 2 <= WS_XS, "ws map 1");
static_assert(WS_XS + (size_t)CAPP * 256 * 1024 * 2 <= WS_BIG && WS_XS + (size_t)TT * 1024 * 4 <= WS_BIG && WS_BIG + (size_t)CAPP * 256 * 2816 <= WS_END && WS_BIG + (size_t)MT * FF * 2 <= WS_END, "ws map 2");
static_assert(WS_K + (size_t)NBATCH * LKV * 256 * 2 <= WS_V && WS_Q + (size_t)TT * 1024 * 2 <= WS_K && WS_V + (size_t)NBATCH * LKV * 256 * 2 <= WS_QN && WS_QN + (size_t)TT * 1024 * 2 <= WS_KN && WS_QN + (size_t)MT * 1024 * 2 <= WS_END && WS_KN + (size_t)NBATCH * LKV * 256 * 2 <= WS_END, "ws map 3");
constexpr int CW_TMO = 0, CW_CODE = 1;
constexpr int CW_BAR = 4096;
constexpr int CW_CNT = 16384, CW_FILL = 16384 + 64 * 8;

constexpr int RING_OFF = 0, RING_BYTES = 131072;
constexpr int LDSCTL_OFF = RING_BYTES, MISC_OFF = LDSCTL_OFF + 320;
constexpr int LDS_BYTES = 147456;
static_assert(MISC_OFF + 128 <= LDS_BYTES, "LDS map");

#define GAS __attribute__((address_space(1)))
#define LAS __attribute__((address_space(3)))
typedef unsigned short bf16;
typedef unsigned v4u __attribute__((ext_vector_type(4)));
typedef float f32x4 __attribute__((ext_vector_type(4)));
typedef short bf16x8 __attribute__((ext_vector_type(8)));
typedef GAS unsigned gu32;
typedef GAS unsigned long long gu64;
#define RLX_AGENT __ATOMIC_RELAXED, __HIP_MEMORY_SCOPE_AGENT
#define LDS_WAIT() asm volatile("s_waitcnt lgkmcnt(0)" ::: "memory")
#define VM_WAIT() asm volatile("s_waitcnt vmcnt(0)" ::: "memory")
__device__ __forceinline__ unsigned long long rt() { return __builtin_amdgcn_s_memrealtime(); }
__device__ __forceinline__ unsigned f2bf(float f) { unsigned u = __builtin_bit_cast(unsigned, f); return (u + 0x7fffu + ((u >> 16) & 1u)) >> 16; }
__device__ __forceinline__ unsigned pk2(float lo, float hi) { return f2bf(lo) | (f2bf(hi) << 16); }

#define XB_TMO      128
#define XB_XCNT(j)  (256  + 64 * (j))
#define XB_XSUB(j)  (1280 + 64 * (j))
#define XB_XGEN(j)  (2304 + 64 * (j))
#define XB_TOP      3328
#define XB_TOPGEN   3392
#define XCD_BAR_WORDS 3456
#define XB_SPIN_CAP (1u << 18)

__device__ __forceinline__ unsigned xb_ld(unsigned* p)              { return __hip_atomic_load(p, __ATOMIC_RELAXED, __HIP_MEMORY_SCOPE_AGENT); }
__device__ __forceinline__ unsigned xb_add(unsigned* p, unsigned v) { return __hip_atomic_fetch_add(p, v, __ATOMIC_RELAXED, __HIP_MEMORY_SCOPE_AGENT); }
__device__ __forceinline__ unsigned xb_xcc_id() { return (unsigned)__builtin_amdgcn_s_getreg((3 << 11) | 20) & 0xFu; }
#define XB_SPIN(cond, bar) do { unsigned _sp = 0; while (cond) { __builtin_amdgcn_s_sleep(1); \
    if ((++_sp & 255u) == 0u) { if (xb_ld(&(bar)[XB_TMO])) break; if (_sp > XB_SPIN_CAP) { atomicAdd(&(bar)[XB_TMO], 1u); break; } } } } while (0)

struct XcdBarrier {
    unsigned* bar; unsigned x; int w;
    volatile LAS unsigned* st;
};

__device__ __forceinline__ XcdBarrier xcd_barrier_post(unsigned* bar, volatile LAS unsigned* st, int wave) {
    XcdBarrier b; b.bar = bar; b.x = xb_xcc_id(); b.st = st; b.w = wave;
    if (b.w == 0 && mk_lane() == 0) (void)xb_add(&bar[XB_XCNT(b.x)], 1u);
    return b;
}
__device__ __forceinline__ void xcd_barrier_complete(unsigned* bar, unsigned x, unsigned& nloc, unsigned& nx) {
    const unsigned G = gridDim.x * gridDim.y * gridDim.z;
    unsigned sum, cnt, mine, sp = 0u;
    for (;;) {
        sum = 0u; cnt = 0u; mine = 0u;
#pragma unroll
        for (unsigned j = 0; j < 16; ++j) { const unsigned c = xb_ld(&bar[XB_XCNT(j)]); sum += c; cnt += (c > 0u) ? 1u : 0u; mine = (j == x) ? c : mine; }
        if (sum == G) break;
        __builtin_amdgcn_s_sleep(1);
        if ((++sp & 255u) == 0u) { if (xb_ld(&bar[XB_TMO])) break; if (sp > XB_SPIN_CAP) { atomicAdd(&bar[XB_TMO], 1u); break; } }
    }
    nloc = mine > 0u ? mine : 1u; nx = cnt > 0u ? cnt : 1u;
}

__device__ __forceinline__ void xcd_barrier(const XcdBarrier& b) {
    asm volatile("s_waitcnt vmcnt(0)" ::: "memory");
    __syncthreads();
    if (b.w == 0 && mk_lane() == 0) {
        unsigned* bar = b.bar;
        __builtin_amdgcn_s_waitcnt(0);
        unsigned nloc = b.st[0], nx = b.st[1];
        if (nloc == 0u) { xcd_barrier_complete(bar, b.x, nloc, nx); b.st[0] = nloc; b.st[1] = nx; }
        const unsigned old = xb_add(&bar[XB_XSUB(b.x)], 1u);
        const unsigned gen = old / nloc;
        if (old + 1u == (gen + 1u) * nloc) {
            __builtin_amdgcn_fence(__ATOMIC_RELEASE, "agent");
            asm volatile("s_waitcnt vmcnt(0)" ::: "memory");
            const unsigned og = xb_add(&bar[XB_TOP], 1u);
            const unsigned tg = og / nx;
            if (og + 1u == (tg + 1u) * nx) xb_add(&bar[XB_TOPGEN], 1u);
            else XB_SPIN(xb_ld(&bar[XB_TOPGEN]) == tg, bar);
            __builtin_amdgcn_fence(__ATOMIC_ACQUIRE, "agent");
            xb_add(&bar[XB_XGEN(b.x)], 1u);
            asm volatile("s_waitcnt vmcnt(0)" ::: "memory");
        } else {
            XB_SPIN(xb_ld(&bar[XB_XGEN(b.x)]) == gen, bar);
            __builtin_amdgcn_fence(__ATOMIC_ACQUIRE, "agent");
            asm volatile("s_waitcnt vmcnt(0)" ::: "memory");
        }
    }
    __syncthreads();
}

struct Frame {
    LAS unsigned char* lds;
    volatile LAS unsigned* MISC;
    gu32* ctl;
    int tid, lane, wave;
    int vcu, G;
    unsigned char* ws;
    const float* in[21]; float* out;
};
__device__ __forceinline__ float wave_sum(float v) {
#pragma unroll
    for (int o = 1; o < 64; o <<= 1) v += __shfl_xor(v, o);
    return v;
}
__device__ __forceinline__ float bf_lo(unsigned w) { return __builtin_bit_cast(float, w << 16); }
__device__ __forceinline__ float bf_hi(unsigned w) { return __builtin_bit_cast(float, w & 0xffff0000u); }
__device__ __forceinline__ float silu_acc(float a) { return a / (1.0f + expf(-a)); }
__device__ __forceinline__ const float* row_src(const float* xs, const float* cs, int r) { return r < TT ? xs + (size_t)r * D : cs + (size_t)(r - TT) * D; }
__device__ __forceinline__ int row_kind(int r) { return r < LSEQ ? 0 : (r < TT ? 1 : 2); }

__device__ __forceinline__ void tr_item(const float* W, int N, int k0, int n0, bf16* WT, int ldt, int drow0, LAS float* scr, int lane) {
#pragma unroll 8
    for (int i = 0; i < 32; ++i) { const int kk = 2 * i + (lane >> 5); scr[kk * 33 + (lane & 31)] = W[(size_t)(k0 + kk) * N + n0 + (lane & 31)]; }
    LDS_WAIT(); asm volatile("" ::: "memory");
    const int c = lane & 7;
#pragma unroll
    for (int j = 0; j < 4; ++j) { const int n = (lane >> 3) + 8 * j; const LAS float* s = scr + (8 * c) * 33 + n;
        v4u o; o.x = pk2(s[0 * 33], s[1 * 33]); o.y = pk2(s[2 * 33], s[3 * 33]); o.z = pk2(s[4 * 33], s[5 * 33]); o.w = pk2(s[6 * 33], s[7 * 33]);
        *(GAS v4u*)(WT + (size_t)(drow0 + n) * ldt + k0 + 8 * c) = o; }
    LDS_WAIT(); asm volatile("" ::: "memory");
}
__device__ __forceinline__ void tr_item8(const float* W, int N, int k0, int n0, unsigned char* WT, int ldt, int drow0, LAS float* scr, int lane) {
#pragma unroll 8
    for (int i = 0; i < 32; ++i) { const int kk = 2 * i + (lane >> 5); scr[kk * 33 + (lane & 31)] = W[(size_t)(k0 + kk) * N + n0 + (lane & 31)] * FP8_SW; }
    LDS_WAIT(); asm volatile("" ::: "memory");
    const int c = lane & 7;
#pragma unroll
    for (int j = 0; j < 4; ++j) { const int n = (lane >> 3) + 8 * j; const LAS float* s = scr + (8 * c) * 33 + n;
        const unsigned long long o = (unsigned long long)pg8::pk4_fp8(s[0 * 33], s[1 * 33], s[2 * 33], s[3 * 33]) | ((unsigned long long)pg8::pk4_fp8(s[4 * 33], s[5 * 33], s[6 * 33], s[7 * 33]) << 32);
        *(GAS unsigned long long*)(WT + (size_t)(drow0 + n) * ldt + k0 + 8 * c) = o; }
    LDS_WAIT(); asm volatile("" ::: "memory");
}
__device__ __forceinline__ void tr_w13(const float* W, bf16* WT, int which, int q, LAS float* scr, int lane) {
    const int kb = q / 88, nb = q % 88, n0 = 32 * nb;
    tr_item(W, FF, 64 * kb, n0, WT, D, (n0 >> 7) * 256 + (n0 & 127) + which * 128, scr, lane);
}
__device__ __forceinline__ void tr_w2(const float* W, bf16* WT, int q, LAS float* scr, int lane) {
    const int kb = q >> 5, nb = q & 31;
    tr_item(W, D, 64 * kb, 32 * nb, WT, FF, 32 * nb, scr, lane);
}

__device__ __forceinline__ void p0_phase(Frame& F) {
    LAS float* scr = (LAS float*)(F.lds + RING_OFF + F.wave * 16384);
    const int gw = F.vcu * NWAVES + F.wave, NGW = F.G * NWAVES;
    static_assert(NWAVES == 8, "adaLN k-splits = the waves of a workgroup");
    for (int task = gw; task < 2 * 96 * 8; task += NGW) {
        const int ks = task & 7, cg = (task >> 3) % 96, layer = task / 768, k0 = ks * 128, col = cg * 64 + F.lane;
        float sa[3][2];
#pragma unroll
        for (int v = 0; v < 3; ++v)
#pragma unroll
            for (int h = 0; h < 2; ++h) { const float* cv = v < 2 ? F.in[1] + v * D : F.in[3]; sa[v][h] = silu_acc(cv[k0 + h * 64 + F.lane]); }
        const float* W = F.in[4] + (size_t)layer * D * 6144 + (size_t)k0 * 6144 + col;
        float a0 = 0.f, a1 = 0.f, a2 = 0.f;
#pragma unroll
        for (int h = 0; h < 2; ++h)
#pragma unroll 8
            for (int kk = 0; kk < 64; ++kk) { const float w = W[(size_t)(h * 64 + kk) * 6144];
                a0 += __shfl(sa[0][h], kk) * w; a1 += __shfl(sa[1][h], kk) * w; a2 += __shfl(sa[2][h], kk) * w; }
        LAS float* red = (LAS float*)(F.lds + RING_OFF);
        red[(ks * 3 + 0) * 64 + F.lane] = a0; red[(ks * 3 + 1) * 64 + F.lane] = a1; red[(ks * 3 + 2) * 64 + F.lane] = a2;
        __syncthreads();
        if (ks < 3) { float sacc = F.in[5][layer * 6144 + col];
#pragma unroll
            for (int q = 0; q < 8; ++q) sacc += red[(q * 3 + ks) * 64 + F.lane];
            ((float*)(F.ws + WS_MODS))[layer * 18432 + ks * 6144 + col] = sacc; }
        __syncthreads();
    }
    constexpr int I_POOL = 4 * 4 * 8, I_13 = 16 * 88, I_2 = 44 * 32, I_QKV = 16 * 48, I_O = 16 * 32;
    constexpr int NITEMS = I_POOL + 2 * I_13 + I_2 + I_QKV + I_O;
    for (int it = gw; it < NITEMS; it += NGW) {
        int r = it;
        if (r < I_POOL) { const int g = r >> 5, q = r & 31; tr_item(F.in[7] + (size_t)g * 65536, 256, 64 * (q >> 3), 32 * (q & 7), (bf16*)(F.ws + WS_POOL) + (size_t)g * 65536, 256, 32 * (q & 7), scr, F.lane); continue; } r -= I_POOL;
        if (r < I_13) { tr_w13(F.in[9], (bf16*)(F.ws + WS_W13F), 0, r, scr, F.lane); continue; } r -= I_13;
        if (r < I_13) { tr_w13(F.in[10], (bf16*)(F.ws + WS_W13F), 1, r, scr, F.lane); continue; } r -= I_13;
        if (r < I_2) { if (MK_FP8_DENSE) { const int kb = r >> 5, nb = r & 31; tr_item8(F.in[11], D, 64 * kb, 32 * nb, F.ws + WS_W2F, FF, 32 * nb, scr, F.lane); } else tr_w2(F.in[11], (bf16*)(F.ws + WS_W2F), r, scr, F.lane); continue; } r -= I_2;
        if (r < I_QKV) { const int kb = r / 48, nb = r % 48; if (MK_FP8_DENSE) tr_item8(F.in[12], NQKV, 64 * kb, 32 * nb, F.ws + WS_WQKV, D, 32 * nb, scr, F.lane); else tr_item(F.in[12], NQKV, 64 * kb, 32 * nb, (bf16*)(F.ws + WS_WQKV), D, 32 * nb, scr, F.lane); continue; } r -= I_QKV;
        { const int kb = r >> 5, nb = r & 31; tr_item(F.in[13], D, 64 * kb, 32 * nb, (bf16*)(F.ws + WS_WO), D, 32 * nb, scr, F.lane); }
    }
    float* RS = (float*)(F.ws + WS_RSTD);
    for (int r = gw; r < MT; r += NGW) {
        const GAS f32x4* xr = (const GAS f32x4*)row_src(F.in[0], F.in[2], r) + F.lane; float s = 0.f;
#pragma unroll
        for (int j = 0; j < 4; ++j) { const f32x4 v = xr[64 * j]; s += (v.x * v.x + v.y * v.y) + (v.z * v.z + v.w * v.w); }
        s = wave_sum(s);
        if (F.lane == 0) RS[r] = 1.0f / sqrtf(s * (1.0f / D) + NORM_EPS);
    }
    { const int gt = (F.vcu * NWAVES + F.wave) * 64 + F.lane;
      if (gt < 4096) { const int pos = gt >> 4, i = gt & 15; const float fr = powf(10000.0f, -(float)i * (1.0f / 16.0f)); const float ang = (float)pos * fr;
          float2* RT = (float2*)(F.ws + WS_ROPE); RT[gt] = make_float2(cosf(ang), sinf(ang)); } }
}
__device__ __forceinline__ void p1_phase(Frame& F) {
    LAS float* scr = (LAS float*)(F.lds + RING_OFF + F.wave * 16384);
    const int gw = F.vcu * NWAVES + F.wave, NGW = F.G * NWAVES;
    { const int gt = gw * 64 + F.lane;
      if (gt < 2 * 3 * 6144) { const int layer = gt / 18432, v = (gt % 18432) / 6144, n = gt % 6144; const float* PART = (const float*)(F.ws + WS_PART);
          float s = F.in[5][layer * 6144 + n];
#pragma unroll
          for (int ks = 0; ks < 8; ++ks) s += PART[(size_t)((layer * 8 + ks) * 3 + v) * 6144 + n];
          ((float*)(F.ws + WS_MODS))[gt] = s; } }
}
__device__ __forceinline__ void moe_weights_phase(Frame& F, int w, int NW, int it_lo, int it_hi) {
    LAS float* scr = (LAS float*)(F.lds + RING_OFF + F.wave * 16384);
    for (int it = it_lo + w; it < it_hi; it += NW) {
        const int e = it / 4224, r = it % 4224, m = r / 1408, q = r % 1408;
        if (m < 2) { const int kb = q / 88, nb = q % 88, n0 = 32 * nb;
            tr_item8((m == 0 ? F.in[17] : F.in[18]) + (size_t)e * D * FF, FF, 64 * kb, n0, F.ws + WS_W13M + (size_t)e * 5632 * D, D, (n0 >> 7) * 256 + (n0 & 127) + m * 128, scr, F.lane); }
        else { const int kb = q >> 5, nb = q & 31; tr_item8(F.in[19] + (size_t)e * FF * D, D, 64 * kb, 32 * nb, F.ws + WS_W2M + (size_t)e * D * FF, FF, 32 * nb, scr, F.lane); }
    }
}
struct RowSpan { int s0, Ls, t0, n; };
__device__ __forceinline__ RowSpan row_span(int gw, int NGW) {
    const int W0 = (NGW * 63) >> 7, Wr = NGW - 2 * W0, Wc0 = Wr >> 1, Wc1 = Wr - Wc0;
    int sq, i, W;
    if (gw < W0) { sq = 0; i = gw; W = W0; } else if (gw < 2 * W0) { sq = 1; i = gw - W0; W = W0; } else if (gw < 2 * W0 + Wc0) { sq = 2; i = gw - 2 * W0; W = Wc0; } else { sq = 3; i = gw - 2 * W0 - Wc0; W = Wc1; }
    RowSpan sp; sp.Ls = sq < 2 ? LSEQ : CTXL; sp.s0 = sq == 0 ? 0 : (sq == 1 ? LSEQ : (sq == 2 ? TT : TT + CTXL));
    const int lo = (int)(((long)i * sp.Ls) / W), hi = (int)(((long)(i + 1) * sp.Ls) / W);
    sp.t0 = lo; sp.n = hi - lo; return sp;
}
__device__ __forceinline__ void p2_pooldiff(Frame& F) {
    const int gw = F.vcu * NWAVES + F.wave, NGW = F.G * NWAVES, lane = F.lane;
    const float* RS = (const float*)(F.ws + WS_RSTD); const float* MODS = (const float*)(F.ws + WS_MODS);
    bf16* Dm = (bf16*)(F.ws + WS_XS);
    const RowSpan sp = row_span(gw, NGW);
    for (int c0 = 0; c0 < sp.n; c0 += 32) {
        const int s0 = sp.s0, Ls = sp.Ls, t0 = sp.t0 + c0, nn = sp.n - c0 < 32 ? sp.n - c0 : 32;
        const int mi = row_kind(s0);
        const GAS f32x4* X0 = (const GAS f32x4*)row_src(F.in[0], F.in[2], s0) + lane;
        f32x4 gm[4];
#pragma unroll
        for (int j = 0; j < 4; ++j) { const f32x4 g = ((const GAS f32x4*)(F.in[6]))[64 * j + lane]; const f32x4 sc = ((const GAS f32x4*)(MODS + (mi * 6 + 1) * D))[64 * j + lane]; gm[j] = g * (sc + 1.0f); }
        int rsv; { int tt = t0 - 9 + lane; tt = tt < 0 ? 0 : (tt >= Ls ? Ls - 1 : tt); rsv = __builtin_bit_cast(int, RS[s0 + tt]); }
#define P2_RS(tt) __builtin_bit_cast(float, __builtin_amdgcn_readlane(rsv, (tt) - (t0 - 9)))
        f32x4 S[4];
#pragma unroll
        for (int j = 0; j < 4; ++j) { const int h = 1 << j; f32x4 acc = {0.f, 0.f, 0.f, 0.f};
#pragma unroll
            for (int k = 0; k < 2 * h; ++k) { const int tt = t0 - h + k; const bool ok = tt >= 0 && tt < Ls; const int tc = ok ? tt : t0; const f32x4 v = X0[(size_t)tc * 256 + 64 * j]; acc = acc + v * (ok ? P2_RS(tc) : 0.f); }
            S[j] = acc; }
        f32x4 n_own[4], n_add[4], n_sub[4];
#pragma unroll
        for (int j = 0; j < 4; ++j) { n_own[j] = X0[(size_t)t0 * 256 + 64 * j]; n_add[j] = n_own[j]; n_sub[j] = n_own[j]; }
        for (int rr = 0; rr < nn; ++rr) {
            const int t = t0 + rr;
            f32x4 c_own[4], c_add[4], c_sub[4];
#pragma unroll
            for (int j = 0; j < 4; ++j) { c_own[j] = n_own[j]; c_add[j] = n_add[j]; c_sub[j] = n_sub[j]; }
            if (rr < nn - 1) {
#pragma unroll
                for (int j = 0; j < 4; ++j) { const int h = 1 << j; const int ta = t + h, tb = t - h;
                    n_own[j] = X0[(size_t)(t + 1) * 256 + 64 * j];
                    n_add[j] = X0[(size_t)(ta < Ls ? ta : t) * 256 + 64 * j]; n_sub[j] = X0[(size_t)(tb >= 0 ? tb : t) * 256 + 64 * j]; } }
            GAS unsigned long long* o8 = (GAS unsigned long long*)(Dm + (size_t)(s0 + t) * D) + lane;
            const float rs = P2_RS(t);
#pragma unroll
            for (int j = 0; j < 4; ++j) { const int h = 1 << j;
                if (rr > 0) { const int ta = t + h - 1, tb = t - h - 1;
                    S[j] = S[j] + c_add[j] * (ta < Ls ? P2_RS(ta) : 0.f) - c_sub[j] * (tb >= 0 ? P2_RS(tb) : 0.f); }
                const int lo = t - h < 0 ? 0 : t - h, hi = t + h > Ls ? Ls : t + h;
                const f32x4 d = (S[j] * (1.0f / (float)(hi - lo)) - c_own[j] * rs) * gm[j];
                o8[64 * j] = (unsigned long long)pk2(d.x, d.y) | ((unsigned long long)pk2(d.z, d.w) << 32); }
        }
#undef P2_RS
    }
}
__device__ __forceinline__ void p2_pooldiff_ring(Frame& F) {
    const int gw = F.vcu * NWAVES + F.wave, NGW = F.G * NWAVES, lane = F.lane;
    const float* RS = (const float*)(F.ws + WS_RSTD); const float* MODS = (const float*)(F.ws + WS_MODS);
    bf16* Dm = (bf16*)(F.ws + WS_XS);
    const int j = gw & 3, h = 1 << j, W = 2 * h;
    const RowSpan sp = row_span(gw >> 2, NGW >> 2);
    const int s0 = sp.s0, Ls = sp.Ls, mi = row_kind(s0);
    LAS f32x4* ring = (LAS f32x4*)(F.lds + RING_OFF + F.wave * 16384) + lane;
    const GAS f32x4* X0 = (const GAS f32x4*)row_src(F.in[0], F.in[2], s0) + lane + 64 * j;
    f32x4 gm; { const f32x4 g = ((const GAS f32x4*)(F.in[6]))[64 * j + lane]; const f32x4 sc = ((const GAS f32x4*)(MODS + (mi * 6 + 1) * D))[64 * j + lane]; gm = g * (sc + 1.0f); }
    for (int c0 = 0; c0 < sp.n; c0 += 96) {
    const int t0 = sp.t0 + c0, n = sp.n - c0 < 96 ? sp.n - c0 : 96;
    const int rb = t0 - 8;
    int rsv0, rsv1; { int tt = rb + lane; tt = tt < 0 ? 0 : (tt >= Ls ? Ls - 1 : tt); rsv0 = __builtin_bit_cast(int, RS[s0 + tt]); tt = rb + 64 + lane; tt = tt < 0 ? 0 : (tt >= Ls ? Ls - 1 : tt); rsv1 = __builtin_bit_cast(int, RS[s0 + tt]); }
#define P2R_RS(r_) __builtin_bit_cast(float, ((r_) - rb) < 64 ? __builtin_amdgcn_readlane(rsv0, ((r_) - rb) & 63) : __builtin_amdgcn_readlane(rsv1, ((r_) - rb) & 63))
#define P2R_LOAD(r_) X0[(size_t)((r_) < 0 ? 0 : ((r_) >= Ls ? Ls - 1 : (r_))) * 256]
#define P2R_SCALE(r_) (((r_) >= 0 && (r_) < Ls) ? P2R_RS(r_) : 0.f)
    f32x4 S = {0.f, 0.f, 0.f, 0.f};
    { f32x4 v[16];
#pragma unroll
      for (int k = 0; k < 16; ++k) if (k < W) v[k] = P2R_LOAD(t0 - h + k);
#pragma unroll
      for (int k = 0; k < 16; ++k) if (k < W) { const int r = t0 - h + k; const f32x4 x = v[k] * P2R_SCALE(r); ring[((r + 64) & (W - 1)) * 64] = x; S = S + x; } }
    f32x4 nx[8];
#pragma unroll
    for (int k = 0; k < 8; ++k) nx[k] = P2R_LOAD(t0 + h + k);
    for (int tb = t0; tb < t0 + n; tb += 8) {
        f32x4 cu[8];
#pragma unroll
        for (int k = 0; k < 8; ++k) cu[k] = nx[k];
        if (tb + 8 < t0 + n) {
#pragma unroll
            for (int k = 0; k < 8; ++k) nx[k] = P2R_LOAD(tb + 8 + h + k); }
#pragma unroll
        for (int k = 0; k < 8; ++k) { const int t = tb + k;
            if (t < t0 + n) {
                const f32x4 own = ring[((t + 64) & (W - 1)) * 64];
                const int lo = t - h < 0 ? 0 : t - h, hi = t + h > Ls ? Ls : t + h;
                const f32x4 d = (S * (1.0f / (float)(hi - lo)) - own) * gm;
                ((GAS unsigned long long*)(Dm + (size_t)(s0 + t) * D) + lane)[64 * j] = (unsigned long long)pk2(d.x, d.y) | ((unsigned long long)pk2(d.z, d.w) << 32);
                const int slot = ((t + h + 64) & (W - 1)) * 64;
                const f32x4 oldv = ring[slot]; const f32x4 newv = cu[k] * P2R_SCALE(t + h);
                S = S + newv - oldv; ring[slot] = newv; } }
    }
    }
#undef P2R_RS
#undef P2R_LOAD
#undef P2R_SCALE
}
__device__ __forceinline__ void bias_dot(const float (&w)[16], const float* shb, int sidx, float* dst, int ld, int nn, int lane) {
#pragma unroll
    for (int kind = 0; kind < 3; ++kind) { const GAS f32x4* sp = (const GAS f32x4*)(shb + (kind * 6 + sidx) * D + 16 * lane); float s = 0.f;
#pragma unroll
        for (int q = 0; q < 4; ++q) { const f32x4 v = sp[q]; s = __builtin_fmaf(v.x, w[4 * q], s); s = __builtin_fmaf(v.y, w[4 * q + 1], s); s = __builtin_fmaf(v.z, w[4 * q + 2], s); s = __builtin_fmaf(v.w, w[4 * q + 3], s); }
        s = wave_sum(s); if (lane == 0) dst[(size_t)kind * ld + nn] = s; }
}
__device__ __forceinline__ void bias_phase(Frame& F) {
    const int gw = F.vcu * NWAVES + F.wave, NGW = F.G * NWAVES, lane = F.lane;
    const float* MODS0 = (const float*)(F.ws + WS_MODS); const float* MODS1 = MODS0 + 3 * 6 * D;
    for (int n = gw; n < 5632; n += NGW) {
        const GAS v4u* src = (const GAS v4u*)((const bf16*)(F.ws + WS_W13F) + (size_t)n * D + 16 * lane); const v4u a = src[0], b = src[1]; float w[16];
        w[0] = bf_lo(a.x); w[1] = bf_hi(a.x); w[2] = bf_lo(a.y); w[3] = bf_hi(a.y); w[4] = bf_lo(a.z); w[5] = bf_hi(a.z); w[6] = bf_lo(a.w); w[7] = bf_hi(a.w);
        w[8] = bf_lo(b.x); w[9] = bf_hi(b.x); w[10] = bf_lo(b.y); w[11] = bf_hi(b.y); w[12] = bf_lo(b.z); w[13] = bf_hi(b.z); w[14] = bf_lo(b.w); w[15] = bf_hi(b.w);
        bias_dot(w, MODS0, 3, (float*)(F.ws + WS_B13), 5632, n, lane);
    }
    for (int n = gw; n < NQKV; n += NGW) {
        const v4u a = *(const GAS v4u*)(F.ws + WS_WQKV + (size_t)n * D + 16 * lane); const float is = 1.0f / FP8_SW; float w[16];
        w[0] = __builtin_amdgcn_cvt_f32_fp8((int)a.x, 0) * is; w[1] = __builtin_amdgcn_cvt_f32_fp8((int)a.x, 1) * is; w[2] = __builtin_amdgcn_cvt_f32_fp8((int)a.x, 2) * is; w[3] = __builtin_amdgcn_cvt_f32_fp8((int)a.x, 3) * is;
        w[4] = __builtin_amdgcn_cvt_f32_fp8((int)a.y, 0) * is; w[5] = __builtin_amdgcn_cvt_f32_fp8((int)a.y, 1) * is; w[6] = __builtin_amdgcn_cvt_f32_fp8((int)a.y, 2) * is; w[7] = __builtin_amdgcn_cvt_f32_fp8((int)a.y, 3) * is;
        w[8] = __builtin_amdgcn_cvt_f32_fp8((int)a.z, 0) * is; w[9] = __builtin_amdgcn_cvt_f32_fp8((int)a.z, 1) * is; w[10] = __builtin_amdgcn_cvt_f32_fp8((int)a.z, 2) * is; w[11] = __builtin_amdgcn_cvt_f32_fp8((int)a.z, 3) * is;
        w[12] = __builtin_amdgcn_cvt_f32_fp8((int)a.w, 0) * is; w[13] = __builtin_amdgcn_cvt_f32_fp8((int)a.w, 1) * is; w[14] = __builtin_amdgcn_cvt_f32_fp8((int)a.w, 2) * is; w[15] = __builtin_amdgcn_cvt_f32_fp8((int)a.w, 3) * is;
        bias_dot(w, MODS1, 0, (float*)(F.ws + WS_BQ), NQKV, n, lane);
    }
}
__device__ __forceinline__ void normmod_phase(Frame& F, const bf16* xs, const float* cs, bf16* HX, const float* ng, const float* mods, int ish, int isc, int nrows, bool fp8out) {
    const int gw = F.vcu * NWAVES + F.wave, NGW = F.G * NWAVES;
#pragma unroll 1
    for (int seg = 0; seg < 3; ++seg) {
        const int lo = seg == 0 ? 0 : (seg == 1 ? LSEQ : TT), hi = seg == 0 ? LSEQ : (seg == 1 ? TT : MT), mi = seg;
        if (lo + gw >= hi) continue;
        f32x4 gm[4], sh[4];
#pragma unroll
        for (int j = 0; j < 4; ++j) { const f32x4 g = ((const GAS f32x4*)ng)[64 * j + F.lane]; const f32x4 sc = ((const GAS f32x4*)(mods + (mi * 6 + isc) * D))[64 * j + F.lane]; gm[j] = g * (sc + 1.0f);
            sh[j] = ((const GAS f32x4*)(mods + (mi * 6 + ish) * D))[64 * j + F.lane]; }
#define NM_ROW(r_) do { float s = 0.f; \
            _Pragma("unroll") for (int j = 0; j < 4; ++j) s += (v[j].x * v[j].x + v[j].y * v[j].y) + (v[j].z * v[j].z + v[j].w * v[j].w); \
            const float rstd = 1.0f / sqrtf(wave_sum(s) * (1.0f / D) + NORM_EPS); \
            GAS unsigned long long* o8 = (GAS unsigned long long*)(HX + (size_t)(r_) * D) + F.lane; \
            _Pragma("unroll") for (int j = 0; j < 4; ++j) { const f32x4 o = v[j] * rstd * gm[j] + sh[j]; \
                if (fp8out) ((GAS unsigned*)((unsigned char*)HX + (size_t)(r_) * D) + F.lane)[64 * j] = pg8::pk4_fp8(o.x * FP8_SA, o.y * FP8_SA, o.z * FP8_SA, o.w * FP8_SA); \
                else o8[64 * j] = (unsigned long long)pk2(o.x, o.y) | ((unsigned long long)pk2(o.z, o.w) << 32); } } while (0)
        if (seg < 2) {
            for (int rb = lo + gw; rb < hi; rb += 8 * NGW) {
                unsigned long long w[8][4];
#pragma unroll
                for (int u = 0; u < 8; ++u) { const int ru = rb + u * NGW < hi ? rb + u * NGW : rb; const GAS unsigned long long* xr = (const GAS unsigned long long*)(xs + (size_t)ru * D) + F.lane;
#pragma unroll
                    for (int j = 0; j < 4; ++j) w[u][j] = xr[64 * j]; }
#pragma unroll
                for (int u = 0; u < 8; ++u) if (rb + u * NGW < hi) { f32x4 v[4];
#pragma unroll
                    for (int j = 0; j < 4; ++j) v[j] = (f32x4){bf_lo((unsigned)w[u][j]), bf_hi((unsigned)w[u][j]), bf_lo((unsigned)(w[u][j] >> 32)), bf_hi((unsigned)(w[u][j] >> 32))};
                    NM_ROW(rb + u * NGW); }
            }
        } else {
            for (int r = lo + gw; r < hi; r += NGW) { f32x4 v[4];
                const GAS f32x4* xr = (const GAS f32x4*)(cs + (size_t)(r - TT) * D) + F.lane;
#pragma unroll
                for (int j = 0; j < 4; ++j) v[j] = xr[64 * j];
                NM_ROW(r); }
        }
#undef NM_ROW
    }
}
__device__ __forceinline__ float dpp_xor1(float v) { return __builtin_bit_cast(float, __builtin_amdgcn_update_dpp(0, __builtin_bit_cast(int, v), 0xB1, 0xF, 0xF, true)); }
__device__ __forceinline__ float dpp_xor2(float v) { return __builtin_bit_cast(float, __builtin_amdgcn_update_dpp(0, __builtin_bit_cast(int, v), 0x4E, 0xF, 0xF, true)); }
__device__ __forceinline__ void qk_norm_rope(float (&v)[16], const f32x4 (&gn)[4], const LAS float2* RT, int qt, int pos, bool rope, float scale) {
    float ss = 0.f;
#pragma unroll
    for (int i = 0; i < 16; ++i) ss += v[i] * v[i];
    ss += dpp_xor1(ss); ss += dpp_xor2(ss);
    const float rstd = 1.0f / sqrtf(ss * (1.0f / 64.0f) + NORM_EPS);
#pragma unroll
    for (int i = 0; i < 16; ++i) v[i] = v[i] * rstd * gn[i >> 2][i & 3];
    const LAS f32x4* rt = (const LAS f32x4*)(RT + pos * 16);
#pragma unroll
    for (int i = 0; i < 16; i += 2) { const f32x4 cs = rt[i >> 1];
        const float p0 = dpp_xor1(v[i]), p1 = dpp_xor1(v[i + 1]);
        const float r0 = v[i] * cs.x + ((qt & 1) ? p0 : -p0) * cs.y, r1 = v[i + 1] * cs.z + ((qt & 1) ? p1 : -p1) * cs.w;
        v[i] = (rope ? r0 : v[i]) * scale; v[i + 1] = (rope ? r1 : v[i + 1]) * scale; }
}
struct QkTask { const GAS v4u* p; GAS v4u* q; GAS v4u* q8; int pos; bool rope, isq; };
__device__ __forceinline__ QkTask qk_task(Frame& F, int task, int qt) {
    constexpr int NQT = TT; QkTask k; const int lane = F.lane;
    if (task < NQT) { const int t = task & (LSEQ - 1); k.pos = qt < 2 ? (t >> 6) : (t & 63); k.rope = true; k.isq = true; k.p = (const GAS v4u*)((bf16*)(F.ws + WS_Q) + (size_t)task * D + 16 * lane); k.q = (GAS v4u*)((bf16*)(F.ws + WS_QN) + (size_t)task * D + 16 * lane); k.q8 = (GAS v4u*)(F.ws + WS_QN + (size_t)task * D + 16 * lane); }
    else { const int kr = (task - NQT) * 4 + (lane >> 4), t = kr % LKV; k.rope = t < LSEQ; const int tc = k.rope ? t : 0; k.pos = qt < 2 ? (tc >> 6) : (tc & 63); k.isq = false; k.p = (const GAS v4u*)((bf16*)(F.ws + WS_K) + (size_t)kr * 256 + 16 * (lane & 15)); k.q = (GAS v4u*)((bf16*)(F.ws + WS_KN) + (size_t)kr * 256 + 16 * (lane & 15)); k.q8 = (GAS v4u*)(F.ws + WS_KN + (size_t)kr * 256 + 16 * (lane & 15)); }
    return k;
}
__device__ __forceinline__ void p9_qknorm(Frame& F, bool fp8out) {
    const int gw = F.vcu * NWAVES + F.wave, NGW = F.G * NWAVES, lane = F.lane;
    LAS float2* RT = (LAS float2*)(F.lds + RING_OFF + 65536);
    { const GAS f32x4* src = (const GAS f32x4*)(F.ws + WS_ROPE); for (int i = F.tid; i < 2048; i += NWAVES * 64) ((LAS f32x4*)RT)[i] = src[i]; }
    __syncthreads();
    const int qt = lane & 3;
    f32x4 gq[4], gk[4];
#pragma unroll
    for (int i = 0; i < 4; ++i) { gq[i] = ((const GAS f32x4*)(F.in[14]))[qt * 4 + i]; gk[i] = ((const GAS f32x4*)(F.in[15]))[qt * 4 + i]; }
    constexpr int NTASK = TT + (NBATCH * LKV) / 4;
    for (int t0 = gw; t0 < NTASK; t0 += 4 * NGW) {
        QkTask tk[4]; v4u w0[4], w1[4];
#pragma unroll
        for (int u = 0; u < 4; ++u) { const int task = t0 + u * NGW; const int tc = task < NTASK ? task : t0; tk[u] = qk_task(F, tc, qt); w0[u] = tk[u].p[0]; w1[u] = tk[u].p[1]; }
#pragma unroll
        for (int u = 0; u < 4; ++u) { if (t0 + u * NGW < NTASK) {
            const QkTask cur = tk[u]; const v4u a = w0[u], b = w1[u]; float v[16];
            v[0] = bf_lo(a.x); v[1] = bf_hi(a.x); v[2] = bf_lo(a.y); v[3] = bf_hi(a.y); v[4] = bf_lo(a.z); v[5] = bf_hi(a.z); v[6] = bf_lo(a.w); v[7] = bf_hi(a.w);
            v[8] = bf_lo(b.x); v[9] = bf_hi(b.x); v[10] = bf_lo(b.y); v[11] = bf_hi(b.y); v[12] = bf_lo(b.z); v[13] = bf_hi(b.z); v[14] = bf_lo(b.w); v[15] = bf_hi(b.w);
            if (cur.isq) qk_norm_rope(v, gq, RT, qt, cur.pos, cur.rope, fp8out ? QSCALE * attn_body::QF8 : QSCALE); else qk_norm_rope(v, gk, RT, qt, cur.pos, cur.rope, fp8out ? attn_body::KF8 : 1.0f);
            if (fp8out) { v4u o8; o8.x = pg8::pk4_fp8(v[0], v[1], v[2], v[3]); o8.y = pg8::pk4_fp8(v[4], v[5], v[6], v[7]); o8.z = pg8::pk4_fp8(v[8], v[9], v[10], v[11]); o8.w = pg8::pk4_fp8(v[12], v[13], v[14], v[15]); cur.q8[0] = o8; }
            else { v4u o0, o1; o0.x = pk2(v[0], v[1]); o0.y = pk2(v[2], v[3]); o0.z = pk2(v[4], v[5]); o0.w = pk2(v[6], v[7]); o1.x = pk2(v[8], v[9]); o1.y = pk2(v[10], v[11]); o1.z = pk2(v[12], v[13]); o1.w = pk2(v[14], v[15]); cur.q[0] = o0; cur.q[1] = o1; } } }
    }
}
__device__ __forceinline__ void p9_vtrans(Frame& F) {
    const int gw = F.vcu * NWAVES + F.wave, NGW = F.G * NWAVES, lane = F.lane;
    LAS unsigned char* scr = F.lds + RING_OFF + F.wave * 8192;
    const int dp = lane & 31, kh = lane >> 5;
    for (int it = 0; it * NGW < NBATCH * 4 * (LKV / 64); ++it) {
        const int task = it * NGW + ((it & 1) ? NGW - 1 - gw : gw); if (task >= NBATCH * 4 * (LKV / 64)) continue;
        const int bk = task / (LKV / 64), tile = task % (LKV / 64), b = bk >> 2, kvh = bk & 3;
        const bf16* src = (const bf16*)(F.ws + WS_V) + ((size_t)(b * LKV + tile * 64)) * 256 + kvh * 64;
#pragma unroll
        for (int i = 0; i < 8; ++i) { const int row = 8 * i + (lane >> 3), ch = lane & 7; const v4u w = *(const GAS v4u*)(src + (size_t)row * 256 + ch * 8); *(LAS v4u*)(scr + row * 128 + ch * 16) = w; }
        LDS_WAIT(); asm volatile("" ::: "memory");
        float lo[32], hi[32];
#pragma unroll
        for (int j = 0; j < 32; ++j) { const int jj = j & 15, key = (jj & 3) + 8 * (jj >> 2) + 4 * kh + 32 * (j >> 4); const unsigned w = *(const LAS unsigned*)(scr + key * 128 + dp * 4); lo[j] = bf_lo(w) * attn_body::VF8; hi[j] = bf_hi(w) * attn_body::VF8; }
        v4u o0, o1, o2, o3;
        o0.x = pg8::pk4_fp8(lo[0], lo[1], lo[2], lo[3]); o0.y = pg8::pk4_fp8(lo[4], lo[5], lo[6], lo[7]); o0.z = pg8::pk4_fp8(lo[8], lo[9], lo[10], lo[11]); o0.w = pg8::pk4_fp8(lo[12], lo[13], lo[14], lo[15]);
        o1.x = pg8::pk4_fp8(lo[16], lo[17], lo[18], lo[19]); o1.y = pg8::pk4_fp8(lo[20], lo[21], lo[22], lo[23]); o1.z = pg8::pk4_fp8(lo[24], lo[25], lo[26], lo[27]); o1.w = pg8::pk4_fp8(lo[28], lo[29], lo[30], lo[31]);
        o2.x = pg8::pk4_fp8(hi[0], hi[1], hi[2], hi[3]); o2.y = pg8::pk4_fp8(hi[4], hi[5], hi[6], hi[7]); o2.z = pg8::pk4_fp8(hi[8], hi[9], hi[10], hi[11]); o2.w = pg8::pk4_fp8(hi[12], hi[13], hi[14], hi[15]);
        o3.x = pg8::pk4_fp8(hi[16], hi[17], hi[18], hi[19]); o3.y = pg8::pk4_fp8(hi[20], hi[21], hi[22], hi[23]); o3.z = pg8::pk4_fp8(hi[24], hi[25], hi[26], hi[27]); o3.w = pg8::pk4_fp8(hi[28], hi[29], hi[30], hi[31]);
        unsigned char* dst = F.ws + WS_VT + ((size_t)(bk * 64 + 2 * dp)) * LKV + tile * 64 + 32 * kh;
        *(GAS v4u*)(dst) = o0; *(GAS v4u*)(dst + 16) = o1; *(GAS v4u*)(dst + LKV) = o2; *(GAS v4u*)(dst + LKV + 16) = o3;
        LDS_WAIT(); asm volatile("" ::: "memory");
    }
}
__device__ __forceinline__ void p12_router(Frame& F) {
    const int gw = F.vcu * NWAVES + F.wave, NGW = F.G * NWAVES, lane = F.lane;
    LAS float* RW = (LAS float*)(F.lds + RING_OFF);
    for (int c = F.tid; c < D; c += NWAVES * 64) { const f32x4 a = ((const GAS f32x4*)(F.in[16]))[2 * c], b = ((const GAS f32x4*)(F.in[16]))[2 * c + 1];
        RW[0 * D + c] = a.x; RW[1 * D + c] = a.y; RW[2 * D + c] = a.z; RW[3 * D + c] = a.w; RW[4 * D + c] = b.x; RW[5 * D + c] = b.y; RW[6 * D + c] = b.z; RW[7 * D + c] = b.w; }
    __syncthreads();
    const float* MODS = (const float*)(F.ws + WS_MODS) + 3 * 6 * D;
    const float* ng = F.in[6] + 3 * D;
    unsigned char* HX = F.ws + WS_BIG; int* EID = (int*)(F.ws + WS_EID); float* GATE = (float*)(F.ws + WS_GATE);
    const bf16* X3B = (const bf16*)(F.ws + WS_X3B);
    int* CNTW = (int*)(F.ws + WS_CNTW);
    const bool b5 = (lane & 32) != 0, b4 = (lane & 16) != 0, b3 = (lane & 8) != 0;
    constexpr int RST = TT / 16; static_assert(RST * 8 == LSEQ, "row interleave");
    for (int task = gw; task < TT / 16; task += NGW) {
        const int r0 = task;
        f32x4 gm[4], sh[4];
        f32x4 vn[4];
#pragma unroll
        for (int j = 0; j < 4; ++j) { const unsigned long long w = ((const GAS unsigned long long*)(X3B + (size_t)r0 * D) + lane)[64 * j]; vn[j] = (f32x4){bf_lo((unsigned)w), bf_hi((unsigned)w), bf_lo((unsigned)(w >> 32)), bf_hi((unsigned)(w >> 32))}; }
        int cnt0 = 0, cnt1 = 0, cnt2 = 0, cnt3 = 0, cnt4 = 0, cnt5 = 0, cnt6 = 0, cnt7 = 0;
        int myeid = 0; float mygate = 0.f;
        for (int rr = 0; rr < 16; ++rr) {
            const int r = r0 + rr * RST;
            if ((rr & 7) == 0) { const int mi = rr >> 3;
#pragma unroll
                for (int j = 0; j < 4; ++j) { const f32x4 g = ((const GAS f32x4*)ng)[64 * j + lane]; const f32x4 sc = ((const GAS f32x4*)(MODS + (mi * 6 + 4) * D))[64 * j + lane]; gm[j] = g * (sc + 1.0f);
                    sh[j] = ((const GAS f32x4*)(MODS + (mi * 6 + 3) * D))[64 * j + lane]; } }
            f32x4 v[4]; float s = 0.f;
#pragma unroll
            for (int j = 0; j < 4; ++j) { v[j] = vn[j]; s += (v[j].x * v[j].x + v[j].y * v[j].y) + (v[j].z * v[j].z + v[j].w * v[j].w); }
            if (rr < 15) {
#pragma unroll
                for (int j = 0; j < 4; ++j) { const unsigned long long w = ((const GAS unsigned long long*)(X3B + (size_t)(r + RST) * D) + lane)[64 * j]; vn[j] = (f32x4){bf_lo((unsigned)w), bf_hi((unsigned)w), bf_lo((unsigned)(w >> 32)), bf_hi((unsigned)(w >> 32))}; } }
            const float rstd = 1.0f / sqrtf(wave_sum(s) * (1.0f / D) + NORM_EPS);
            GAS unsigned* o4 = (GAS unsigned*)(HX + (size_t)r * D) + lane;
            float lg[8];
#pragma unroll
            for (int e = 0; e < 8; ++e) lg[e] = 0.f;
#pragma unroll
            for (int j = 0; j < 4; ++j) { const f32x4 o = v[j] * rstd * gm[j] + sh[j]; o4[64 * j] = pg8::pk4_fp8(o.x * FP8_SA, o.y * FP8_SA, o.z * FP8_SA, o.w * FP8_SA);
#pragma unroll
                for (int e = 0; e < 8; ++e) { const f32x4 w = *(const LAS f32x4*)(RW + e * D + 256 * j + 4 * lane); lg[e] = __builtin_fmaf(o.w, w.w, __builtin_fmaf(o.z, w.z, __builtin_fmaf(o.y, w.y, __builtin_fmaf(o.x, w.x, lg[e])))); } }
            float a4[4], a2[2], a1;
#pragma unroll
            for (int e = 0; e < 4; ++e) { const float send = b5 ? lg[e] : lg[e + 4], keep = b5 ? lg[e + 4] : lg[e]; a4[e] = keep + __shfl_xor(send, 32); }
#pragma unroll
            for (int e = 0; e < 2; ++e) { const float send = b4 ? a4[e] : a4[e + 2], keep = b4 ? a4[e + 2] : a4[e]; a2[e] = keep + __shfl_xor(send, 16); }
            { const float send = b3 ? a2[0] : a2[1], keep = b3 ? a2[1] : a2[0]; a1 = keep + __shfl_xor(send, 8); }
            a1 += __shfl_xor(a1, 4); a1 += __shfl_xor(a1, 2); a1 += __shfl_xor(a1, 1);
            float L[8];
#pragma unroll
            for (int e = 0; e < 8; ++e) L[e] = __builtin_bit_cast(float, __builtin_amdgcn_readlane(__builtin_bit_cast(int, a1), 8 * e));
            int e1 = 0; float l1 = L[0];
#pragma unroll
            for (int e = 1; e < 8; ++e) if (L[e] > l1) { l1 = L[e]; e1 = e; }
            int e2 = -1; float l2 = -INFINITY;
#pragma unroll
            for (int e = 0; e < 8; ++e) if (e != e1 && L[e] > l2) { l2 = L[e]; e2 = e; }
            const float dd = expf(l2 - l1), g1 = 1.0f / (1.0f + dd), g2 = dd / (1.0f + dd);
            if (lane == 2 * rr) { myeid = e1; mygate = g1; }
            if (lane == 2 * rr + 1) { myeid = e2; mygate = g2; }
            cnt0 += (e1 == 0) + (e2 == 0); cnt1 += (e1 == 1) + (e2 == 1); cnt2 += (e1 == 2) + (e2 == 2); cnt3 += (e1 == 3) + (e2 == 3);
            cnt4 += (e1 == 4) + (e2 == 4); cnt5 += (e1 == 5) + (e2 == 5); cnt6 += (e1 == 6) + (e2 == 6); cnt7 += (e1 == 7) + (e2 == 7);
        }
        if (lane < 32) { EID[32 * task + lane] = myeid; GATE[32 * task + lane] = mygate; }
        { const int mine = lane == 0 ? cnt0 : lane == 1 ? cnt1 : lane == 2 ? cnt2 : lane == 3 ? cnt3 : lane == 4 ? cnt4 : lane == 5 ? cnt5 : lane == 6 ? cnt6 : cnt7;
          if (lane < 8) CNTW[task * 8 + lane] = mine; }
    }
    __syncthreads();
}
__device__ __forceinline__ void p13_slots(Frame& F) {
    const int gw = F.vcu * NWAVES + F.wave, NGW = F.G * NWAVES, lane = F.lane;
    constexpr int NTASK = TT / 16;
    const int* CNTW = (const int*)(F.ws + WS_CNTW);
    int* PEXP = (int*)(F.ws + WS_PEXP);
    const int* EID = (const int*)(F.ws + WS_EID); int* SLOT = (int*)(F.ws + WS_SLOT);
    const unsigned char* HX = F.ws + WS_BIG; unsigned char* XS = F.ws + WS_XS;
    for (int task = gw; task < NTASK; task += NGW) {
        int tot[8], pre[8];
#pragma unroll
        for (int e = 0; e < 8; ++e) { tot[e] = 0; pre[e] = 0; }
#pragma unroll 8
        for (int k = 0; k < NTASK / 64; ++k) { const int t = 64 * k + lane; const v4u a = ((const GAS v4u*)CNTW)[2 * t], b = ((const GAS v4u*)CNTW)[2 * t + 1]; const int m = t < task ? -1 : 0;
            tot[0] += (int)a.x; tot[1] += (int)a.y; tot[2] += (int)a.z; tot[3] += (int)a.w; tot[4] += (int)b.x; tot[5] += (int)b.y; tot[6] += (int)b.z; tot[7] += (int)b.w;
            pre[0] += (int)a.x & m; pre[1] += (int)a.y & m; pre[2] += (int)a.z & m; pre[3] += (int)a.w & m; pre[4] += (int)b.x & m; pre[5] += (int)b.y & m; pre[6] += (int)b.z & m; pre[7] += (int)b.w & m; }
#pragma unroll
        for (int e = 0; e < 8; ++e)
#pragma unroll
            for (int o = 1; o < 64; o <<= 1) { tot[e] += __shfl_xor(tot[e], o); pre[e] += __shfl_xor(pre[e], o); }
        int pstart[8], ends[8]; { int run = 0;
#pragma unroll
            for (int e = 0; e < 8; ++e) { pstart[e] = run; run += (tot[e] + 255) & ~255; ends[e] = run; } }
        if (task == 0) {
            for (int p = lane; p < CAPP; p += 64) { int e = 0;
#pragma unroll
                for (int j = 0; j < 8; ++j) e += (ends[j] <= p * 256) ? 1 : 0;
                PEXP[p] = e > 7 ? 7 : e; }
            if (lane == 0) PEXP[512] = ends[7] >> 8; }
        constexpr int RST = TT / 16;
        const int e = lane < 32 ? EID[32 * task + lane] : -1; int slot = 0;
#pragma unroll
        for (int ee = 0; ee < 8; ++ee) { const unsigned long long mask = __ballot(e == ee); if (e == ee) slot = pstart[ee] + pre[ee] + __popcll(mask & ((1ull << lane) - 1ull)); }
        if (lane < 32) SLOT[32 * task + lane] = slot;
#pragma unroll
        for (int g = 0; g < 2; ++g) {
            v4u a[8];
#pragma unroll
            for (int i = 0; i < 8; ++i) a[i] = ((const GAS v4u*)(HX + (size_t)(task + (8 * g + i) * RST) * D))[lane];
#pragma unroll
            for (int i = 0; i < 8; ++i)
#pragma unroll
                for (int k = 0; k < 2; ++k) { const int s = __builtin_amdgcn_readlane(slot, 2 * (8 * g + i) + k); ((GAS v4u*)(XS + (size_t)s * D))[lane] = a[i]; }
        }
    }
}
struct CombRow { unsigned long long x[4], ya[4], yb[4]; };
__device__ __forceinline__ void comb_load(CombRow& R, const bf16* X, const bf16* Y, int r, int s0, int s1, int lane) {
    const GAS unsigned long long* xr = (const GAS unsigned long long*)(X + (size_t)r * D) + lane;
    const GAS unsigned long long* y0 = (const GAS unsigned long long*)(Y + (size_t)s0 * D) + lane; const GAS unsigned long long* y1 = (const GAS unsigned long long*)(Y + (size_t)s1 * D) + lane;
#pragma unroll
    for (int j = 0; j < 4; ++j) { R.x[j] = xr[64 * j]; R.ya[j] = y0[64 * j]; R.yb[j] = y1[64 * j]; }
}
__device__ __forceinline__ void p18_combine(Frame& F) {
    const int gw = F.vcu * NWAVES + F.wave, NGW = F.G * NWAVES, lane = F.lane;
    const float* MODS = (const float*)(F.ws + WS_MODS) + 3 * 6 * D;
    const int* SLOT = (const int*)(F.ws + WS_SLOT); const float* GATE = (const float*)(F.ws + WS_GATE); const bf16* Y = (const bf16*)(F.ws + WS_XS); const bf16* X3B = (const bf16*)(F.ws + WS_X3B);
    constexpr int RST = TT / 16;
    for (int task = gw; task < TT / 16; task += NGW) {
        const int r0 = task;
        const int slotv = lane < 32 ? SLOT[32 * task + lane] : 0; const float gatev = lane < 32 ? GATE[32 * task + lane] : 0.f;
        f32x4 g2[4], fg[4];
#pragma unroll
        for (int j = 0; j < 4; ++j) fg[j] = ((const GAS f32x4*)(F.in[20]))[64 * j + lane];
        CombRow nx; comb_load(nx, X3B, Y, r0, __builtin_amdgcn_readlane(slotv, 0), __builtin_amdgcn_readlane(slotv, 1), lane);
#pragma unroll 2
        for (int rr = 0; rr < 16; ++rr) {
            const int r = r0 + rr * RST; CombRow c = nx;
            if ((rr & 7) == 0) { const int mi = rr >> 3;
#pragma unroll
                for (int j = 0; j < 4; ++j) g2[j] = ((const GAS f32x4*)(MODS + (mi * 6 + 5) * D))[64 * j + lane]; }
            const float ga = __builtin_bit_cast(float, __builtin_amdgcn_readlane(__builtin_bit_cast(int, gatev), 2 * rr)), gb = __builtin_bit_cast(float, __builtin_amdgcn_readlane(__builtin_bit_cast(int, gatev), 2 * rr + 1));
            if (rr < 15) comb_load(nx, X3B, Y, r + RST, __builtin_amdgcn_readlane(slotv, 2 * rr + 2), __builtin_amdgcn_readlane(slotv, 2 * rr + 3), lane);
            f32x4 v[4]; float s = 0.f;
#pragma unroll
            for (int j = 0; j < 4; ++j) { const unsigned long long a = c.ya[j], b = c.yb[j], xw = c.x[j];
                const f32x4 xv = {bf_lo((unsigned)xw), bf_hi((unsigned)xw), bf_lo((unsigned)(xw >> 32)), bf_hi((unsigned)(xw >> 32))};
                const f32x4 ya = {bf_lo((unsigned)a), bf_hi((unsigned)a), bf_lo((unsigned)(a >> 32)), bf_hi((unsigned)(a >> 32))};
                const f32x4 yb = {bf_lo((unsigned)b), bf_hi((unsigned)b), bf_lo((unsigned)(b >> 32)), bf_hi((unsigned)(b >> 32))};
                v[j] = xv + g2[j] * (ya * ga + yb * gb); s += (v[j].x * v[j].x + v[j].y * v[j].y) + (v[j].z * v[j].z + v[j].w * v[j].w); }
            const float rstd = 1.0f / sqrtf(wave_sum(s) * (1.0f / D) + NORM_EPS);
            GAS f32x4* xo = (GAS f32x4*)(F.out + (size_t)r * D) + lane;
#pragma unroll
            for (int j = 0; j < 4; ++j) xo[64 * j] = v[j] * rstd * fg[j];
        }
    }
}

__device__ __forceinline__ bool attn_fast_ok(Frame& F, float& cref) {
    float mq = fabsf(F.in[14][F.lane]), mk = fabsf(F.in[15][F.lane]);
#pragma unroll
    for (int o = 1; o < 64; o <<= 1) { mq = fmaxf(mq, __shfl_xor(mq, o)); mk = fmaxf(mk, __shfl_xor(mk, o)); }
    const float bound = __builtin_bit_cast(float, __builtin_amdgcn_readfirstlane(__builtin_bit_cast(int, 64.0f * mq * mk * QSCALE)));
    cref = bound > 15.0f ? bound - 15.0f : 0.0f;
    return bound < 24.0f;
}
constexpr int MW_N1 = 10000, MW_N2 = MW_N1 + 18792;
__device__ __forceinline__ void tail_convert(Frame& F, int bx, int nunits, int lo, int hi) {
    const int nlong = nunits % F.G;
    if (nlong > 0) { if (bx >= nlong) moe_weights_phase(F, (bx - nlong) * NWAVES + F.wave, (F.G - nlong) * NWAVES, lo, hi); }
    else moe_weights_phase(F, F.vcu * NWAVES + F.wave, F.G * NWAVES, lo, hi);
}
#ifndef MK_SYNTH
#define MK_SYNTH 0
#endif
#if MK_SYNTH
typedef float sy_f16v __attribute__((ext_vector_type(16)));
typedef int sy_i8v __attribute__((ext_vector_type(8)));
typedef unsigned sy_u4v __attribute__((ext_vector_type(4)));
__device__ __forceinline__ void synth_phase(const Frame& F, int nsteps) {
    const int lane = mk_lane();
    sy_i8v kf0, kf1, vf0, vf1, q8, p8, ones8;
    { const int z = 0; kf0 = kf1 = vf0 = vf1 = q8 = p8 = (sy_i8v){z, z, z, z, z, z, z, z}; const int o_ = 0x38383838; ones8 = (sy_i8v){o_, o_, o_, o_, o_, o_, o_, o_}; }
    asm volatile("" : "+v"(kf0), "+v"(kf1), "+v"(vf0), "+v"(vf1), "+v"(q8), "+v"(p8), "+v"(ones8));
    sy_f16v negc, pA0, pA1, pB0, pB1, o0, o1, lacc;
    { const float m = -1.0f; negc = (sy_f16v){m, m, m, m, m, m, m, m, m, m, m, m, m, m, m, m}; pA0 = pA1 = pB0 = pB1 = negc; o0 = o1 = lacc = sy_f16v{}; }
    asm volatile("" : "+v"(negc), "+v"(pA0), "+v"(pA1), "+v"(pB0), "+v"(pB1), "+v"(o0), "+v"(o1), "+v"(lacc));
#if MK_SYNTH & 16
    const int sc = 0x7E7E7E7E;
    { LAS unsigned* l32 = (LAS unsigned*)(F.lds + RING_OFF); for (int i = F.wave * 64 + lane; i < 12288; i += NWAVES * 64) { unsigned h = (unsigned)i * 2654435761u; h ^= h >> 15; h *= 2246822519u; h ^= h >> 13; l32[i] = h & 0xBFBFBFBFu; }
      unsigned h = (unsigned)(lane + 77) * 2654435761u; h ^= h >> 15; h *= 2246822519u; h ^= h >> 13;
      _Pragma("unroll") for (int j = 0; j < 8; ++j) { h = h * 1664525u + 1013904223u; q8[j] = (int)((h ^ (h >> 11)) & 0xBFBFBFBFu); h = h * 1664525u + 1013904223u; kf0[j] = (int)((h ^ (h >> 11)) & 0xBFBFBFBFu);
        h = h * 1664525u + 1013904223u; kf1[j] = (int)((h ^ (h >> 11)) & 0xBFBFBFBFu); h = h * 1664525u + 1013904223u; vf0[j] = (int)((h ^ (h >> 11)) & 0xBFBFBFBFu); h = h * 1664525u + 1013904223u; vf1[j] = (int)((h ^ (h >> 11)) & 0xBFBFBFBFu); }
      _Pragma("unroll") for (int j = 0; j < 8; ++j) { h = h * 1664525u + 1013904223u; p8[j] = (int)((h ^ (h >> 11)) & 0xBFBFBFBFu); }
      asm volatile("" : "+v"(q8), "+v"(kf0), "+v"(kf1), "+v"(vf0), "+v"(vf1), "+v"(p8)); __syncthreads(); }
#else
    const int sc = 0x7F7F7F7F;
#endif
    LAS const unsigned char* lp = F.lds + RING_OFF + (lane & 31) * 16 + (lane >> 5) * 2048;
#define SY_SB() __builtin_amdgcn_sched_barrier(0)
#define SY_PIN(x) asm volatile("" : "+v"(x))
#if (MK_SYNTH & 33) == 33
    typedef float sy_f4v __attribute__((ext_vector_type(4)));
    sy_f4v t0, t1, t2, t3, t4, t5, t6, t7, t8, t9, nc4; { const float m = -1.0f; nc4 = (sy_f4v){m, m, m, m}; t0 = t1 = t2 = t3 = t4 = t5 = t6 = t7 = t8 = t9 = sy_f4v{}; }
    asm volatile("" : "+v"(nc4), "+v"(t0), "+v"(t1), "+v"(t2), "+v"(t3), "+v"(t4), "+v"(t5), "+v"(t6), "+v"(t7), "+v"(t8), "+v"(t9));
#define SY_M16(Dd, A, B, Cc) asm volatile("v_mfma_scale_f32_16x16x128_f8f6f4 %0, %1, %2, %3, %4, %4 op_sel_hi:[0,0,0]" : "=&v"(Dd) : "v"(A), "v"(B), "v"(Cc), "v"(sc))
#define SY_M16A(Dd, A, B) asm volatile("v_mfma_scale_f32_16x16x128_f8f6f4 %0, %1, %2, %0, %3, %3 op_sel_hi:[0,0,0] cbsz:1" : "+v"(Dd) : "v"(A), "v"(B), "v"(sc))
#define SY_AQK(C, kf, PT) do { if (&C == &pB0 || &C == &pA0) { SY_M16(t0, kf, q8, nc4); SY_M16(t1, q8, kf, nc4); } else { SY_M16(t2, kf, q8, nc4); SY_M16(t3, q8, kf, nc4); } } while (0)
#define SY_APV(O, vf, CT) do { if (&O == &o0) { SY_M16A(t4, p8, vf); SY_M16A(t5, vf, p8); } else if (&O == &o1) { SY_M16A(t6, p8, vf); SY_M16A(t7, vf, p8); } else { SY_M16A(t8, p8, vf); SY_M16A(t9, vf, p8); } } while (0)
#define SY_KEEP() asm volatile("" : "+v"(t0), "+v"(t1), "+v"(t2), "+v"(t3))
#elif MK_SYNTH & 1
#define SY_KEEP() do { } while (0)
#define SY_AQK(C, kf, PT) asm volatile("v_mfma_scale_f32_32x32x64_f8f6f4 %0, %2, %3, %4, %5, %5 op_sel_hi:[0,0,0]" : "=&v"(C), "+v"(PT) : "v"(kf), "v"(q8), "v"(negc), "v"(sc))
#define SY_APV(O, vf, CT) asm volatile("v_mfma_scale_f32_32x32x64_f8f6f4 %0, %2, %3, %0, %4, %4 op_sel_hi:[0,0,0] cbsz:1" : "+v"(O), "+v"(CT) : "v"(p8), "v"(vf), "v"(sc))
#else
#define SY_KEEP() do { } while (0)
#define SY_AQK(C, kf, PT) asm volatile("" : "+v"(C), "+v"(PT) : "v"(kf), "v"(q8), "v"(negc), "v"(sc))
#define SY_APV(O, vf, CT) asm volatile("" : "+v"(O), "+v"(CT) : "v"(p8), "v"(vf), "v"(sc))
#endif
#if MK_SYNTH & 2
#define SY_PK4(P, B, d) do { int w_; asm volatile("" : "=v"(w_)); w_ = __builtin_amdgcn_cvt_pk_bf8_f32(P[B], P[(B) + 1], w_, false); w_ = __builtin_amdgcn_cvt_pk_bf8_f32(P[(B) + 2], P[(B) + 3], w_, true); p8[d] = w_; } while (0)
#define SY_EXN(X, B) do { _Pragma("unroll") for (int e_ = 0; e_ < 8; ++e_) X[(B) + e_] = __builtin_amdgcn_exp2f(X[(B) + e_]); SY_PIN(X); } while (0)
#else
#define SY_PK4(P, B, d) do { } while (0)
#define SY_EXN(X, B) do { } while (0)
#endif
#if MK_SYNTH & 4
#define SY_KLD(dst, kp) do { const sy_u4v a_ = *(LAS const sy_u4v*)(kp), b_ = *(LAS const sy_u4v*)((kp) + 1024); dst = (sy_i8v){(int)a_.x, (int)a_.y, (int)a_.z, (int)a_.w, (int)b_.x, (int)b_.y, (int)b_.z, (int)b_.w}; } while (0)
#else
#define SY_KLD(dst, kp) do { } while (0)
#endif
#if MK_SYNTH & 8
#define SY_BAR() asm volatile("s_waitcnt vmcnt(0) lgkmcnt(0)\n\ts_barrier" ::: "memory")
#else
#define SY_BAR() do { } while (0)
#endif
#define SY_STEP(C0, C1, P0, P1) do { SY_SB(); \
    SY_AQK(C0, kf0, P0); SY_PK4(P0, 0, 0); SY_PK4(P0, 4, 1); SY_PK4(P0, 8, 2); SY_PK4(P0, 12, 3); SY_KLD(vf0, lp + 32768); SY_PIN(p8); SY_SB(); \
    SY_AQK(C1, kf1, P1); SY_PK4(P1, 0, 4); SY_PK4(P1, 4, 5); SY_PK4(P1, 8, 6); SY_PK4(P1, 12, 7); SY_KLD(vf1, lp + 32768 + 512); SY_PIN(p8); SY_SB(); \
    SY_APV(o0, vf0, C0); SY_EXN(C0, 0); SY_SB(); \
    SY_APV(o1, vf1, C0); SY_EXN(C0, 8); SY_KLD(kf0, lp); SY_SB(); \
    SY_APV(lacc, ones8, C1); SY_EXN(C1, 0); SY_KLD(kf1, lp + 512); SY_SB(); \
    SY_EXN(C1, 8); SY_SB(); } while (0)
#pragma nounroll
    for (int t = 0; t < nsteps; t += 2) {
        SY_STEP(pB0, pB1, pA0, pA1); SY_KEEP(); SY_BAR();
        SY_STEP(pA0, pA1, pB0, pB1); SY_KEEP(); SY_BAR();
    }
    asm volatile("s_nop 15\n\ts_nop 15" : "+v"(o0), "+v"(o1), "+v"(lacc), "+v"(pA0), "+v"(pA1), "+v"(pB0), "+v"(pB1));
#if (MK_SYNTH & 33) == 33
    asm volatile("" : "+v"(t0), "+v"(t1), "+v"(t2), "+v"(t3), "+v"(t4), "+v"(t5), "+v"(t6), "+v"(t7), "+v"(t8), "+v"(t9));
#endif
}
#endif
struct Args { const float* in[21]; float* out; unsigned char* ws; int ph_lo, ph_hi; };
__global__ void __launch_bounds__(NWAVES * 64, 2) mk_fwd(Args args) {
    extern __shared__ __attribute__((aligned(16))) unsigned char lds[];
    Frame F;
    F.lds = (LAS unsigned char*)lds;
    F.MISC = (volatile LAS unsigned*)(F.lds + MISC_OFF);
    F.wave = __builtin_amdgcn_readfirstlane((int)threadIdx.x >> 6); F.lane = mk_lane(); F.tid = F.wave * 64 + F.lane;
#define FRESH() do { F.lane = mk_lane(); F.tid = F.wave * 64 + F.lane; } while (0)
    F.G = gridDim.x; { const int bx = blockIdx.x; F.vcu = (F.G % 8 == 0) ? (bx % 8) * (F.G / 8) + bx / 8 : bx; }
    F.ws = args.ws; F.ctl = (gu32*)(args.ws + WS_CTL); F.out = args.out;
#pragma unroll
    for (int i = 0; i < 21; ++i) F.in[i] = args.in[i];
    for (int u = F.tid; u < (LDS_BYTES - LDSCTL_OFF) / 4; u += NWAVES * 64) ((LAS unsigned*)(F.lds + LDSCTL_OFF))[u] = 0u;
    __syncthreads();
    XcdBarrier bar; bar.bar = (unsigned*)(F.ctl + CW_BAR); bar.x = 0; bar.st = nullptr; bar.w = F.wave;
    if (N_LAUNCHES != PER_PHASE) bar = xcd_barrier_post((unsigned*)(F.ctl + CW_BAR), F.MISC + 8, F.wave);
#define GRID_BAR(seam) do { if (N_LAUNCHES == PER_PHASE) { if (F.tid == 0) __hip_atomic_store(F.ctl + CW_TMO, 0xBADBA0u | (unsigned)(seam), RLX_AGENT); } else { xcd_barrier(bar); } } while (0)
    const int lo = args.ph_lo, hi = args.ph_hi;
#define IN(k) (lo <= (k) && (k) < hi)
#define BOTH(k) (IN(k) && IN((k) + 1))
#ifndef MK_REPN
#define MK_REPN 1
#endif
#define NREP(k) (((MK_REPEAT >> (k)) & 1) * MK_REPN)
#define REPEAT(k) for (int rep_ = 0; rep_ <= NREP(k); ++rep_, (rep_ <= NREP(k) ? (void)xcd_barrier(bar) : (void)0))
    const int bx = (int)blockIdx.x;
    const float* MODS0 = (const float*)(F.ws + WS_MODS); const float* MODS1 = MODS0 + 3 * 6 * D;
    bf16* HXB = (bf16*)(F.ws + WS_XS); float* CTXB = (float*)(F.ws + WS_CTXB); float* CTXB2 = CTXB + (size_t)NCTX * D; bf16* HB = (bf16*)(F.ws + WS_BIG);
    bf16* X1B = (bf16*)F.out; bf16* X2B = X1B + (size_t)TT * D; bf16* X3B = (bf16*)(F.ws + WS_X3B);
    bf16* HXB2 = (bf16*)(F.ws + WS_QN);

#if MK_SYNTH
    if (IN(0)) { synth_phase(F, 2080); __syncthreads(); }
#endif
    if (IN(0)) { FRESH(); REPEAT(0) { p0_phase(F); } if (BOTH(0)) GRID_BAR(0); }
    if (IN(2)) { FRESH(); REPEAT(2) { p2_pooldiff_ring(F); } if (BOTH(2)) GRID_BAR(2); }
    if (IN(3)) { FRESH();
        pg8::Gemm g{HXB, (const bf16*)(F.ws + WS_POOL), 256, D, 256}; pg8::GridOrder S{NPT, 4, F.G, bx, 256, 1 + NREP(3)};
        pg8::EpiResB E{(const unsigned char*)F.in[0], F.in[2], (pg8::bf16_t*)X1B, CTXB, MODS0, F.in[8], 2, 0, 1.0f};
        pg8::gemm_phase<pg8::EpiResB, pg8::GridOrder, true, true>(F.lds + RING_OFF, g, S, E, F.wave);
        if (BOTH(3)) GRID_BAR(3);
    }
    if (IN(4)) { FRESH(); REPEAT(4) { normmod_phase(F, X1B, CTXB, HXB, F.in[6] + D, MODS0, 3, 4, MT, false); } if (BOTH(4)) GRID_BAR(4); }
    if (IN(5)) { FRESH();
        pg8::Gemm g{HXB, (const bf16*)(F.ws + WS_W13F), D, D, D}; pg8::GridOrder S{NPT, 22, F.G, bx, 0, 1 + NREP(5)};
        if (MK_FP8_DENSE) { pg8::EpiSwiGLU8 E{F.ws + WS_BIG, FF, 1.0f, FP8_SH};
            pg8::gemm_phase<pg8::EpiSwiGLU8, pg8::GridOrder, false, true>(F.lds + RING_OFF, g, S, E, F.wave); }
        else { pg8::EpiSwiGLU E{HB, FF};
            pg8::gemm_phase<pg8::EpiSwiGLU, pg8::GridOrder, true, true>(F.lds + RING_OFF, g, S, E, F.wave); }
        tail_convert(F, bx, NPT * 22, 0, MW_N1);
        if (BOTH(5)) GRID_BAR(5);
    }
    if (IN(6)) { FRESH();
        pg8::GridOrder S{NPT, 4, F.G, bx, 0, 1 + NREP(6)};
        if (MK_FP8_DENSE) { pg8::Gemm g{HB, (const bf16*)(F.ws + WS_W2F), FF / 2, FF / 2, FF / 2};
            pg8::EpiResB E{(const unsigned char*)X1B, CTXB, (pg8::bf16_t*)X2B, CTXB2, MODS0, nullptr, 5, 1, 1.0f / (FP8_SH * FP8_SW)};
            pg8::gemm_phase<pg8::EpiResB, pg8::GridOrder, true, true, true>(F.lds + RING_OFF, g, S, E, F.wave); }
        else { pg8::Gemm g{HB, (const bf16*)(F.ws + WS_W2F), FF, FF, FF};
            pg8::EpiResB E{(const unsigned char*)X1B, CTXB, (pg8::bf16_t*)X2B, CTXB2, MODS0, nullptr, 5, 1, 1.0f};
            pg8::gemm_phase<pg8::EpiResB, pg8::GridOrder, true, true>(F.lds + RING_OFF, g, S, E, F.wave); }
        tail_convert(F, bx, NPT * 4, MW_N1, MW_N2);
        if (BOTH(6)) GRID_BAR(6);
    }
    if (IN(7)) { FRESH(); REPEAT(7) { normmod_phase(F, X2B, CTXB2, HXB2, F.in[6] + 2 * D, MODS1, 0, 1, MT, MK_FP8_DENSE != 0); } if (BOTH(7)) GRID_BAR(7); }
    if (IN(8)) { FRESH();
        pg8::QkvOrder S{F.G, bx, 1 + NREP(8)};
        if (MK_FP8_DENSE) { pg8::Gemm g{HXB2, (const bf16*)(F.ws + WS_WQKV), D / 2, D / 2, D / 2};
            pg8::EpiQKV E{(bf16*)(F.ws + WS_Q), (bf16*)(F.ws + WS_K), (bf16*)(F.ws + WS_V), 1.0f / (FP8_SA * FP8_SW)};
            pg8::gemm_phase<pg8::EpiQKV, pg8::QkvOrder, true, true, true>(F.lds + RING_OFF, g, S, E, F.wave); }
        else { pg8::Gemm g{HXB2, (const bf16*)(F.ws + WS_WQKV), D, D, D};
            pg8::EpiQKV E{(bf16*)(F.ws + WS_Q), (bf16*)(F.ws + WS_K), (bf16*)(F.ws + WS_V), 1.0f};
            pg8::gemm_phase<pg8::EpiQKV, pg8::QkvOrder, true, true>(F.lds + RING_OFF, g, S, E, F.wave); }
        tail_convert(F, bx, 772, MW_N2, NE * 4224);
        if (BOTH(8)) GRID_BAR(8);
    }
    if (IN(9)) { FRESH(); REPEAT(9) { float cref_; const bool fast_ = attn_fast_ok(F, cref_); p9_qknorm(F, fast_); if (fast_) p9_vtrans(F); } if (BOTH(9)) GRID_BAR(9); }
    if (IN(10)) { FRESH(); REPEAT(10) {
        float cref; const bool fast = attn_fast_ok(F, cref);
        const attn_body::AttnTensors AT{(const attn_body::bf16*)(F.ws + WS_QN), (const attn_body::bf16*)(F.ws + WS_KN), (const attn_body::bf16*)(F.ws + WS_V), (attn_body::bf16*)(F.ws + WS_O), F.ws + WS_QN, F.ws + WS_KN, F.ws + WS_VT, cref};
        const attn_body::StaticOrder S((int)F.G, bx);
        attn_body::attn_phase<attn_body::StaticOrder>((char*)lds + RING_OFF, AT, S, fast, F.wave);
        } if (BOTH(10)) GRID_BAR(10);
    }
    if (IN(11)) { FRESH();
        pg8::Gemm g{(const bf16*)(F.ws + WS_O), (const bf16*)(F.ws + WS_WO), D, D, D}; pg8::GridOrder S{NPX, 4, F.G, bx, 0, 1 + NREP(11)};
        pg8::EpiResB E{(const unsigned char*)X2B, CTXB2, (pg8::bf16_t*)X3B, CTXB2, MODS1, nullptr, 2, 1, 1.0f};
        pg8::gemm_phase<pg8::EpiResB, pg8::GridOrder, true, true>(F.lds + RING_OFF, g, S, E, F.wave);
        if (BOTH(11)) GRID_BAR(11);
    }
    if (IN(12)) { FRESH(); REPEAT(12) { p12_router(F); } if (BOTH(12)) GRID_BAR(12); }
    if (IN(13)) { FRESH(); REPEAT(13) { p13_slots(F); } if (BOTH(13)) GRID_BAR(13); }
    if (IN(14)) { FRESH();
        const int* PEXP = (const int*)(F.ws + WS_PEXP); const int np = __builtin_amdgcn_readfirstlane(PEXP[512]);
        pg8::Gemm g{(const bf16*)(F.ws + WS_XS), (const bf16*)(F.ws + WS_W13M), D / 2, D / 2, D / 2}; pg8::MoeOrder S{np, 22, F.G, bx, 0, 0, 1 + NREP(14), PEXP};
        pg8::EpiSwiGLU8 E{F.ws + WS_BIG, FF, 1.0f / (FP8_SA * FP8_SW), FP8_SH};
        pg8::gemm_phase<pg8::EpiSwiGLU8, pg8::MoeOrder, false, true, true>(F.lds + RING_OFF, g, S, E, F.wave);
        if (BOTH(14)) GRID_BAR(14);
    }
    if (IN(15)) { FRESH();
        const int* PEXP = (const int*)(F.ws + WS_PEXP); const int np = __builtin_amdgcn_readfirstlane(PEXP[512]);
        pg8::Gemm g{(const bf16*)(F.ws + WS_BIG), (const bf16*)(F.ws + WS_W2M), FF / 2, FF / 2, FF / 2}; pg8::MoeOrder S{np, 4, F.G, bx, 0, 0, 1 + NREP(15), PEXP};
        pg8::EpiBf16 E{(bf16*)(F.ws + WS_XS), D, 1.0f / (FP8_SH * FP8_SW)};
        pg8::gemm_phase<pg8::EpiBf16, pg8::MoeOrder, true, true, true>(F.lds + RING_OFF, g, S, E, F.wave);
        if (BOTH(15)) GRID_BAR(15);
    }
    if (IN(16)) { FRESH(); REPEAT(16) { p18_combine(F); } }
#undef IN
#undef BOTH
}

extern "C" void kernel_launch(void* const* d_in, const int* in_sizes, int n_in, void* d_out, int out_size, void* d_ws, size_t ws_size, hipStream_t stream) {
    static int grid = 0;
    if (grid == 0) {
        if (n_in != 21 || in_sizes[0] != TT * D || out_size != TT * D || ws_size < WS_END) { fprintf(stderr, "kernel_launch: unexpected shapes (n_in %d, in0 %d, out %d, ws %zu); nothing launched\n", n_in, n_in > 0 ? in_sizes[0] : -1, out_size, ws_size); grid = -1; return; }
        int dev = 0, cus = 0, per_cu = 0;
        if (hipGetDevice(&dev) != hipSuccess || hipDeviceGetAttribute(&cus, hipDeviceAttributeMultiprocessorCount, dev) != hipSuccess) { grid = -1; return; }
        if (hipFuncSetAttribute((const void*)mk_fwd, hipFuncAttributeMaxDynamicSharedMemorySize, LDS_BYTES) != hipSuccess) { fprintf(stderr, "kernel_launch: hipFuncSetAttribute failed\n"); grid = -1; return; }
        if (hipOccupancyMaxActiveBlocksPerMultiprocessor(&per_cu, (const void*)mk_fwd, NWAVES * 64, LDS_BYTES) != hipSuccess || per_cu < 1)
            fprintf(stderr, "kernel_launch: note: occupancy query reports %d workgroups per CU\n", per_cu);
        (void)hipGetLastError();
        grid = cus;
    }
    if (grid < 0) return;
    if (hipMemsetAsync((char*)d_ws + WS_CTL, 0, CTL_ZERO_BYTES, stream) != hipSuccess) return;
    Args a{};
    for (int i = 0; i < 21; ++i) a.in[i] = (const float*)d_in[i];
    a.out = (float*)d_out; a.ws = (unsigned char*)d_ws;
    if (N_LAUNCHES == 1) { a.ph_lo = 0; a.ph_hi = PER_PHASE; hipLaunchKernelGGL(mk_fwd, dim3(grid), dim3(NWAVES * 64), LDS_BYTES, stream, a); }
    else for (int li = 0; li < PER_PHASE; ++li) { a.ph_lo = li; a.ph_hi = li + 1; hipLaunchKernelGGL(mk_fwd, dim3(grid), dim3(NWAVES * 64), LDS_BYTES, stream, a); }
}
```

```cpp
#include <hip/hip_runtime.h>
#include <hip/hip_bf16.h>
#include <cstdio>
#include <cstdint>
#include <cmath>
__device__ __forceinline__ int mk_lane() { int l; asm volatile("v_mbcnt_lo_u32_b32 %0, -1, 0\n\tv_mbcnt_hi_u32_b32 %0, -1, %0" : "=v"(l)); return l; }

namespace pg8 {
#define PG8_LAS __attribute__((address_space(3)))
typedef unsigned short bf16_t;
typedef short bf16x8 __attribute__((ext_vector_type(8)));
typedef float f32x4 __attribute__((ext_vector_type(4)));
typedef unsigned u32x4 __attribute__((ext_vector_type(4)));
constexpr int BM = 256, BK = 64, HALF = 128, HTB = HALF * BK * 2  , STAGE_BYTES = 8 * HTB, NXCD = 8, WGM = 8;

__host__ __device__ __forceinline__ int lds_byte(int r, int c) { const int st = (r >> 4) * 2 + (c >> 5), rr = r & 15, cc = c & 31, ob = rr * 64 + cc * 2; return st * 1024 + (ob ^ (((ob >> 9) & 1) << 5)); }
__host__ __device__ __forceinline__ void stage_rc(int b, int& R, int& C) { const int st = b / 1024, sb = b % 1024, swz = sb ^ (((sb >> 9) & 1) << 5); R = (st >> 1) * 16 + swz / 64; C = (st & 1) * 32 + (swz % 64) / 2; }
__host__ __device__ __forceinline__ int perm32(int rho) { const int n = rho >> 4, i = rho & 15; return 8 * (i >> 2) + 4 * n + (i & 3); }
__device__ __forceinline__ void glds_s(const char* sbase, unsigned voff, unsigned lds_dst) {
    unsigned keep;
    asm volatile("s_mov_b32 %0, m0\n\ts_mov_b32 m0, %1\n\ts_nop 0\n\tglobal_load_lds_dwordx4 %2, %3\n\ts_mov_b32 m0, %0" : "=&s"(keep) : "s"(lds_dst), "v"(voff), "s"(sbase) : "memory");
}
struct Unit { int pa, pb, pr, pc, ak, rp; };
struct Gemm { const bf16_t* A; const bf16_t* Bt; int K, lda, ldb; };

__device__ __forceinline__ void grid_order(int L, int nM, int nN, int& pm, int& pn) {
    const int nwg = nM * nN; int wgid = L;
    { const int q = nwg / NXCD, r = nwg % NXCD, xcd = wgid % NXCD, off = wgid / NXCD; wgid = (xcd < r ? xcd * (q + 1) : r * (q + 1) + (xcd - r) * q) + off; }
    const int nig = WGM * nN, gid = wgid / nig, fm = gid * WGM, gsz = (nM - fm) < WGM ? (nM - fm) : WGM;
    pm = fm + ((wgid % nig) % gsz); pn = (wgid % nig) / gsz;
}
struct GridOrder {
    int nM, nN, G, c, akmul, rep;
    __device__ __forceinline__ bool next(int i, Unit& u) const {
        int L = i * G + c; if (L >= nM * nN * rep) return false; u.rp = L / (nM * nN); L %= nM * nN;
        int pm, pn; grid_order(L, nM, nN, pm, pn);
        u.pa = pm; u.pb = pn; u.pr = pm; u.pc = pn; u.ak = akmul * pn; return true;
    }
    __device__ __forceinline__ void a_ready(const Unit&) const {}
    __device__ __forceinline__ void done(const Unit&) const {}
};
struct QkvOrder {
    int G, c, rep;
    __device__ __forceinline__ bool next(int i, Unit& u) const {
        int L = i * G + c; if (L >= 772 * rep) return false; L %= 772;
        int pm, pn;
        if (L < 768) grid_order(L, 128, 6, pm, pn); else { pm = 128 + ((L - 768) >> 1); pn = 4 + ((L - 768) & 1); }
        u.pa = pm; u.pb = pn; u.pr = pm; u.pc = pn; u.ak = 0; u.rp = 0; return true;
    }
    __device__ __forceinline__ void a_ready(const Unit&) const {}
    __device__ __forceinline__ void done(const Unit&) const {}
};
struct MoeOrder {
    int nM, nN, G, c, lo, a_rel, rep; const int* pexp;
    __device__ __forceinline__ bool next(int i, Unit& u) const {
        int L = i * G + c; if (L >= nM * nN * rep) return false; L %= nM * nN;
        int pm, pn; grid_order(L, nM, nN, pm, pn);
        const int e = __builtin_amdgcn_readfirstlane(pexp[lo + pm]);
        u.pa = a_rel ? pm : lo + pm; u.pb = e * nN + pn; u.pr = a_rel ? lo + pm : pm; u.pc = pn; u.ak = 0; u.rp = 0; return true;
    }
    __device__ __forceinline__ void a_ready(const Unit&) const {}
    __device__ __forceinline__ void done(const Unit&) const {}
};

__device__ __forceinline__ unsigned cvt_pk_bf16(float lo, float hi) { unsigned r; asm volatile("v_cvt_pk_bf16_f32 %0, %1, %2" : "=v"(r) : "v"(lo), "v"(hi)); return r; }
typedef int v8i __attribute__((ext_vector_type(8)));
typedef short s16x16 __attribute__((ext_vector_type(16)));
__device__ __forceinline__ v8i cat8(bf16x8 a, bf16x8 b) { const s16x16 t = __builtin_shufflevector(a, b, 0, 1, 2, 3, 4, 5, 6, 7, 8, 9, 10, 11, 12, 13, 14, 15); return __builtin_bit_cast(v8i, t); }
__device__ __forceinline__ unsigned pk4_fp8(float a, float b, float c, float d) {
    a = __builtin_fminf(__builtin_fmaxf(a, -448.f), 448.f); b = __builtin_fminf(__builtin_fmaxf(b, -448.f), 448.f); c = __builtin_fminf(__builtin_fmaxf(c, -448.f), 448.f); d = __builtin_fminf(__builtin_fmaxf(d, -448.f), 448.f);
    int w = 0; w = __builtin_amdgcn_cvt_pk_fp8_f32(a, b, w, false); w = __builtin_amdgcn_cvt_pk_fp8_f32(c, d, w, true); return (unsigned)w; }
__device__ __forceinline__ float silu_f(float a) { return a * __builtin_amdgcn_rcpf(1.0f + __builtin_amdgcn_exp2f(-1.4426950408889634f * a)); }

struct EpiBf16 {
    static constexpr bool PERM = true, AFTER_DRAIN = false;
    bf16_t* O; int ldc; float sc;
    __device__ __forceinline__ void operator()(const f32x4 (&acc)[2][2][4][2], const Unit& u, int wr, int wc, int fr, int fq) const {
        const int row0 = u.pr * BM + wr * 64 + fr, col0 = u.pc * BM + wc * 32 + 8 * fq;
#pragma unroll
        for (int ai = 0; ai < 2; ++ai)
#pragma unroll
            for (int m = 0; m < 4; ++m) { bf16_t* rowp = O + (size_t)(row0 + ai * HALF + m * 16) * ldc + col0;
#pragma unroll
                for (int bj = 0; bj < 2; ++bj) { const f32x4 v0 = acc[ai][bj][m][0] * sc, v1 = acc[ai][bj][m][1] * sc;
                    u32x4 w; w.x = cvt_pk_bf16(v0[0], v0[1]); w.y = cvt_pk_bf16(v0[2], v0[3]); w.z = cvt_pk_bf16(v1[0], v1[1]); w.w = cvt_pk_bf16(v1[2], v1[3]);
                    *(u32x4*)(rowp + bj * HALF) = w; } }
    }
};
struct EpiQKV {
    static constexpr bool PERM = true, AFTER_DRAIN = false;
    bf16_t* Q; bf16_t* Kb; bf16_t* Vb; float sc;
    __device__ __forceinline__ void operator()(const f32x4 (&acc)[2][2][4][2], const Unit& u, int wr, int wc, int fr, int fq) const {
        bf16_t* base; int ldc;
        if (u.pc < 4) { base = Q + (size_t)u.pr * BM * 1024 + u.pc * BM; ldc = 1024; }
        else { const int krow0 = u.pr < 128 ? (u.pr >> 6) * 16640 + (u.pr & 63) * 256 : (u.pr - 128) * 16640 + 16384; base = (u.pc == 4 ? Kb : Vb) + (size_t)krow0 * 256; ldc = 256; }
        const int row0 = wr * 64 + fr, col0 = wc * 32 + 8 * fq;
#pragma unroll
        for (int ai = 0; ai < 2; ++ai)
#pragma unroll
            for (int m = 0; m < 4; ++m) { bf16_t* rowp = base + (size_t)(row0 + ai * HALF + m * 16) * ldc + col0;
#pragma unroll
                for (int bj = 0; bj < 2; ++bj) { const f32x4 v0 = acc[ai][bj][m][0] * sc, v1 = acc[ai][bj][m][1] * sc;
                    u32x4 w; w.x = cvt_pk_bf16(v0[0], v0[1]); w.y = cvt_pk_bf16(v0[2], v0[3]); w.z = cvt_pk_bf16(v1[0], v1[1]); w.w = cvt_pk_bf16(v1[2], v1[3]);
                    *(u32x4*)(rowp + bj * HALF) = w; } }
    }
};
struct EpiSwiGLU {
    static constexpr bool PERM = true, AFTER_DRAIN = false;
    bf16_t* H; int ldh;
    __device__ __forceinline__ void operator()(const f32x4 (&acc)[2][2][4][2], const Unit& u, int wr, int wc, int fr, int fq) const {
        const int row0 = u.pr * BM + wr * 64 + fr, col0 = u.pc * HALF + wc * 32 + 8 * fq;
#pragma unroll
        for (int ai = 0; ai < 2; ++ai)
#pragma unroll
            for (int m = 0; m < 4; ++m) { bf16_t* rowp = H + (size_t)(row0 + ai * HALF + m * 16) * ldh + col0;
                const f32x4 a0 = acc[ai][0][m][0], a1 = acc[ai][0][m][1], b0 = acc[ai][1][m][0], b1 = acc[ai][1][m][1];
                u32x4 w;
                w.x = cvt_pk_bf16(silu_f(a0[0]) * b0[0], silu_f(a0[1]) * b0[1]); w.y = cvt_pk_bf16(silu_f(a0[2]) * b0[2], silu_f(a0[3]) * b0[3]);
                w.z = cvt_pk_bf16(silu_f(a1[0]) * b1[0], silu_f(a1[1]) * b1[1]); w.w = cvt_pk_bf16(silu_f(a1[2]) * b1[2], silu_f(a1[3]) * b1[3]);
                *(u32x4*)rowp = w; }
    }
};
struct EpiSwiGLU8 {
    static constexpr bool PERM = true, AFTER_DRAIN = false;
    unsigned char* H; int ldh; float sin, sout;
    typedef float f32x2 __attribute__((ext_vector_type(2)));
    template <bool HI> __device__ __forceinline__ unsigned pk2h(f32x2 a, f32x2 b, float k1, float k2, unsigned old) const {
        const f32x2 e = a * k1; f32x2 d; d.x = __builtin_amdgcn_exp2f(e.x); d.y = __builtin_amdgcn_exp2f(e.y); d = d + 1.0f;
        f32x2 r; r.x = __builtin_amdgcn_rcpf(d.x); r.y = __builtin_amdgcn_rcpf(d.y);
        f32x2 h = ((a * b) * k2) * r;
        h.x = __builtin_amdgcn_fmed3f(h.x, -448.f, 448.f); h.y = __builtin_amdgcn_fmed3f(h.y, -448.f, 448.f);
        return (unsigned)__builtin_amdgcn_cvt_pk_fp8_f32(h.x, h.y, (int)old, HI);
    }
    __device__ __forceinline__ void operator()(const f32x4 (&acc)[2][2][4][2], const Unit& u, int wr, int wc, int fr, int fq) const {
        const int row0 = u.pr * BM + wr * 64 + fr, col0 = u.pc * HALF + wc * 32 + 8 * fq;
        const float k1 = -1.4426950408889634f * sin, k2 = sin * sin * sout;
#pragma unroll
        for (int ai = 0; ai < 2; ++ai)
#pragma unroll
            for (int m = 0; m < 4; ++m) { unsigned char* rowp = H + (size_t)(row0 + ai * HALF + m * 16) * ldh + col0;
                const f32x4 a0 = acc[ai][0][m][0], a1 = acc[ai][0][m][1], b0 = acc[ai][1][m][0], b1 = acc[ai][1][m][1];
                unsigned w0 = 0, w1 = 0;
                w0 = pk2h<false>((f32x2){a0[0], a0[1]}, (f32x2){b0[0], b0[1]}, k1, k2, w0); w0 = pk2h<true>((f32x2){a0[2], a0[3]}, (f32x2){b0[2], b0[3]}, k1, k2, w0);
                w1 = pk2h<false>((f32x2){a1[0], a1[1]}, (f32x2){b1[0], b1[1]}, k1, k2, w1); w1 = pk2h<true>((f32x2){a1[2], a1[3]}, (f32x2){b1[2], b1[3]}, k1, k2, w1);
                *(unsigned long long*)rowp = (unsigned long long)w0 | ((unsigned long long)w1 << 32); }
    }
};
struct EpiResB {
    static constexpr bool PERM = true, AFTER_DRAIN = false;
    const unsigned char* baseX; const float* baseC; bf16_t* outX; float* outC; const float* mods; const float* gate2; int gidx; int base_bf; float sc;
    __device__ __forceinline__ void operator()(const f32x4 (&acc)[2][2][4][2], const Unit& u, int wr, int wc, int fr, int fq) const {
        const int pr = u.pr; const bool isx = pr < 128; const int mi = pr < 64 ? 0 : (pr < 128 ? 1 : 2);
        const float* gv = mods + (mi * 6 + gidx) * 1024;
        const int col0 = u.pc * BM + wc * 32 + 8 * fq;
        f32x4 g[2][2];
#pragma unroll
        for (int bj = 0; bj < 2; ++bj)
#pragma unroll
            for (int n = 0; n < 2; ++n) { g[bj][n] = *(const f32x4*)(gv + col0 + bj * HALF + n * 4) * sc; if (gate2) g[bj][n] = g[bj][n] * *(const f32x4*)(gate2 + col0 + bj * HALF + n * 4); }
        if (isx) {
            const size_t rb = (size_t)pr * BM;
#pragma unroll
            for (int ai = 0; ai < 2; ++ai)
#pragma unroll
                for (int m = 0; m < 4; ++m) { const size_t off = (rb + ai * HALF + wr * 64 + m * 16 + fr) * 1024 + col0;
#pragma unroll
                    for (int bj = 0; bj < 2; ++bj) { f32x4 b0, b1;
                        if (base_bf) { const u32x4 w = *(const u32x4*)((const bf16_t*)baseX + off + bj * HALF);
                            b0 = (f32x4){__builtin_bit_cast(float, w.x << 16), __builtin_bit_cast(float, w.x & 0xffff0000u), __builtin_bit_cast(float, w.y << 16), __builtin_bit_cast(float, w.y & 0xffff0000u)};
                            b1 = (f32x4){__builtin_bit_cast(float, w.z << 16), __builtin_bit_cast(float, w.z & 0xffff0000u), __builtin_bit_cast(float, w.w << 16), __builtin_bit_cast(float, w.w & 0xffff0000u)}; }
                        else { b0 = *(const f32x4*)((const float*)baseX + off + bj * HALF); b1 = *(const f32x4*)((const float*)baseX + off + bj * HALF + 4); }
                        const f32x4 v0 = b0 + g[bj][0] * acc[ai][bj][m][0], v1 = b1 + g[bj][1] * acc[ai][bj][m][1];
                        u32x4 o; o.x = cvt_pk_bf16(v0[0], v0[1]); o.y = cvt_pk_bf16(v0[2], v0[3]); o.z = cvt_pk_bf16(v1[0], v1[1]); o.w = cvt_pk_bf16(v1[2], v1[3]);
                        *(u32x4*)(outX + off + bj * HALF) = o; }
                    if (m & 1) asm volatile("" ::: "memory"); }
        } else {
            const size_t rb = (size_t)(pr - 128) * BM;
#pragma unroll
            for (int ai = 0; ai < 2; ++ai)
#pragma unroll
                for (int m = 0; m < 4; ++m) { const size_t off = (rb + ai * HALF + wr * 64 + m * 16 + fr) * 1024 + col0;
#pragma unroll
                    for (int bj = 0; bj < 2; ++bj)
#pragma unroll
                        for (int n = 0; n < 2; ++n) { const f32x4 bs = *(const f32x4*)(baseC + off + bj * HALF + n * 4); *(f32x4*)(outC + off + bj * HALF + n * 4) = bs + g[bj][n] * acc[ai][bj][m][n]; }
                    if (m & 1) asm volatile("" ::: "memory"); }
        }
    }
};
struct EpiRes {
    static constexpr bool PERM = false, AFTER_DRAIN = false;
    const float* baseX; const float* baseC; float* outX; float* outC; const float* mods; int gidx; const float* gate2; float sc;
    __device__ __forceinline__ void operator()(const f32x4 (&acc)[2][2][4][2], const Unit& u, int wr, int wc, int fr, int fq) const {
        const int pr = u.pr; const bool isx = pr < 128; const int mi = pr < 64 ? 0 : (pr < 128 ? 1 : 2);
        const float* base = isx ? baseX + (size_t)pr * BM * 1024 : baseC + (size_t)(pr - 128) * BM * 1024;
        float* out = isx ? outX + (size_t)pr * BM * 1024 : outC + (size_t)(pr - 128) * BM * 1024;
        const float* gv = mods + (mi * 6 + gidx) * 1024;
        const int col0 = u.pc * BM + wc * 32 + 4 * fq;
        f32x4 g[2][2];
#pragma unroll
        for (int bj = 0; bj < 2; ++bj)
#pragma unroll
            for (int n = 0; n < 2; ++n) { g[bj][n] = *(const f32x4*)(gv + col0 + bj * HALF + n * 16) * sc; if (gate2) g[bj][n] = g[bj][n] * *(const f32x4*)(gate2 + col0 + bj * HALF + n * 16); }
#pragma unroll
        for (int ai = 0; ai < 2; ++ai)
#pragma unroll
            for (int m = 0; m < 4; ++m) { const size_t off = (size_t)(ai * HALF + wr * 64 + m * 16 + fr) * 1024 + col0;
#pragma unroll
                for (int bj = 0; bj < 2; ++bj)
#pragma unroll
                    for (int n = 0; n < 2; ++n) { const f32x4 bs = *(const f32x4*)(base + off + bj * HALF + n * 16); *(f32x4*)(out + off + bj * HALF + n * 16) = bs + g[bj][n] * acc[ai][bj][m][n]; }
                if (m & 1) asm volatile("" ::: "memory"); }
    }
};

__device__ __forceinline__ float row_rstd(const float* ssq, int row, float eps) {
    const f32x4* p = (const f32x4*)(ssq + (size_t)row * 16); const f32x4 a = p[0], b = p[1], c = p[2], d = p[3];
    const float s = (((a[0] + a[1]) + (a[2] + a[3])) + ((b[0] + b[1]) + (b[2] + b[3]))) + (((c[0] + c[1]) + (c[2] + c[3])) + ((d[0] + d[1]) + (d[2] + d[3])));
    return 1.0f / sqrtf(s * (1.0f / 1024.0f) + eps);
}
template <bool FP8A> struct EpiResN {
    static constexpr bool PERM = false, AFTER_DRAIN = false;
    const float* baseX; const float* baseC; float* outX; float* outC; const float* mods; const float* gate2;
    const float* ng; const float* nmods; unsigned char* aout; float* ssq; int gidx, nsc; float sc, a_scale;
    __device__ __forceinline__ void operator()(const f32x4 (&acc)[2][2][4][2], const Unit& u, int wr, int wc, int fr, int fq) const {
        const int pr = u.pr; const bool isx = pr < 128; const int mi = pr < 64 ? 0 : (pr < 128 ? 1 : 2);
        const float* base = isx ? baseX + (size_t)pr * BM * 1024 : baseC + (size_t)(pr - 128) * BM * 1024;
        float* out = isx ? outX + (size_t)pr * BM * 1024 : outC + (size_t)(pr - 128) * BM * 1024;
        const float* gv = mods + (mi * 6 + gidx) * 1024; const float* nsv = nmods + (mi * 6 + nsc) * 1024;
        const int col0 = u.pc * BM + wc * 32 + 4 * fq;
        f32x4 g[2][2], gm[2][2];
#pragma unroll
        for (int bj = 0; bj < 2; ++bj)
#pragma unroll
            for (int n = 0; n < 2; ++n) { g[bj][n] = *(const f32x4*)(gv + col0 + bj * HALF + n * 16) * sc; if (gate2) g[bj][n] = g[bj][n] * *(const f32x4*)(gate2 + col0 + bj * HALF + n * 16);
                gm[bj][n] = *(const f32x4*)(ng + col0 + bj * HALF + n * 16) * (*(const f32x4*)(nsv + col0 + bj * HALF + n * 16) + 1.0f) * a_scale; }
#pragma unroll
        for (int ai = 0; ai < 2; ++ai)
#pragma unroll
            for (int m = 0; m < 4; ++m) { const int rl = ai * HALF + wr * 64 + m * 16 + fr; const size_t off = (size_t)rl * 1024 + col0; const size_t rowg = (size_t)pr * BM + rl; float ss = 0.f;
#pragma unroll
                for (int bj = 0; bj < 2; ++bj)
#pragma unroll
                    for (int n = 0; n < 2; ++n) { const f32x4 bs = *(const f32x4*)(base + off + bj * HALF + n * 16); const f32x4 o = bs + g[bj][n] * acc[ai][bj][m][n]; *(f32x4*)(out + off + bj * HALF + n * 16) = o;
                        ss += (o[0] * o[0] + o[1] * o[1]) + (o[2] * o[2] + o[3] * o[3]); const f32x4 a = o * gm[bj][n];
                        if (FP8A) *(unsigned*)(aout + rowg * 1024 + col0 + bj * HALF + n * 16) = pk4_fp8(a[0], a[1], a[2], a[3]);
                        else { unsigned long long w = (unsigned long long)cvt_pk_bf16(a[0], a[1]) | ((unsigned long long)cvt_pk_bf16(a[2], a[3]) << 32); *(unsigned long long*)(aout + (rowg * 1024 + col0 + bj * HALF + n * 16) * 2) = w; } }
                ss += __shfl_xor(ss, 16); ss += __shfl_xor(ss, 32);
                if (fq == 0) ssq[rowg * 16 + u.pc * 4 + wc] = ss;
                if (m & 1) asm volatile("" ::: "memory"); }
    }
};
struct EpiSwiGLU8N {
    static constexpr bool PERM = true, AFTER_DRAIN = false;
    unsigned char* H; int ldh; float sin, sout; const float* ssq; const float* bias; float eps;
    __device__ __forceinline__ void operator()(const f32x4 (&acc)[2][2][4][2], const Unit& u, int wr, int wc, int fr, int fq) const {
        const int row0 = u.pr * BM + wr * 64 + fr, col0 = u.pc * HALF + wc * 32 + 8 * fq; const int mi = u.pr < 64 ? 0 : (u.pr < 128 ? 1 : 2);
        const float* bp = bias + (size_t)mi * 5632 + u.pc * BM + wc * 32 + 8 * fq;
        const f32x4 b1a = *(const f32x4*)(bp), b1b = *(const f32x4*)(bp + 4), b3a = *(const f32x4*)(bp + HALF), b3b = *(const f32x4*)(bp + HALF + 4);
#pragma unroll
        for (int ai = 0; ai < 2; ++ai)
#pragma unroll
            for (int m = 0; m < 4; ++m) { const int row = row0 + ai * HALF + m * 16; unsigned char* rowp = H + (size_t)row * ldh + col0; const float rs = row_rstd(ssq, row, eps) * sin;
                const f32x4 a0 = acc[ai][0][m][0] * rs + b1a, a1 = acc[ai][0][m][1] * rs + b1b, b0 = (acc[ai][1][m][0] * rs + b3a) * sout, b1 = (acc[ai][1][m][1] * rs + b3b) * sout;
                unsigned long long w = (unsigned long long)pk4_fp8(silu_f(a0[0]) * b0[0], silu_f(a0[1]) * b0[1], silu_f(a0[2]) * b0[2], silu_f(a0[3]) * b0[3])
                                     | ((unsigned long long)pk4_fp8(silu_f(a1[0]) * b1[0], silu_f(a1[1]) * b1[1], silu_f(a1[2]) * b1[2], silu_f(a1[3]) * b1[3]) << 32);
                *(unsigned long long*)rowp = w; }
    }
};
struct EpiQKVN {
    static constexpr bool PERM = true, AFTER_DRAIN = false;
    bf16_t* Q; bf16_t* Kb; bf16_t* Vb; float sc; const float* ssq; const float* bias; float eps;
    __device__ __forceinline__ void operator()(const f32x4 (&acc)[2][2][4][2], const Unit& u, int wr, int wc, int fr, int fq) const {
        bf16_t* base; int ldc; const int mi = u.pr < 64 ? 0 : (u.pr < 128 ? 1 : 2);
        if (u.pc < 4) { base = Q + (size_t)u.pr * BM * 1024 + u.pc * BM; ldc = 1024; }
        else { const int krow0 = u.pr < 128 ? (u.pr >> 6) * 16640 + (u.pr & 63) * 256 : (u.pr - 128) * 16640 + 16384; base = (u.pc == 4 ? Kb : Vb) + (size_t)krow0 * 256; ldc = 256; }
        const int row0 = wr * 64 + fr, col0 = wc * 32 + 8 * fq;
        const float* bp = bias + (size_t)mi * 1536 + u.pc * BM + col0; f32x4 bv[2][2];
#pragma unroll
        for (int bj = 0; bj < 2; ++bj)
#pragma unroll
            for (int n = 0; n < 2; ++n) bv[bj][n] = *(const f32x4*)(bp + bj * HALF + 4 * n);
#pragma unroll
        for (int ai = 0; ai < 2; ++ai)
#pragma unroll
            for (int m = 0; m < 4; ++m) { const int rl = row0 + ai * HALF + m * 16; bf16_t* rowp = base + (size_t)rl * ldc + col0; const float rs = row_rstd(ssq, u.pr * BM + rl, eps) * sc;
#pragma unroll
                for (int bj = 0; bj < 2; ++bj) { const f32x4 v0 = acc[ai][bj][m][0] * rs + bv[bj][0], v1 = acc[ai][bj][m][1] * rs + bv[bj][1];
                    u32x4 w; w.x = cvt_pk_bf16(v0[0], v0[1]); w.y = cvt_pk_bf16(v0[2], v0[3]); w.z = cvt_pk_bf16(v1[0], v1[1]); w.w = cvt_pk_bf16(v1[2], v1[3]);
                    *(u32x4*)(rowp + bj * HALF) = w; } }
    }
};

template <class Epi, class Sched, bool ALIGN_EPI = false, bool SP2 = false, bool FP8 = false>
__device__ __forceinline__ void gemm_phase(PG8_LAS unsigned char* lds, const Gemm g, const Sched& S, const Epi& E, const int wid) {
    const int lane = mk_lane(), tid = wid * 64 + lane, wr = wid >> 2, wc = wid & 3, fr = lane & 15, fq = lane >> 4;
    const int K = g.K, nt = K / BK;
    unsigned voffA[2], voffB[2];
#pragma unroll
    for (int i = 0; i < 2; ++i) { int R, C; stage_rc(tid * 16 + i * 8192, R, C); const int Rb = Epi::PERM ? ((R & ~31) + perm32(R & 31)) : R;
        voffA[i] = (unsigned)(R * g.lda + C) * 2u; voffB[i] = (unsigned)(Rb * g.ldb + C) * 2u; }
    const size_t kstep = (size_t)(BK * 2);
    const size_t hstepA = (size_t)HALF * g.lda * 2, hstepB = (size_t)HALF * g.ldb * 2;
    const size_t tstepA = 2 * hstepA, tstepB = 2 * hstepB;
    const unsigned ldsw = (unsigned)wid * 1024u; const unsigned lds32 = (unsigned)(uintptr_t)lds; const int sc1_ = 0x7f7f7f7f;
    const int aoff = lds_byte(wr * 64 + fr, fq * 8), boff = lds_byte(wc * 32 + fr, fq * 8);
#define PG8_SA(b, h) (((b) * 2 + (h)) * HTB)
#define PG8_SB(b, h) ((4 + (b) * 2 + (h)) * HTB)
#define PG8_STAGE(bufoff, gbase, voff) do { _Pragma("unroll") for (int _i = 0; _i < 2; ++_i) \
        glds_s((const char*)(gbase), (voff)[_i], (unsigned)__builtin_amdgcn_readfirstlane((int)(lds32 + (unsigned)(bufoff) + ldsw + _i * 8192))); } while (0)
#define PG8_LDF(dst, i_, k_, addr_) do { const u32x4 t_ = *(const PG8_LAS u32x4*)(addr_); \
        if constexpr (FP8) { dst##8[i_][4 * (k_)] = (int)t_.x; dst##8[i_][4 * (k_) + 1] = (int)t_.y; dst##8[i_][4 * (k_) + 2] = (int)t_.z; dst##8[i_][4 * (k_) + 3] = (int)t_.w; } \
        else dst[i_][k_] = __builtin_bit_cast(bf16x8, t_); } while (0)
#define PG8_LDA(dst, b, h) do { _Pragma("unroll") for (int m = 0; m < 4; ++m) _Pragma("unroll") for (int k = 0; k < 2; ++k) PG8_LDF(dst, m, k, lds + PG8_SA(b, h) + aoff + m * 2048 + k * 1024); } while (0)
#define PG8_LDB(dst, b, h) do { _Pragma("unroll") for (int n = 0; n < 2; ++n) _Pragma("unroll") for (int k = 0; k < 2; ++k) PG8_LDF(dst, n, k, lds + PG8_SB(b, h) + boff + n * 2048 + k * 1024); } while (0)
#define PG8_MMA(ai, bj, At, Bt) do { __builtin_amdgcn_s_setprio(1); \
        if constexpr (FP8) { _Pragma("unroll") for (int m = 0; m < 4; ++m) _Pragma("unroll") for (int n = 0; n < 2; ++n) \
            asm volatile("v_mfma_scale_f32_16x16x128_f8f6f4 %0, %1, %2, %0, %3, %3 op_sel_hi:[0,0,0]" : "+v"(acc[ai][bj][m][n]) : "v"(Bt##8[n]), "v"(At##8[m]), "v"(sc1_)); } \
        else { _Pragma("unroll") for (int m = 0; m < 4; ++m) _Pragma("unroll") for (int n = 0; n < 2; ++n) _Pragma("unroll") for (int k = 0; k < 2; ++k) \
            acc[ai][bj][m][n] = __builtin_amdgcn_mfma_f32_16x16x32_bf16(Bt[n][k], At[m][k], acc[ai][bj][m][n], 0, 0, 0); } \
        __builtin_amdgcn_s_setprio(0); } while (0)
#define PG8_WAIT_V(n) asm volatile("s_waitcnt vmcnt(" #n ")" ::: "memory")
#define PG8_WAIT_L(n) asm volatile("s_waitcnt lgkmcnt(" #n ")" ::: "memory")
#define PG8_BAR __builtin_amdgcn_s_barrier()
#define PG8_SCHED __builtin_amdgcn_sched_barrier(0)
    Unit cur, nxt; int ui = 0;
    if (!S.next(0, cur)) return;
    f32x4 acc[2][2][4][2];
#pragma unroll
    for (int a = 0; a < 2; ++a)
#pragma unroll
        for (int b = 0; b < 2; ++b)
#pragma unroll
            for (int m = 0; m < 4; ++m)
#pragma unroll
                for (int n = 0; n < 2; ++n) acc[a][b][m][n] = (f32x4){0.f, 0.f, 0.f, 0.f};
    bf16x8 At[4][2], B0[2][2], B1[2][2]; v8i At8[4], B08[2], B18[2];
    const char* cA = (const char*)g.A + (size_t)cur.pa * tstepA + (size_t)cur.ak * 2; const char* cB = (const char*)g.Bt + (size_t)cur.pb * tstepB;
    S.a_ready(cur);
    if constexpr (SP2) {
        PG8_STAGE(PG8_SB(0, 0), cB, voffB); PG8_STAGE(PG8_SB(0, 1), cB + hstepB, voffB); PG8_STAGE(PG8_SA(0, 0), cA, voffA); PG8_STAGE(PG8_SA(0, 1), cA + hstepA, voffA);
        if (wr == 1) PG8_BAR;
        PG8_WAIT_V(2); PG8_BAR;
        PG8_STAGE(PG8_SB(1, 0), cB + kstep, voffB); PG8_STAGE(PG8_SA(1, 0), cA + kstep, voffA); PG8_STAGE(PG8_SB(1, 1), cB + hstepB + kstep, voffB);
        PG8_WAIT_V(6); PG8_BAR;
    } else {
        PG8_STAGE(PG8_SB(0, 0), cB, voffB); PG8_STAGE(PG8_SA(0, 0), cA, voffA); PG8_STAGE(PG8_SB(0, 1), cB + hstepB, voffB); PG8_STAGE(PG8_SA(0, 1), cA + hstepA, voffA);
        if (wr == 1) PG8_BAR;
        PG8_WAIT_V(4); PG8_BAR;
        PG8_STAGE(PG8_SB(1, 0), cB + kstep, voffB); PG8_STAGE(PG8_SA(1, 0), cA + kstep, voffA); PG8_STAGE(PG8_SB(1, 1), cB + hstepB + kstep, voffB);
        PG8_WAIT_V(6); PG8_BAR;
    }
    for (;;) {
        const bool has_next = S.next(ui + 1, nxt);
        const char* nA = has_next ? (const char*)g.A + (size_t)nxt.pa * tstepA + (size_t)nxt.ak * 2 : cA; const char* nB = has_next ? (const char*)g.Bt + (size_t)nxt.pb * tstepB : cB;
        asm volatile(".p2align 6\n\t.rept 2\n\ts_nop 0\n\t.endr");
#pragma nounroll
        for (int t = 0; t < nt; t += 2) {
            const bool last = (t == nt - 2);
            const char* a1 = cA + (size_t)(t + 1) * kstep;
            const char* a2 = last ? nA : cA + (size_t)(t + 2) * kstep; const char* b2 = last ? nB : cB + (size_t)(t + 2) * kstep;
            const char* a3 = a2 + kstep; const char* b3 = b2 + kstep;
            if (last && has_next) S.a_ready(nxt);
            if constexpr (SP2) {
            PG8_LDB(B0, 0, 0); PG8_LDB(B1, 0, 1); PG8_SCHED; PG8_LDA(At, 0, 0); PG8_STAGE(PG8_SA(1, 1), a1 + hstepA, voffA);
            PG8_WAIT_V(8); PG8_WAIT_L(0); PG8_BAR; PG8_MMA(0, 0, At, B0); PG8_MMA(0, 1, At, B1); PG8_BAR; PG8_SCHED;
            PG8_LDA(At, 0, 1); PG8_STAGE(PG8_SB(0, 0), b2, voffB); PG8_STAGE(PG8_SB(0, 1), b2 + hstepB, voffB); PG8_STAGE(PG8_SA(0, 0), a2, voffA);
            PG8_WAIT_V(8); PG8_WAIT_L(0); PG8_BAR; PG8_MMA(1, 0, At, B0); PG8_MMA(1, 1, At, B1); PG8_BAR; PG8_SCHED;
            PG8_LDB(B0, 1, 0); PG8_LDB(B1, 1, 1); PG8_SCHED; PG8_LDA(At, 1, 0); PG8_STAGE(PG8_SA(0, 1), a2 + hstepA, voffA);
            PG8_WAIT_V(8); PG8_WAIT_L(0); PG8_BAR; PG8_MMA(0, 0, At, B0); PG8_MMA(0, 1, At, B1); PG8_BAR; PG8_SCHED;
            PG8_LDA(At, 1, 1); PG8_STAGE(PG8_SB(1, 0), b3, voffB); PG8_STAGE(PG8_SB(1, 1), b3 + hstepB, voffB); PG8_STAGE(PG8_SA(1, 0), a3, voffA);
            PG8_WAIT_V(8); PG8_WAIT_L(0); PG8_BAR; PG8_MMA(1, 0, At, B0); PG8_MMA(1, 1, At, B1); PG8_BAR; PG8_SCHED;
            } else {
            PG8_LDB(B0, 0, 0); PG8_SCHED; PG8_LDA(At, 0, 0); PG8_STAGE(PG8_SA(1, 1), a1 + hstepA, voffA);
            PG8_WAIT_L(8); PG8_BAR; PG8_WAIT_L(0); PG8_MMA(0, 0, At, B0); PG8_BAR; PG8_SCHED;
            PG8_LDB(B1, 0, 1); PG8_STAGE(PG8_SB(0, 0), b2, voffB);
            PG8_BAR; PG8_WAIT_L(0); PG8_MMA(0, 1, At, B1); PG8_BAR;
            PG8_LDA(At, 0, 1); PG8_STAGE(PG8_SA(0, 0), a2, voffA);
            PG8_BAR; PG8_WAIT_L(0); PG8_MMA(1, 0, At, B0); PG8_BAR; PG8_SCHED;
            PG8_STAGE(PG8_SB(0, 1), b2 + hstepB, voffB);
            PG8_WAIT_V(6); PG8_BAR; PG8_MMA(1, 1, At, B1); PG8_BAR;
            PG8_LDB(B0, 1, 0); PG8_SCHED; PG8_LDA(At, 1, 0); PG8_STAGE(PG8_SA(0, 1), a2 + hstepA, voffA);
            PG8_WAIT_L(8); PG8_BAR; PG8_WAIT_L(0); PG8_MMA(0, 0, At, B0); PG8_BAR; PG8_SCHED;
            PG8_LDB(B1, 1, 1); PG8_STAGE(PG8_SB(1, 0), b3, voffB);
            PG8_BAR; PG8_WAIT_L(0); PG8_MMA(0, 1, At, B1); PG8_BAR;
            PG8_LDA(At, 1, 1); PG8_STAGE(PG8_SA(1, 0), a3, voffA);
            PG8_BAR; PG8_WAIT_L(0); PG8_MMA(1, 0, At, B0); PG8_BAR; PG8_SCHED;
            PG8_STAGE(PG8_SB(1, 1), b3 + hstepB, voffB);
            PG8_WAIT_V(6); PG8_BAR; PG8_MMA(1, 1, At, B1); PG8_BAR;
            }
        }
        if constexpr (ALIGN_EPI) { if (wr == 0) PG8_BAR; }
        if constexpr (FP8) asm volatile("s_nop 15\n\ts_nop 15" ::: "memory");
        if constexpr (!Epi::AFTER_DRAIN) { const int l2_ = mk_lane(); E(acc, cur, wid >> 2, wid & 3, l2_ & 15, l2_ >> 4); S.done(cur); }
        if (!has_next) break;
#pragma unroll
        for (int a = 0; a < 2; ++a)
#pragma unroll
            for (int b = 0; b < 2; ++b)
#pragma unroll
                for (int m = 0; m < 4; ++m)
#pragma unroll
                    for (int n = 0; n < 2; ++n) acc[a][b][m][n] = (f32x4){0.f, 0.f, 0.f, 0.f};
        cur = nxt; cA = nA; cB = nB; ++ui;
        if constexpr (ALIGN_EPI) { if (wr == 1) PG8_BAR; }
    }
    PG8_WAIT_V(0);
    if constexpr (!ALIGN_EPI) { if (wr == 0) PG8_BAR; }
    PG8_BAR;
    if constexpr (Epi::AFTER_DRAIN) { E.fused(acc, cur, wr, wc, fr, fq, lds, wid, lane); S.done(cur); }
#undef PG8_SA
#undef PG8_SB
#undef PG8_STAGE
#undef PG8_LDF
#undef PG8_LDA
#undef PG8_LDB
#undef PG8_MMA
#undef PG8_WAIT_V
#undef PG8_WAIT_L
#undef PG8_BAR
#undef PG8_SCHED
}
}

#include <hip/hip_bf16.h>
#include <cmath>
namespace attn_body {
using bf16=__hip_bfloat16;
using bf16x8=__attribute__((ext_vector_type(8)))short;
using s16x4=__attribute__((ext_vector_type(4)))short;
using f32x16=__attribute__((ext_vector_type(16)))float;
using u32x4=__attribute__((ext_vector_type(4)))unsigned;
using v8i_t=__attribute__((ext_vector_type(8)))int;
using f32x4v=__attribute__((ext_vector_type(4)))float;
constexpr float QF8=16.0f,KF8=4.0f,VF8=8.0f; constexpr int QSC8=0x7B7B7B7B,KSC8=0x7D7D7D7D,VSC8=0x7C7C7C7C;
constexpr int BATCH=2,NHEAD=16,SEQ=16384,D=64,DM=NHEAD*D,KVP=256,LKV=16640;
constexpr int NW=8,QBLK=32,QB=QBLK*NW,KVBLK=64,NQB=SEQ/QB;
constexpr int ATTN_PITCH=DM, ATTN_UNIT_ROWS=QB;
__device__ __forceinline__ int crow(int r,int hi){return (r&3)+8*(r>>2)+4*hi;}
#define SBAR() __builtin_amdgcn_sched_barrier(0)
__device__ __forceinline__ void cmask(f32x16&p0,f32x16&p1,int jb,int qrel,int hi){
  const float NEG=-INFINITY; int kb=64*jb+4*hi;
  #pragma unroll
  for(int r=0;r<16;++r){int kv=kb+(r&3)+8*(r>>2); if(kv>qrel)p0[r]=NEG; if(kv+32>qrel)p1[r]=NEG;}
}

constexpr int NSLOT=3, SLOTB=8192;
constexpr int LDS_K=0, LDS_V=NSLOT*SLOTB, LDS_WS=2*NSLOT*SLOTB, LDS_OST=LDS_WS+NW*64*4, LDS_BYTES=LDS_OST+NW*4096;
constexpr float C2=0.125f*1.4426950408889634f;
__device__ __forceinline__ void glds16(const void*gsrc,unsigned lds_dst){unsigned keep;
  asm volatile("s_mov_b32 %0, m0\n\ts_mov_b32 m0, %2\n\ts_nop 0\n\tglobal_load_lds_dwordx4 %1, off\n\ts_mov_b32 m0, %0":"=&s"(keep):"v"(gsrc),"s"(lds_dst):"memory");}
__device__ __forceinline__ float max3f(float a,float b,float c){float r;asm("v_max3_f32 %0, %1, %2, %3":"=v"(r):"v"(a),"v"(b),"v"(c));return r;}
__device__ __forceinline__ float max2f(float a,float b){float r;asm("v_max_f32_e32 %0, %1, %2":"=v"(r):"v"(a),"v"(b));return r;}
__device__ __forceinline__ float fadd_s(float a,float b){float r;asm("v_add_f32_e32 %0, %1, %2":"=v"(r):"v"(a),"v"(b));return r;}
__device__ __forceinline__ float fsub_s(float a,float b){float r;asm("v_sub_f32_e32 %0, %1, %2":"=v"(r):"v"(a),"v"(b));return r;}
typedef float f32x2_t __attribute__((ext_vector_type(2))); typedef __bf16 bf16x2_t __attribute__((ext_vector_type(2)));
__device__ __forceinline__ unsigned cvtpk_s(float lo,float hi){f32x2_t v={lo,hi};bf16x2_t b=__builtin_convertvector(v,bf16x2_t);return __builtin_bit_cast(unsigned,b);}
#define WAIT_BAR(N) asm volatile("s_waitcnt vmcnt(" #N ") lgkmcnt(0)\n\ts_barrier":::"memory")

__device__ __forceinline__ void qkt(f32x16&p0,f32x16&p1,const char*Kslot,const bf16x8*qr,const f32x16&negm,int r32,int hi){
  const char*kb=Kslot+hi*1024+r32*16;
  #pragma unroll
  for(int d0=0;d0<4;++d0){
    const bf16x8 b0=*reinterpret_cast<const bf16x8*>(kb+d0*2048);
    const bf16x8 b1=*reinterpret_cast<const bf16x8*>(kb+d0*2048+512);
    if(d0==0){p0=__builtin_amdgcn_mfma_f32_32x32x16_bf16(b0,qr[0],negm,0,0,0);p1=__builtin_amdgcn_mfma_f32_32x32x16_bf16(b1,qr[0],negm,0,0,0);}
    else{p0=__builtin_amdgcn_mfma_f32_32x32x16_bf16(b0,qr[d0],p0,0,0,0);p1=__builtin_amdgcn_mfma_f32_32x32x16_bf16(b1,qr[d0],p1,0,0,0);}}
}
typedef __attribute__((address_space(3))) const char* lds_cptr;
typedef short v4i16_t __attribute__((ext_vector_type(4)));
__device__ __forceinline__ void kload8(bf16x8*kf,lds_cptr kp){
  kf[0]=*(const __attribute__((address_space(3))) bf16x8*)(kp);      kf[1]=*(const __attribute__((address_space(3))) bf16x8*)(kp+512);
  kf[2]=*(const __attribute__((address_space(3))) bf16x8*)(kp+2048); kf[3]=*(const __attribute__((address_space(3))) bf16x8*)(kp+2560);
  kf[4]=*(const __attribute__((address_space(3))) bf16x8*)(kp+4096); kf[5]=*(const __attribute__((address_space(3))) bf16x8*)(kp+4608);
  kf[6]=*(const __attribute__((address_space(3))) bf16x8*)(kp+6144); kf[7]=*(const __attribute__((address_space(3))) bf16x8*)(kp+6656);
}
__device__ __forceinline__ void kload2(bf16x8*kf,lds_cptr kp,int j){ kf[2*j]=*(const __attribute__((address_space(3))) bf16x8*)(kp+j*2048); kf[2*j+1]=*(const __attribute__((address_space(3))) bf16x8*)(kp+j*2048+512); }
__device__ __forceinline__ s16x4 vtr(lds_cptr p){ return __builtin_bit_cast(s16x4,__builtin_amdgcn_ds_read_tr16_b64_v4i16((__attribute__((address_space(3))) v4i16_t*)p)); }
__device__ __forceinline__ float rowmax(const f32x16&p0,const f32x16&p1){
  float a=max3f(p0[0],p0[1],p1[0]),b=max3f(p0[2],p0[3],p1[1]);a=max3f(a,p1[2],p1[3]);
  #pragma unroll
  for(int r=4;r<16;r+=4){a=max3f(a,p0[r],p0[r+1]);b=max3f(b,p0[r+2],p0[r+3]);a=max3f(a,p1[r],p1[r+1]);b=max3f(b,p1[r+2],p1[r+3]);}
  const float m=max2f(a,b);
  auto rr=__builtin_amdgcn_permlane32_swap(__float_as_uint(m),__float_as_uint(m),false,false);
  return max2f(__uint_as_float(rr[0]),__uint_as_float(rr[1]));
}
__device__ __forceinline__ void pv(f32x16*o,int vb,bf16x8 pa0,bf16x8 pa1,bf16x8 pa2,bf16x8 pa3){
  #pragma unroll
  for(int d0=0;d0<2;++d0){s16x4 lo[4],hi[4];
    #pragma unroll
    for(int ks=0;ks<4;++ks){
      asm volatile("ds_read_b64_tr_b16 %0,%1 offset:%c2":"=&v"(lo[ks]):"v"(vb),"i"(d0*4096+ks*1024):"memory");
      asm volatile("ds_read_b64_tr_b16 %0,%1 offset:%c2":"=&v"(hi[ks]):"v"(vb),"i"(d0*4096+ks*1024+512):"memory");}
    asm volatile("s_waitcnt lgkmcnt(0)":::"memory");SBAR();
    #define PK(k) (bf16x8){lo[k][0],lo[k][1],lo[k][2],lo[k][3],hi[k][0],hi[k][1],hi[k][2],hi[k][3]}
    o[d0]=__builtin_amdgcn_mfma_f32_32x32x16_bf16(pa0,PK(0),o[d0],0,0,0);
    o[d0]=__builtin_amdgcn_mfma_f32_32x32x16_bf16(pa1,PK(1),o[d0],0,0,0);
    o[d0]=__builtin_amdgcn_mfma_f32_32x32x16_bf16(pa2,PK(2),o[d0],0,0,0);
    o[d0]=__builtin_amdgcn_mfma_f32_32x32x16_bf16(pa3,PK(3),o[d0],0,0,0);
    #undef PK
  }
}

#ifndef ATTN_STORE16
#define ATTN_STORE16(p,v) (*(u32x4*)(p)=(v))
#endif
template<int THRL> __device__ __forceinline__ void attn_unit(int wv,int b,int h,int qb,const bf16*Q,const bf16*__restrict__ K,const bf16*__restrict__ V,bf16*O,char*shm){
  const int lane=mk_lane(),r32=lane&31,hi=lane>>5; const int wid=wv;
  const long rowbase=(long)b*SEQ; const long rowk=(long)b*LKV; const int q0=qb*QB;
  const bf16*Qw=Q+(rowbase+q0+wid*QBLK)*DM+h*D;
  const bf16*Kh=K+rowk*KVP+(h>>2)*D,*Vh=V+rowk*KVP+(h>>2)*D;
  const unsigned lds0=(unsigned)(uintptr_t)shm;
  float*wsf=(float*)(shm+LDS_WS)+wid*64;
  const bf16*ksrc=Kh+(long)lane*KVP+wid*8;
  const bf16*vsrc=Vh+(long)(16*(wid&3)+(lane>>2))*KVP+(wid>>2)*32+(lane&3)*8;
  const unsigned kdst=lds0+LDS_K+wid*1024, vdst=lds0+LDS_V+wid*1024;
  #define DMA_K(t,slot) glds16(ksrc+(long)(t)*KVBLK*KVP,(unsigned)__builtin_amdgcn_readfirstlane(kdst+(slot)))
  #define DMA_V(t,slot) glds16(vsrc+(long)(t)*KVBLK*KVP,(unsigned)__builtin_amdgcn_readfirstlane(vdst+(slot)))
  const int vb0=(int)(lds0+LDS_V)+((lane>>4)&1)*32+(lane&3)*8+(4*hi+((lane&15)>>2))*64;
  const char*Kbase=shm+LDS_K; bf16x8 kf[8];
  const lds_cptr shm3=(lds_cptr)shm; const lds_cptr kp0=shm3+LDS_K+hi*1024+r32*16; const lds_cptr vp0=shm3+LDS_V+((lane>>4)&1)*32+(lane&3)*8+(4*hi+((lane&15)>>2))*64;
  constexpr int NT=LKV/KVBLK;
  DMA_K(0,0);DMA_V(0,0);DMA_K(1,SLOTB);
  bf16x8 qr[4];
  #pragma unroll
  for(int d0=0;d0<4;++d0)qr[d0]=*reinterpret_cast<const bf16x8*>(&Qw[(long)r32*DM+d0*16+hi*8]);
  float mhat=0.f,l_reg=0.f;f32x16 o[2];o[0]=f32x16{};o[1]=f32x16{};f32x16 negm=f32x16{};asm volatile("":"+v"(negm));

  #define CMASK(P0,P1,t) do{}while(0)
  bool resc=false;
  #define START(P0,P1) do{ const float rm=rowmax(P0,P1); resc=false; \
    { const float dl=rm; mhat=fadd_s(mhat,dl); \
      _Pragma("unroll") for(int r=0;r<16;++r){P0[r]=fsub_s(P0[r],dl);P1[r]=fsub_s(P1[r],dl);} \
      _Pragma("unroll") for(int r=0;r<16;++r)negm[r]=-mhat; asm volatile("":"+v"(negm)); } \
    _Pragma("unroll") for(int r=0;r<16;++r)P0[r]=__builtin_amdgcn_exp2f(P0[r]); }while(0)
  #define RESC() do{ if(resc){ asm volatile("s_waitcnt lgkmcnt(0)":::"memory"); \
      _Pragma("unroll") for(int d_=0;d_<2;++d_) _Pragma("unroll") for(int r=0;r<16;++r)o[d_][r]*=wsf[crow(r,hi)]; } }while(0)
  f32x16 pA0,pA1,pB0,pB1;
  int sl_prev=0,sl_cur=0,sl_next=SLOTB;
  #define ROT() do{sl_prev=sl_cur;sl_cur=sl_next;sl_next=(sl_next==(NSLOT-1)*SLOTB)?0:sl_next+SLOTB;}while(0)
  DMA_K(2,2*SLOTB);
  WAIT_BAR(3);
  qkt(pA0,pA1,Kbase,qr,negm,r32,hi);asm volatile("s_nop 15\n\ts_nop 7":"+v"(pA0),"+v"(pA1));CMASK(pA0,pA1,0);
  START(pA0,pA1);
  _Pragma("unroll") for(int r=0;r<16;++r)pA1[r]=__builtin_amdgcn_exp2f(pA1[r]);
  WAIT_BAR(0);
  DMA_K(3,0);DMA_V(1,SLOTB);
  ROT();
  kload8(kf,kp0+sl_cur);
  WAIT_BAR(2);
  s16x4 vlo[8],vhi[8]; u32x4 pw0,pw1,pw2,pw3;
  #define PKW(P,B) cvtpk_s(P[B],P[B+1])
  #define PAF(k) __builtin_bit_cast(bf16x8,pw##k)
  #define VFR(i) (bf16x8){vlo[i][0],vlo[i][1],vlo[i][2],vlo[i][3],vhi[i][0],vhi[i][1],vhi[i][2],vhi[i][3]}
  #define PIN(x) asm volatile("":"+v"(x))
  #define MX3(a,b,c) __builtin_fmaxf(__builtin_fmaxf((a),(b)),(c))
  #define GAPA(MF,A0,A1,A2,A3,W0,W1,PW) do{ MF; sacc+=A0; sacc+=A1; sacc+=A2; sacc+=A3; PIN(sacc); W0; W1; PIN(PW); SBAR(); }while(0)
  #define EX(v) __builtin_amdgcn_exp2f(v)
  #define GAPB(MF,X,B) do{ MF; X[B]=EX(X[B]); X[B+1]=EX(X[B+1]); X[B+2]=EX(X[B+2]); X[B+3]=EX(X[B+3]); PIN(X); SBAR(); }while(0)
  #define VRD(i) do{ vlo[i]=vtr(vp_+(((i)>>2)*4096+((i)&3)*1024)); vhi[i]=vtr(vp_+(((i)>>2)*4096+((i)&3)*1024+512)); }while(0)
  #define KRD(G,j) do{ if(G){ kload2(kf,kp0+sl_next,j); SBAR(); } }while(0)
  #define STEP(C0,C1,P0,P1,t,GK,GV,GL) do{ SBAR(); \
    const lds_cptr vp_=vp0+sl_prev; \
    VRD(0); SBAR(); float sacc=(P0[0]+P0[1]); \
    GAPA(C0=__builtin_amdgcn_mfma_f32_32x32x16_bf16(kf[0],qr[0],negm,0,0,0), P0[2],P0[3],P0[4],P0[5],     pw0[0]=PKW(P0,0), pw0[1]=PKW(P0,2), pw0); \
    VRD(4); SBAR(); GAPA(C1=__builtin_amdgcn_mfma_f32_32x32x16_bf16(kf[1],qr[0],negm,0,0,0), P0[6],P0[7],P0[8],P0[9],     pw0[2]=PKW(P0,4), pw0[3]=PKW(P0,6), pw0); \
    VRD(1); SBAR(); GAPA(C0=__builtin_amdgcn_mfma_f32_32x32x16_bf16(kf[2],qr[1],C0,0,0,0),   P0[10],P0[11],P0[12],P0[13], pw1[0]=PKW(P0,8), pw1[1]=PKW(P0,10), pw1); \
    VRD(5); SBAR(); GAPA(C1=__builtin_amdgcn_mfma_f32_32x32x16_bf16(kf[3],qr[1],C1,0,0,0),   P0[14],P0[15],P1[0],P1[1],   pw1[2]=PKW(P0,12),pw1[3]=PKW(P0,14), pw1); \
    VRD(2); SBAR(); GAPA(C0=__builtin_amdgcn_mfma_f32_32x32x16_bf16(kf[4],qr[2],C0,0,0,0),   P1[2],P1[3],P1[4],P1[5],     pw2[0]=PKW(P1,0), pw2[1]=PKW(P1,2), pw2); \
    VRD(6); SBAR(); GAPA(C1=__builtin_amdgcn_mfma_f32_32x32x16_bf16(kf[5],qr[2],C1,0,0,0),   P1[6],P1[7],P1[8],P1[9],     pw2[2]=PKW(P1,4), pw2[3]=PKW(P1,6), pw2); \
    VRD(3); SBAR(); GAPA(C0=__builtin_amdgcn_mfma_f32_32x32x16_bf16(kf[6],qr[3],C0,0,0,0),   P1[10],P1[11],P1[12],P1[13], pw3[0]=PKW(P1,8), pw3[1]=PKW(P1,10), pw3); \
    VRD(7); SBAR(); GAPA(C1=__builtin_amdgcn_mfma_f32_32x32x16_bf16(kf[7],qr[3],C1,0,0,0),   P1[14],P1[15],0.f,0.f,       pw3[2]=PKW(P1,12),pw3[3]=PKW(P1,14), pw3); \
    l_reg+=sacc; \
    if(GK){DMA_K((t)+3,sl_cur);} if(GV){DMA_V((t)+1,sl_next);} \
    CMASK(C0,C1,t); \
    { float a=MX3(C0[0],C0[1],C1[0]),b=MX3(C0[2],C0[3],C1[1]); a=MX3(a,C1[2],C1[3]); \
      _Pragma("unroll") for(int r=4;r<16;r+=4){a=MX3(a,C0[r],C0[r+1]);b=MX3(b,C0[r+2],C0[r+3]);a=MX3(a,C1[r],C1[r+1]);b=MX3(b,C1[r+2],C1[r+3]);} \
      float rm=__builtin_fmaxf(a,b); { auto rr=__builtin_amdgcn_permlane32_swap(__float_as_uint(rm),__float_as_uint(rm),false,false); rm=__builtin_fmaxf(__uint_as_float(rr[0]),__uint_as_float(rr[1])); } \
      resc=false; \
      if(__builtin_expect(__any(rm>(float)THRL),0)){ const float dl=__builtin_fmaxf(rm,0.f); mhat+=dl; \
        _Pragma("unroll") for(int r=0;r<16;++r){C0[r]-=dl;C1[r]-=dl;} \
        _Pragma("unroll") for(int r=0;r<16;++r)negm[r]=-mhat; asm volatile("":"+v"(negm)); \
        const float f=__builtin_amdgcn_exp2f(-dl); l_reg*=f; if(hi==0)wsf[r32]=f; resc=true; } } \
    SBAR(); \
    GAPB(o[0]=__builtin_amdgcn_mfma_f32_32x32x16_bf16(PAF(0),VFR(0),o[0],0,0,0), C0,0); \
    GAPB(o[1]=__builtin_amdgcn_mfma_f32_32x32x16_bf16(PAF(0),VFR(4),o[1],0,0,0), C0,4); \
    KRD(GL,0); GAPB(o[0]=__builtin_amdgcn_mfma_f32_32x32x16_bf16(PAF(1),VFR(1),o[0],0,0,0), C0,8); \
    KRD(GL,1); GAPB(o[1]=__builtin_amdgcn_mfma_f32_32x32x16_bf16(PAF(1),VFR(5),o[1],0,0,0), C0,12); \
    KRD(GL,2); GAPB(o[0]=__builtin_amdgcn_mfma_f32_32x32x16_bf16(PAF(2),VFR(2),o[0],0,0,0), C1,0); \
    KRD(GL,3); GAPB(o[1]=__builtin_amdgcn_mfma_f32_32x32x16_bf16(PAF(2),VFR(6),o[1],0,0,0), C1,4); \
    GAPB(o[0]=__builtin_amdgcn_mfma_f32_32x32x16_bf16(PAF(3),VFR(3),o[0],0,0,0), C1,8); \
    GAPB(o[1]=__builtin_amdgcn_mfma_f32_32x32x16_bf16(PAF(3),VFR(7),o[1],0,0,0), C1,12); \
    }while(0)
  int t=1;
  #undef CMASK
  #define CMASK(P0,P1,t) do{}while(0)
  for(;t+5<NT;t+=2){
    STEP(pB0,pB1,pA0,pA1,t,true,true,true);     WAIT_BAR(2); RESC(); ROT();
    STEP(pA0,pA1,pB0,pB1,t+1,true,true,true);   WAIT_BAR(2); RESC(); ROT();
  }
  #undef CMASK
  #define CMASK(P0,P1,t) do{}while(0)
  #define ENDW(tt) do{ if((tt)+3<NT){WAIT_BAR(2);} else if((tt)+2<NT){WAIT_BAR(1);} else {WAIT_BAR(0);} }while(0)
  for(;t+1<NT;t+=2){
    STEP(pB0,pB1,pA0,pA1,t,(t+3<NT),(t+1<NT),(t+1<NT));       ENDW(t);   RESC(); ROT();
    STEP(pA0,pA1,pB0,pB1,t+1,(t+4<NT),(t+2<NT),(t+2<NT));     ENDW(t+1); RESC(); ROT();
  }
  STEP(pB0,pB1,pA0,pA1,NT-1,false,false,false); RESC();
  { float sacc=pB0[0]+pB0[1]; _Pragma("unroll") for(int r=2;r<16;++r)sacc+=pB0[r]; _Pragma("unroll") for(int r=0;r<16;++r)sacc+=pB1[r]; l_reg+=sacc;
    pw0=(u32x4){PKW(pB0,0),PKW(pB0,2),PKW(pB0,4),PKW(pB0,6)};pw1=(u32x4){PKW(pB0,8),PKW(pB0,10),PKW(pB0,12),PKW(pB0,14)};pw2=(u32x4){PKW(pB1,0),PKW(pB1,2),PKW(pB1,4),PKW(pB1,6)};pw3=(u32x4){PKW(pB1,8),PKW(pB1,10),PKW(pB1,12),PKW(pB1,14)};
    SBAR(); pv(o,vb0+sl_cur,PAF(0),PAF(1),PAF(2),PAF(3)); }
  #undef PKW
  #undef PAF
  #undef VFR
  #undef PIN
  #undef MX3
  #undef GAPA
  #undef GAPB
  #undef EX
  #undef VRD
  #undef KRD
  #undef STEP
  #undef ENDW
  {auto rr=__builtin_amdgcn_permlane32_swap(__float_as_uint(l_reg),__float_as_uint(l_reg),false,false);l_reg=__uint_as_float(rr[0])+__uint_as_float(rr[1]);}
  if(hi==0)wsf[32+r32]=l_reg;asm volatile("s_waitcnt lgkmcnt(0)":::"memory");
  float rli[16];
  #pragma unroll
  for(int r=0;r<16;++r)rli[r]=__builtin_amdgcn_rcpf(wsf[32+crow(r,hi)]);
  bf16*Ow=O+(rowbase+q0+wid*QBLK)*DM+h*D;
  { bf16*stg=(bf16*)(shm+LDS_OST)+wid*2048;
    #pragma unroll
    for(int r=0;r<16;++r){const int orow=crow(r,hi);
      #pragma unroll
      for(int d0=0;d0<2;++d0)stg[orow*64+d0*32+r32]=__float2bfloat16(o[d0][r]*rli[r]);}
    asm volatile("s_waitcnt lgkmcnt(0)":::"memory");
    #pragma unroll
    for(int i=0;i<4;++i){const int row=i*8+(lane>>3),ch=lane&7; const u32x4 v=*(const u32x4*)(stg+row*64+ch*8); ATTN_STORE16(Ow+(long)row*DM+ch*8,v);} }
  asm volatile("s_waitcnt lgkmcnt(0)\n\ts_barrier":::"memory");
  #undef DMA_K
  #undef DMA_V
  #undef CMASK
  #undef START
  #undef RESC
  #undef ROT
}
constexpr int F_LDS_K=0, F_LDS_V=4*SLOTB, F_LDS_OST=8*SLOTB, F_LDS_BYTES=F_LDS_OST+NW*4096;
__device__ __forceinline__ void attn_unit_fast(int wv,int b,int h,int qb,const unsigned char*Q,const unsigned char*__restrict__ K,const unsigned char*__restrict__ VT,bf16*O,char*shm,float cref){
  const int lane=mk_lane(),r32=lane&31,hi=lane>>5; const int wid=wv; const bool kwave=wid<4;
  const long rowbase=(long)b*SEQ; const long rowk=(long)b*LKV; const int q0=qb*QB;
  const unsigned char*Qw=Q+(rowbase+q0+wid*QBLK)*DM+h*D;
  const unsigned char*Kh=K+rowk*KVP+(h>>2)*D;
  const unsigned char*Vh=VT+(long)((b*4+(h>>2))*D)*LKV;
  const unsigned lds0=(unsigned)(uintptr_t)shm;
  const unsigned char*ksrc=Kh+(long)lane*KVP+(wid&3)*16;
  const unsigned char*vsrc=Vh+(long)lane*LKV+(wid&3)*16;
  const unsigned kdst=lds0+F_LDS_K+(wid&3)*1024, vdst=lds0+F_LDS_V+(wid&3)*1024;
  #define SL4(t) (((t)&3)*SLOTB)
  #define DMA_K(t) glds16(ksrc+(long)(t)*KVBLK*KVP,(unsigned)__builtin_amdgcn_readfirstlane(kdst+SL4(t)))
  #define DMA_V(t) glds16(vsrc+(long)(t)*KVBLK,(unsigned)__builtin_amdgcn_readfirstlane(vdst+SL4(t)))
  v8i_t kf0,kf1,vf0,vf1;
  const lds_cptr shm3=(lds_cptr)shm; const lds_cptr kp0=shm3+F_LDS_K+hi*2048+r32*16; const lds_cptr vp0=shm3+F_LDS_V+hi*2048+r32*16;
  constexpr int NT=LKV/KVBLK;
  if(kwave){DMA_K(0);DMA_K(1);DMA_K(2);DMA_K(3);} else {DMA_V(0);DMA_V(1);}
  v8i_t q8; { const u32x4 a_=*reinterpret_cast<const u32x4*>(&Qw[(long)r32*DM+hi*32]),b_=*reinterpret_cast<const u32x4*>(&Qw[(long)r32*DM+hi*32+16]);
    q8=(v8i_t){(int)a_.x,(int)a_.y,(int)a_.z,(int)a_.w,(int)b_.x,(int)b_.y,(int)b_.z,(int)b_.w}; }
  f32x16 o[2];o[0]=f32x16{};o[1]=f32x16{};f32x16 lacc=f32x16{};
  f32x16 negc; { const float nc_=-cref; negc=(f32x16){nc_,nc_,nc_,nc_,nc_,nc_,nc_,nc_,nc_,nc_,nc_,nc_,nc_,nc_,nc_,nc_}; } asm volatile("":"+v"(negc));
  v8i_t ones8; { const int o_=0x38383838; ones8=(v8i_t){o_,o_,o_,o_,o_,o_,o_,o_}; } asm volatile("":"+v"(ones8));
  f32x16 pA0,pA1,pB0,pB1;
  #define KLD8(dst,kp) do{ const u32x4 a_=*(const __attribute__((address_space(3))) u32x4*)(kp),b_=*(const __attribute__((address_space(3))) u32x4*)((kp)+1024); \
    dst=(v8i_t){(int)a_.x,(int)a_.y,(int)a_.z,(int)a_.w,(int)b_.x,(int)b_.y,(int)b_.z,(int)b_.w}; }while(0)
  #define MFQK(a,b) __builtin_amdgcn_mfma_scale_f32_32x32x64_f8f6f4(a,b,negc,0,0,0,KSC8,0,QSC8)
  #define MFPV(p,v,c) __builtin_amdgcn_mfma_scale_f32_32x32x64_f8f6f4(p,v,c,1,0,0,0x7F7F7F7F,0,VSC8)
  #define MFPL(p,c) __builtin_amdgcn_mfma_scale_f32_32x32x64_f8f6f4(p,ones8,c,1,0,0,0x7F7F7F7F,0,0x7F7F7F7F)
  WAIT_BAR(2);
  KLD8(kf0,kp0); KLD8(kf1,kp0+512); pA0=MFQK(kf0,q8); pA1=MFQK(kf1,q8);
  _Pragma("unroll") for(int r=0;r<16;++r){pA0[r]=__builtin_amdgcn_exp2f(pA0[r]);pA1[r]=__builtin_amdgcn_exp2f(pA1[r]);}
  WAIT_BAR(2);
  if(kwave){DMA_K(4);} else {DMA_V(2);}
  WAIT_BAR(2);
  KLD8(kf0,kp0+SL4(1)); KLD8(kf1,kp0+SL4(1)+512);
  v8i_t p8;
  #define PK8(P,B,old,hi_) __builtin_amdgcn_cvt_pk_bf8_f32(P[B],P[B+1],old,hi_)
  #define PIN(x) asm volatile("":"+v"(x))
  #define EX(v) __builtin_amdgcn_exp2f(v)
  #define EXN(X,B,N) do{ _Pragma("unroll") for(int e_=0;e_<(N);++e_) X[(B)+e_]=EX(X[(B)+e_]); PIN(X); }while(0)
  #define UND(w_) asm volatile("":"=v"(w_))
  #define PK4(P,B,d) do{ int w_; UND(w_); w_=PK8(P,B,w_,false); w_=PK8(P,(B)+2,w_,true); p8[d]=w_; }while(0)
  const int sc_one=0x7F7F7F7F, sc_k=KSC8, sc_q=QSC8, sc_v=VSC8;
  #define AQK(C,kf,PT) asm volatile("v_mfma_scale_f32_32x32x64_f8f6f4 %0, %2, %3, %4, %5, %6 op_sel_hi:[0,0,0]" : "=&v"(C), "+v"(PT) : "v"(kf), "v"(q8), "v"(negc), "v"(sc_k), "v"(sc_q))
  #define APV(O,vf,CT) asm volatile("v_mfma_scale_f32_32x32x64_f8f6f4 %0, %2, %3, %0, %4, %5 op_sel_hi:[0,0,0] cbsz:1" : "+v"(O), "+v"(CT) : "v"(p8), "v"(vf), "v"(sc_one), "v"(sc_v))
  #define APL(CT) asm volatile("v_mfma_scale_f32_32x32x64_f8f6f4 %0, %2, %3, %0, %4, %4 op_sel_hi:[0,0,0] cbsz:1" : "+v"(lacc), "+v"(CT) : "v"(p8), "v"(ones8), "v"(sc_one))
  #define STEP(C0,C1,P0,P1,t,GK,GV,GL) do{ SBAR(); \
    AQK(C0,kf0,P0); PK4(P0,0,0); PK4(P0,4,1); PK4(P0,8,2); PK4(P0,12,3); KLD8(vf0,vp0+SL4((t)-1)); PIN(p8); SBAR(); \
    AQK(C1,kf1,P1); PK4(P1,0,4); PK4(P1,4,5); PK4(P1,8,6); PK4(P1,12,7); KLD8(vf1,vp0+SL4((t)-1)+512); PIN(p8); SBAR(); \
    if(kwave){ if(GK){DMA_K((t)+4);} } else { if(GV){DMA_V((t)+2);} } SBAR(); \
    APV(o[0],vf0,C0); EXN(C0,0,8); SBAR(); \
    APV(o[1],vf1,C0); EXN(C0,8,8); if(GL){ KLD8(kf0,kp0+SL4((t)+1)); } SBAR(); \
    APL(C1); EXN(C1,0,8); if(GL){ KLD8(kf1,kp0+SL4((t)+1)+512); } SBAR(); \
    EXN(C1,8,8); SBAR(); \
    }while(0)
  int t=1;
  asm volatile(".p2align 6\n\t.rept 15\n\ts_nop 0\n\t.endr");
  for(;t+5<NT;t+=2){
    STEP(pB0,pB1,pA0,pA1,t,true,true,true);     WAIT_BAR(2);
    STEP(pA0,pA1,pB0,pB1,t+1,true,true,true);   WAIT_BAR(2);
  }
  #define ENDW(i) do{ const int n_=kwave?((((i)+4<NT)?1:0)+(((i)+3<NT)?1:0)):((((i)+2<NT)?1:0)+(((i)+1<NT)?1:0)); if(n_==2){WAIT_BAR(2);} else if(n_==1){WAIT_BAR(1);} else {WAIT_BAR(0);} }while(0)
  for(;t+1<NT;t+=2){
    STEP(pB0,pB1,pA0,pA1,t,(t+4<NT),(t+2<NT),(t+1<NT));       ENDW(t);
    STEP(pA0,pA1,pB0,pB1,t+1,(t+5<NT),(t+3<NT),(t+2<NT));     ENDW(t+1);
  }
  STEP(pB0,pB1,pA0,pA1,NT-1,false,false,false); WAIT_BAR(0);
  { int w_=0; w_=PK8(pB0,0,w_,false); w_=PK8(pB0,2,w_,true); p8[0]=w_; w_=PK8(pB0,4,w_,false); w_=PK8(pB0,6,w_,true); p8[1]=w_; w_=PK8(pB0,8,w_,false); w_=PK8(pB0,10,w_,true); p8[2]=w_; w_=PK8(pB0,12,w_,false); w_=PK8(pB0,14,w_,true); p8[3]=w_;
    w_=PK8(pB1,0,w_,false); w_=PK8(pB1,2,w_,true); p8[4]=w_; w_=PK8(pB1,4,w_,false); w_=PK8(pB1,6,w_,true); p8[5]=w_; w_=PK8(pB1,8,w_,false); w_=PK8(pB1,10,w_,true); p8[6]=w_; w_=PK8(pB1,12,w_,false); w_=PK8(pB1,14,w_,true); p8[7]=w_;
    KLD8(vf0,vp0+SL4(NT-1)); KLD8(vf1,vp0+SL4(NT-1)+512);
    o[0]=MFPV(p8,vf0,o[0]); o[1]=MFPV(p8,vf1,o[1]); lacc=MFPL(p8,lacc); }
  #undef PK8
  #undef PIN
  #undef EX
  #undef EXN
  #undef STEP
  #undef UND
  #undef PK4
  #undef AQK
  #undef APV
  #undef APL
  #undef ENDW
  asm volatile("s_nop 15\n\ts_nop 15":"+v"(o[0]),"+v"(o[1]),"+v"(lacc));
  float rli[16];
  #pragma unroll
  for(int r=0;r<16;++r)rli[r]=__builtin_amdgcn_rcpf(lacc[r]);
  bf16*Ow=O+(rowbase+q0+wid*QBLK)*DM+h*D;
  { bf16*stg=(bf16*)(shm+F_LDS_OST)+wid*2048;
    #pragma unroll
    for(int r=0;r<16;++r){const int orow=crow(r,hi);
      #pragma unroll
      for(int d0=0;d0<2;++d0)stg[orow*64+d0*32+r32]=__float2bfloat16(o[d0][r]*rli[r]);}
    asm volatile("s_waitcnt lgkmcnt(0)":::"memory");
    #pragma unroll
    for(int i=0;i<4;++i){const int row=i*8+(lane>>3),ch=lane&7; const u32x4 v=*(const u32x4*)(stg+row*64+ch*8); ATTN_STORE16(Ow+(long)row*DM+ch*8,v);} }
  asm volatile("s_waitcnt lgkmcnt(0)\n\ts_barrier":::"memory");
  #undef KLD8
  #undef MFQK
  #undef MFPV
  #undef MFPL
  #undef DMA_K
  #undef DMA_V
  #undef SL4
}

constexpr int ATTN_LDS_BYTES=LDS_BYTES;
struct AttnTensors { const bf16* Q; const bf16* K; const bf16* V; bf16* O; const unsigned char* Q8; const unsigned char* K8; const unsigned char* VT8; float cref; };
struct AttnUnit { int bh; int qb; };
struct StaticOrder {
  int vcu, G;
  __device__ __forceinline__ explicit StaticOrder(int grid,int block):vcu((grid%8==0)?(block%8)*(grid/8)+block/8:block),G(grid){}
  __device__ __forceinline__ bool next(int i,AttnUnit&u)const{
    if(G==256){ if(i>=8)return false; const int bkv=vcu>>5,j=vcu&31,un=i*32+j; u.bh=(bkv>>2)*16+(bkv&3)*4+(un>>6); u.qb=un&63; return true; }
    const int un=i*G+vcu; if(un>=BATCH*NHEAD*NQB)return false; u.bh=un/NQB; u.qb=un%NQB; return true; }
  __device__ __forceinline__ void a_ready(const AttnUnit&)const{}
  __device__ __forceinline__ void done(const AttnUnit&)const{}
};
template<class Sched,int THRL=8> __device__ __forceinline__ void attn_phase(char*lds,const AttnTensors&T,const Sched&S,bool fast,int wv){
  AttnUnit u;
  if(fast){ for(int i=0;S.next(i,u);++i){ S.a_ready(u); attn_unit_fast(wv,u.bh/NHEAD,u.bh%NHEAD,u.qb,T.Q8,T.K8,T.VT8,T.O,lds,T.cref); S.done(u); } }
  else{ for(int i=0;S.next(i,u);++i){ S.a_ready(u); attn_unit<THRL>(wv,u.bh/NHEAD,u.bh%NHEAD,u.qb,T.Q,T.K,T.V,T.O,lds); S.done(u); } }
}
#undef SBAR
#undef WAIT_BAR
}
constexpr int NWAVES = 8;
#ifndef MK_REPEAT
#define MK_REPEAT 0
#endif
#ifndef MK_FP8_DENSE
#define MK_FP8_DENSE 1
#endif
#ifndef MK_N_LAUNCHES
#define MK_N_LAUNCHES 1
#endif
constexpr int PER_PHASE = 17;
constexpr int N_LAUNCHES = MK_N_LAUNCHES;

constexpr int D = 1024, LSEQ = 16384, NBATCH = 2, TT = NBATCH * LSEQ, CTXL = 256, NCTX = NBATCH * CTXL, MT = TT + NCTX;
constexpr int FF = 2816, NE = 8, NQKV = 1536, LKV = LSEQ + CTXL;
constexpr int NPX = TT / 256, NPT = MT / 256;
constexpr int CAPP = (2 * TT) / 256 + NE;
constexpr float FP8_SA = 4.0f, FP8_SW = 64.0f, FP8_SH = 4.0f;
constexpr float NORM_EPS = 1e-6f;
constexpr float QSCALE = 0.125f * 1.4426950408889634f;

constexpr size_t MiB = 1u << 20, KiB = 1u << 10;
constexpr size_t WS_CTL = 0, CTL_ZERO_BYTES = 1 * MiB;
constexpr size_t WS_PART = 1 * MiB;
constexpr size_t WS_MODS = 3 * MiB;
constexpr size_t WS_RSTD = 3 * MiB + 256 * KiB;
constexpr size_t WS_ROPE = 3 * MiB + 512 * KiB;
constexpr size_t WS_EID = 3 * MiB + 640 * KiB, WS_GATE = 2 * MiB + 768 * KiB, WS_SLOT = 2 * MiB + 256 * KiB, WS_PEXP = 2 * MiB + 512 * KiB;
constexpr size_t WS_CNTW = 3 * MiB + 896 * KiB;
constexpr size_t WS_CTXB = 4 * MiB;
constexpr size_t WS_W13M = 8 * MiB, WS_W2M = 52 * MiB;
constexpr size_t WS_W13F = 74 * MiB, WS_W2F = 85 * MiB;
constexpr size_t WS_WQKV = 91 * MiB, WS_WO = 94 * MiB, WS_POOL = 96 * MiB;
constexpr size_t WS_XS = 98 * MiB;
constexpr size_t WS_BIG = 230 * MiB;
constexpr size_t WS_Q = WS_BIG, WS_K = WS_BIG + 64 * MiB, WS_V = WS_BIG + 81 * MiB, WS_QN = WS_BIG + 100 * MiB, WS_VT = WS_BIG + 140 * MiB, WS_KN = WS_BIG + 164 * MiB, WS_O = WS_BIG;
constexpr size_t WS_SSQ1 = 412 * MiB, WS_SSQ2 = 415 * MiB, WS_B13 = 418 * MiB, WS_BQ = 418 * MiB + 128 * KiB;
constexpr size_t WS_A1 = WS_XS + 66 * MiB;
constexpr size_t WS_X3B = 419 * MiB;
constexpr size_t WS_END = 483 * MiB;
static_assert(WS_W13M + (size_t)NE * 5632 * 1024 <= WS_W2M && WS_W2M + (size_t)NE * 1024 * 2816 <= WS_W13F && WS_W13F + (size_t)5632 * 1024 * 2 <= WS_W2F && WS_W2F + (size_t)1024 * 2816 * 2 <= WS_WQKV && WS_POOL + 4 * 65536 * 2 <= WS_XS, "ws map 1");
static_assert(WS_XS + (size_t)CAPP * 256 * 1024 * 2 <= WS_BIG && WS_XS + (size_t)TT * 1024 * 4 <= WS_BIG && WS_BIG + (size_t)CAPP * 256 * 2816 <= WS_END && WS_BIG + (size_t)MT * FF * 2 <= WS_END, "ws map 2");
static_assert(WS_K + (size_t)NBATCH * LKV * 256 * 2 <= WS_V && WS_Q + (size_t)TT * 1024 * 2 <= WS_K && WS_V + (size_t)NBATCH * LKV * 256 * 2 <= WS_QN && WS_QN + (size_t)TT * 1024 * 2 <= WS_KN && WS_QN + (size_t)MT * 1024 * 2 <= WS_END && WS_KN + (size_t)NBATCH * LKV * 256 * 2 <= WS_END, "ws map 3");
constexpr int CW_TMO = 0, CW_CODE = 1;
constexpr int CW_BAR = 4096;
constexpr int CW_CNT = 16384, CW_FILL = 16384 + 64 * 8;

constexpr int RING_OFF = 0, RING_BYTES = 131072;
constexpr int LDSCTL_OFF = RING_BYTES, MISC_OFF = LDSCTL_OFF + 320;
constexpr int LDS_BYTES = 147456;
static_assert(MISC_OFF + 128 <= LDS_BYTES, "LDS map");

#define GAS __attribute__((address_space(1)))
#define LAS __attribute__((address_space(3)))
typedef unsigned short bf16;
typedef unsigned v4u __attribute__((ext_vector_type(4)));
typedef float f32x4 __attribute__((ext_vector_type(4)));
typedef short bf16x8 __attribute__((ext_vector_type(8)));
typedef GAS unsigned gu32;
typedef GAS unsigned long long gu64;
#define RLX_AGENT __ATOMIC_RELAXED, __HIP_MEMORY_SCOPE_AGENT
#define LDS_WAIT() asm volatile("s_waitcnt lgkmcnt(0)" ::: "memory")
#define VM_WAIT() asm volatile("s_waitcnt vmcnt(0)" ::: "memory")
__device__ __forceinline__ unsigned long long rt() { return __builtin_amdgcn_s_memrealtime(); }
__device__ __forceinline__ unsigned f2bf(float f) { unsigned u = __builtin_bit_cast(unsigned, f); return (u + 0x7fffu + ((u >> 16) & 1u)) >> 16; }
__device__ __forceinline__ unsigned pk2(float lo, float hi) { return f2bf(lo) | (f2bf(hi) << 16); }

#define XB_TMO      128
#define XB_XCNT(j)  (256  + 64 * (j))
#define XB_XSUB(j)  (1280 + 64 * (j))
#define XB_XGEN(j)  (2304 + 64 * (j))
#define XB_TOP      3328
#define XB_TOPGEN   3392
#define XCD_BAR_WORDS 3456
#define XB_SPIN_CAP (1u << 18)

__device__ __forceinline__ unsigned xb_ld(unsigned* p)              { return __hip_atomic_load(p, __ATOMIC_RELAXED, __HIP_MEMORY_SCOPE_AGENT); }
__device__ __forceinline__ unsigned xb_add(unsigned* p, unsigned v) { return __hip_atomic_fetch_add(p, v, __ATOMIC_RELAXED, __HIP_MEMORY_SCOPE_AGENT); }
__device__ __forceinline__ unsigned xb_xcc_id() { return (unsigned)__builtin_amdgcn_s_getreg((3 << 11) | 20) & 0xFu; }
#define XB_SPIN(cond, bar) do { unsigned _sp = 0; while (cond) { __builtin_amdgcn_s_sleep(1); \
    if ((++_sp & 255u) == 0u) { if (xb_ld(&(bar)[XB_TMO])) break; if (_sp > XB_SPIN_CAP) { atomicAdd(&(bar)[XB_TMO], 1u); break; } } } } while (0)

struct XcdBarrier {
    unsigned* bar; unsigned x; int w;
    volatile LAS unsigned* st;
};

__device__ __forceinline__ XcdBarrier xcd_barrier_post(unsigned* bar, volatile LAS unsigned* st, int wave) {
    XcdBarrier b; b.bar = bar; b.x = xb_xcc_id(); b.st = st; b.w = wave;
    if (b.w == 0 && mk_lane() == 0) (void)xb_add(&bar[XB_XCNT(b.x)], 1u);
    return b;
}
__device__ __forceinline__ void xcd_barrier_complete(unsigned* bar, unsigned x, unsigned& nloc, unsigned& nx) {
    const unsigned G = gridDim.x * gridDim.y * gridDim.z;
    unsigned sum, cnt, mine, sp = 0u;
    for (;;) {
        sum = 0u; cnt = 0u; mine = 0u;
#pragma unroll
        for (unsigned j = 0; j < 16; ++j) { const unsigned c = xb_ld(&bar[XB_XCNT(j)]); sum += c; cnt += (c > 0u) ? 1u : 0u; mine = (j == x) ? c : mine; }
        if (sum == G) break;
        __builtin_amdgcn_s_sleep(1);
        if ((++sp & 255u) == 0u) { if (xb_ld(&bar[XB_TMO])) break; if (sp > XB_SPIN_CAP) { atomicAdd(&bar[XB_TMO], 1u); break; } }
    }
    nloc = mine > 0u ? mine : 1u; nx = cnt > 0u ? cnt : 1u;
}

__device__ __forceinline__ void xcd_barrier(const XcdBarrier& b) {
    asm volatile("s_waitcnt vmcnt(0)" ::: "memory");
    __syncthreads();
    if (b.w == 0 && mk_lane() == 0) {
        unsigned* bar = b.bar;
        __builtin_amdgcn_s_waitcnt(0);
        unsigned nloc = b.st[0], nx = b.st[1];
        if (nloc == 0u) { xcd_barrier_complete(bar, b.x, nloc, nx); b.st[0] = nloc; b.st[1] = nx; }
        const unsigned old = xb_add(&bar[XB_XSUB(b.x)], 1u);
        const unsigned gen = old / nloc;
        if (old + 1u == (gen + 1u) * nloc) {
            __builtin_amdgcn_fence(__ATOMIC_RELEASE, "agent");
            asm volatile("s_waitcnt vmcnt(0)" ::: "memory");
            const unsigned og = xb_add(&bar[XB_TOP], 1u);
            const unsigned tg = og / nx;
            if (og + 1u == (tg + 1u) * nx) xb_add(&bar[XB_TOPGEN], 1u);
            else XB_SPIN(xb_ld(&bar[XB_TOPGEN]) == tg, bar);
            __builtin_amdgcn_fence(__ATOMIC_ACQUIRE, "agent");
            xb_add(&bar[XB_XGEN(b.x)], 1u);
            asm volatile("s_waitcnt vmcnt(0)" ::: "memory");
        } else {
            XB_SPIN(xb_ld(&bar[XB_XGEN(b.x)]) == gen, bar);
            __builtin_amdgcn_fence(__ATOMIC_ACQUIRE, "agent");
            asm volatile("s_waitcnt vmcnt(0)" ::: "memory");
        }
    }
    __syncthreads();
}

struct Frame {
    LAS unsigned char* lds;
    volatile LAS unsigned* MISC;
    gu32* ctl;
    int tid, lane, wave;
    int vcu, G;
    unsigned char* ws;
    const float* in[21]; float* out;
};
__device__ __forceinline__ float wave_sum(float v) {
#pragma unroll
    for (int o = 1; o < 64; o <<= 1) v += __shfl_xor(v, o);
    return v;
}
__device__ __forceinline__ float bf_lo(unsigned w) { return __builtin_bit_cast(float, w << 16); }
__device__ __forceinline__ float bf_hi(unsigned w) { return __builtin_bit_cast(float, w & 0xffff0000u); }
__device__ __forceinline__ float silu_acc(float a) { return a / (1.0f + expf(-a)); }
__device__ __forceinline__ const float* row_src(const float* xs, const float* cs, int r) { return r < TT ? xs + (size_t)r * D : cs + (size_t)(r - TT) * D; }
__device__ __forceinline__ int row_kind(int r) { return r < LSEQ ? 0 : (r < TT ? 1 : 2); }

__device__ __forceinline__ void tr_item(const float* W, int N, int k0, int n0, bf16* WT, int ldt, int drow0, LAS float* scr, int lane) {
#pragma unroll 8
    for (int i = 0; i < 32; ++i) { const int kk = 2 * i + (lane >> 5); scr[kk * 33 + (lane & 31)] = W[(size_t)(k0 + kk) * N + n0 + (lane & 31)]; }
    LDS_WAIT(); asm volatile("" ::: "memory");
    const int c = lane & 7;
#pragma unroll
    for (int j = 0; j < 4; ++j) { const int n = (lane >> 3) + 8 * j; const LAS float* s = scr + (8 * c) * 33 + n;
        v4u o; o.x = pk2(s[0 * 33], s[1 * 33]); o.y = pk2(s[2 * 33], s[3 * 33]); o.z = pk2(s[4 * 33], s[5 * 33]); o.w = pk2(s[6 * 33], s[7 * 33]);
        *(GAS v4u*)(WT + (size_t)(drow0 + n) * ldt + k0 + 8 * c) = o; }
    LDS_WAIT(); asm volatile("" ::: "memory");
}
__device__ __forceinline__ void tr_item8(const float* W, int N, int k0, int n0, unsigned char* WT, int ldt, int drow0, LAS float* scr, int lane) {
#pragma unroll 8
    for (int i = 0; i < 32; ++i) { const int kk = 2 * i + (lane >> 5); scr[kk * 33 + (lane & 31)] = W[(size_t)(k0 + kk) * N + n0 + (lane & 31)] * FP8_SW; }
    LDS_WAIT(); asm volatile("" ::: "memory");
    const int c = lane & 7;
#pragma unroll
    for (int j = 0; j < 4; ++j) { const int n = (lane >> 3) + 8 * j; const LAS float* s = scr + (8 * c) * 33 + n;
        const unsigned long long o = (unsigned long long)pg8::pk4_fp8(s[0 * 33], s[1 * 33], s[2 * 33], s[3 * 33]) | ((unsigned long long)pg8::pk4_fp8(s[4 * 33], s[5 * 33], s[6 * 33], s[7 * 33]) << 32);
        *(GAS unsigned long long*)(WT + (size_t)(drow0 + n) * ldt + k0 + 8 * c) = o; }
    LDS_WAIT(); asm volatile("" ::: "memory");
}
__device__ __forceinline__ void tr_w13(const float* W, bf16* WT, int which, int q, LAS float* scr, int lane) {
    const int kb = q / 88, nb = q % 88, n0 = 32 * nb;
    tr_item(W, FF, 64 * kb, n0, WT, D, (n0 >> 7) * 256 + (n0 & 127) + which * 128, scr, lane);
}
__device__ __forceinline__ void tr_w2(const float* W, bf16* WT, int q, LAS float* scr, int lane) {
    const int kb = q >> 5, nb = q & 31;
    tr_item(W, D, 64 * kb, 32 * nb, WT, FF, 32 * nb, scr, lane);
}

__device__ __forceinline__ void p0_phase(Frame& F) {
    LAS float* scr = (LAS float*)(F.lds + RING_OFF + F.wave * 16384);
    const int gw = F.vcu * NWAVES + F.wave, NGW = F.G * NWAVES;
    static_assert(NWAVES == 8, "adaLN k-splits = the waves of a workgroup");
    for (int task = gw; task < 2 * 96 * 8; task += NGW) {
        const int ks = task & 7, cg = (task >> 3) % 96, layer = task / 768, k0 = ks * 128, col = cg * 64 + F.lane;
        float sa[3][2];
#pragma unroll
        for (int v = 0; v < 3; ++v)
#pragma unroll
            for (int h = 0; h < 2; ++h) { const float* cv = v < 2 ? F.in[1] + v * D : F.in[3]; sa[v][h] = silu_acc(cv[k0 + h * 64 + F.lane]); }
        const float* W = F.in[4] + (size_t)layer * D * 6144 + (size_t)k0 * 6144 + col;
        float a0 = 0.f, a1 = 0.f, a2 = 0.f;
#pragma unroll
        for (int h = 0; h < 2; ++h)
#pragma unroll 8
            for (int kk = 0; kk < 64; ++kk) { const float w = W[(size_t)(h * 64 + kk) * 6144];
                a0 += __shfl(sa[0][h], kk) * w; a1 += __shfl(sa[1][h], kk) * w; a2 += __shfl(sa[2][h], kk) * w; }
        LAS float* red = (LAS float*)(F.lds + RING_OFF);
        red[(ks * 3 + 0) * 64 + F.lane] = a0; red[(ks * 3 + 1) * 64 + F.lane] = a1; red[(ks * 3 + 2) * 64 + F.lane] = a2;
        __syncthreads();
        if (ks < 3) { float sacc = F.in[5][layer * 6144 + col];
#pragma unroll
            for (int q = 0; q < 8; ++q) sacc += red[(q * 3 + ks) * 64 + F.lane];
            ((float*)(F.ws + WS_MODS))[layer * 18432 + ks * 6144 + col] = sacc; }
        __syncthreads();
    }
    constexpr int I_POOL = 4 * 4 * 8, I_13 = 16 * 88, I_2 = 44 * 32, I_QKV = 16 * 48, I_O = 16 * 32;
    constexpr int NITEMS = I_POOL + 2 * I_13 + I_2 + I_QKV + I_O;
    for (int it = gw; it < NITEMS; it += NGW) {
        int r = it;
        if (r < I_POOL) { const int g = r >> 5, q = r & 31; tr_item(F.in[7] + (size_t)g * 65536, 256, 64 * (q >> 3), 32 * (q & 7), (bf16*)(F.ws + WS_POOL) + (size_t)g * 65536, 256, 32 * (q & 7), scr, F.lane); continue; } r -= I_POOL;
        if (r < I_13) { tr_w13(F.in[9], (bf16*)(F.ws + WS_W13F), 0, r, scr, F.lane); continue; } r -= I_13;
        if (r < I_13) { tr_w13(F.in[10], (bf16*)(F.ws + WS_W13F), 1, r, scr, F.lane); continue; } r -= I_13;
        if (r < I_2) { if (MK_FP8_DENSE) { const int kb = r >> 5, nb = r & 31; tr_item8(F.in[11], D, 64 * kb, 32 * nb, F.ws + WS_W2F, FF, 32 * nb, scr, F.lane); } else tr_w2(F.in[11], (bf16*)(F.ws + WS_W2F), r, scr, F.lane); continue; } r -= I_2;
        if (r < I_QKV) { const int kb = r / 48, nb = r % 48; if (MK_FP8_DENSE) tr_item8(F.in[12], NQKV, 64 * kb, 32 * nb, F.ws + WS_WQKV, D, 32 * nb, scr, F.lane); else tr_item(F.in[12], NQKV, 64 * kb, 32 * nb, (bf16*)(F.ws + WS_WQKV), D, 32 * nb, scr, F.lane); continue; } r -= I_QKV;
        { const int kb = r >> 5, nb = r & 31; tr_item(F.in[13], D, 64 * kb, 32 * nb, (bf16*)(F.ws + WS_WO), D, 32 * nb, scr, F.lane); }
    }
    float* RS = (float*)(F.ws + WS_RSTD);
    for (int r = gw; r < MT; r += NGW) {
        const GAS f32x4* xr = (const GAS f32x4*)row_src(F.in[0], F.in[2], r) + F.lane; float s = 0.f;
#pragma unroll
        for (int j = 0; j < 4; ++j) { const f32x4 v = xr[64 * j]; s += (v.x * v.x + v.y * v.y) + (v.z * v.z + v.w * v.w); }
        s = wave_sum(s);
        if (F.lane == 0) RS[r] = 1.0f / sqrtf(s * (1.0f / D) + NORM_EPS);
    }
    { const int gt = (F.vcu * NWAVES + F.wave) * 64 + F.lane;
      if (gt < 4096) { const int pos = gt >> 4, i = gt & 15; const float fr = powf(10000.0f, -(float)i * (1.0f / 16.0f)); const float ang = (float)pos * fr;
          float2* RT = (float2*)(F.ws + WS_ROPE); RT[gt] = make_float2(cosf(ang), sinf(ang)); } }
}
__device__ __forceinline__ void p1_phase(Frame& F) {
    LAS float* scr = (LAS float*)(F.lds + RING_OFF + F.wave * 16384);
    const int gw = F.vcu * NWAVES + F.wave, NGW = F.G * NWAVES;
    { const int gt = gw * 64 + F.lane;
      if (gt < 2 * 3 * 6144) { const int layer = gt / 18432, v = (gt % 18432) / 6144, n = gt % 6144; const float* PART = (const float*)(F.ws + WS_PART);
          float s = F.in[5][layer * 6144 + n];
#pragma unroll
          for (int ks = 0; ks < 8; ++ks) s += PART[(size_t)((layer * 8 + ks) * 3 + v) * 6144 + n];
          ((float*)(F.ws + WS_MODS))[gt] = s; } }
}
__device__ __forceinline__ void moe_weights_phase(Frame& F, int w, int NW, int it_lo, int it_hi) {
    LAS float* scr = (LAS float*)(F.lds + RING_OFF + F.wave * 16384);
    for (int it = it_lo + w; it < it_hi; it += NW) {
        const int e = it / 4224, r = it % 4224, m = r / 1408, q = r % 1408;
        if (m < 2) { const int kb = q / 88, nb = q % 88, n0 = 32 * nb;
            tr_item8((m == 0 ? F.in[17] : F.in[18]) + (size_t)e * D * FF, FF, 64 * kb, n0, F.ws + WS_W13M + (size_t)e * 5632 * D, D, (n0 >> 7) * 256 + (n0 & 127) + m * 128, scr, F.lane); }
        else { const int kb = q >> 5, nb = q & 31; tr_item8(F.in[19] + (size_t)e * FF * D, D, 64 * kb, 32 * nb, F.ws + WS_W2M + (size_t)e * D * FF, FF, 32 * nb, scr, F.lane); }
    }
}
struct RowSpan { int s0, Ls, t0, n; };
__device__ __forceinline__ RowSpan row_span(int gw, int NGW) {
    const int W0 = (NGW * 63) >> 7, Wr = NGW - 2 * W0, Wc0 = Wr >> 1, Wc1 = Wr - Wc0;
    int sq, i, W;
    if (gw < W0) { sq = 0; i = gw; W = W0; } else if (gw < 2 * W0) { sq = 1; i = gw - W0; W = W0; } else if (gw < 2 * W0 + Wc0) { sq = 2; i = gw - 2 * W0; W = Wc0; } else { sq = 3; i = gw - 2 * W0 - Wc0; W = Wc1; }
    RowSpan sp; sp.Ls = sq < 2 ? LSEQ : CTXL; sp.s0 = sq == 0 ? 0 : (sq == 1 ? LSEQ : (sq == 2 ? TT : TT + CTXL));
    const int lo = (int)(((long)i * sp.Ls) / W), hi = (int)(((long)(i + 1) * sp.Ls) / W);
    sp.t0 = lo; sp.n = hi - lo; return sp;
}
__device__ __forceinline__ void p2_pooldiff(Frame& F) {
    const int gw = F.vcu * NWAVES + F.wave, NGW = F.G * NWAVES, lane = F.lane;
    const float* RS = (const float*)(F.ws + WS_RSTD); const float* MODS = (const float*)(F.ws + WS_MODS);
    bf16* Dm = (bf16*)(F.ws + WS_XS);
    const RowSpan sp = row_span(gw, NGW);
    for (int c0 = 0; c0 < sp.n; c0 += 32) {
        const int s0 = sp.s0, Ls = sp.Ls, t0 = sp.t0 + c0, nn = sp.n - c0 < 32 ? sp.n - c0 : 32;
        const int mi = row_kind(s0);
        const GAS f32x4* X0 = (const GAS f32x4*)row_src(F.in[0], F.in[2], s0) + lane;
        f32x4 gm[4];
#pragma unroll
        for (int j = 0; j < 4; ++j) { const f32x4 g = ((const GAS f32x4*)(F.in[6]))[64 * j + lane]; const f32x4 sc = ((const GAS f32x4*)(MODS + (mi * 6 + 1) * D))[64 * j + lane]; gm[j] = g * (sc + 1.0f); }
        int rsv; { int tt = t0 - 9 + lane; tt = tt < 0 ? 0 : (tt >= Ls ? Ls - 1 : tt); rsv = __builtin_bit_cast(int, RS[s0 + tt]); }
#define P2_RS(tt) __builtin_bit_cast(float, __builtin_amdgcn_readlane(rsv, (tt) - (t0 - 9)))
        f32x4 S[4];
#pragma unroll
        for (int j = 0; j < 4; ++j) { const int h = 1 << j; f32x4 acc = {0.f, 0.f, 0.f, 0.f};
#pragma unroll
            for (int k = 0; k < 2 * h; ++k) { const int tt = t0 - h + k; const bool ok = tt >= 0 && tt < Ls; const int tc = ok ? tt : t0; const f32x4 v = X0[(size_t)tc * 256 + 64 * j]; acc = acc + v * (ok ? P2_RS(tc) : 0.f); }
            S[j] = acc; }
        f32x4 n_own[4], n_add[4], n_sub[4];
#pragma unroll
        for (int j = 0; j < 4; ++j) { n_own[j] = X0[(size_t)t0 * 256 + 64 * j]; n_add[j] = n_own[j]; n_sub[j] = n_own[j]; }
        for (int rr = 0; rr < nn; ++rr) {
            const int t = t0 + rr;
            f32x4 c_own[4], c_add[4], c_sub[4];
#pragma unroll
            for (int j = 0; j < 4; ++j) { c_own[j] = n_own[j]; c_add[j] = n_add[j]; c_sub[j] = n_sub[j]; }
            if (rr < nn - 1) {
#pragma unroll
                for (int j = 0; j < 4; ++j) { const int h = 1 << j; const int ta = t + h, tb = t - h;
                    n_own[j] = X0[(size_t)(t + 1) * 256 + 64 * j];
                    n_add[j] = X0[(size_t)(ta < Ls ? ta : t) * 256 + 64 * j]; n_sub[j] = X0[(size_t)(tb >= 0 ? tb : t) * 256 + 64 * j]; } }
            GAS unsigned long long* o8 = (GAS unsigned long long*)(Dm + (size_t)(s0 + t) * D) + lane;
            const float rs = P2_RS(t);
#pragma unroll
            for (int j = 0; j < 4; ++j) { const int h = 1 << j;
                if (rr > 0) { const int ta = t + h - 1, tb = t - h - 1;
                    S[j] = S[j] + c_add[j] * (ta < Ls ? P2_RS(ta) : 0.f) - c_sub[j] * (tb >= 0 ? P2_RS(tb) : 0.f); }
                const int lo = t - h < 0 ? 0 : t - h, hi = t + h > Ls ? Ls : t + h;
                const f32x4 d = (S[j] * (1.0f / (float)(hi - lo)) - c_own[j] * rs) * gm[j];
                o8[64 * j] = (unsigned long long)pk2(d.x, d.y) | ((unsigned long long)pk2(d.z, d.w) << 32); }
        }
#undef P2_RS
    }
}
__device__ __forceinline__ void p2_pooldiff_ring(Frame& F) {
    const int gw = F.vcu * NWAVES + F.wave, NGW = F.G * NWAVES, lane = F.lane;
    const float* RS = (const float*)(F.ws + WS_RSTD); const float* MODS = (const float*)(F.ws + WS_MODS);
    bf16* Dm = (bf16*)(F.ws + WS_XS);
    const int j = gw & 3, h = 1 << j, W = 2 * h;
    const RowSpan sp = row_span(gw >> 2, NGW >> 2);
    const int s0 = sp.s0, Ls = sp.Ls, mi = row_kind(s0);
    LAS f32x4* ring = (LAS f32x4*)(F.lds + RING_OFF + F.wave * 16384) + lane;
    const GAS f32x4* X0 = (const GAS f32x4*)row_src(F.in[0], F.in[2], s0) + lane + 64 * j;
    f32x4 gm; { const f32x4 g = ((const GAS f32x4*)(F.in[6]))[64 * j + lane]; const f32x4 sc = ((const GAS f32x4*)(MODS + (mi * 6 + 1) * D))[64 * j + lane]; gm = g * (sc + 1.0f); }
    for (int c0 = 0; c0 < sp.n; c0 += 96) {
    const int t0 = sp.t0 + c0, n = sp.n - c0 < 96 ? sp.n - c0 : 96;
    const int rb = t0 - 8;
    int rsv0, rsv1; { int tt = rb + lane; tt = tt < 0 ? 0 : (tt >= Ls ? Ls - 1 : tt); rsv0 = __builtin_bit_cast(int, RS[s0 + tt]); tt = rb + 64 + lane; tt = tt < 0 ? 0 : (tt >= Ls ? Ls - 1 : tt); rsv1 = __builtin_bit_cast(int, RS[s0 + tt]); }
#define P2R_RS(r_) __builtin_bit_cast(float, ((r_) - rb) < 64 ? __builtin_amdgcn_readlane(rsv0, ((r_) - rb) & 63) : __builtin_amdgcn_readlane(rsv1, ((r_) - rb) & 63))
#define P2R_LOAD(r_) X0[(size_t)((r_) < 0 ? 0 : ((r_) >= Ls ? Ls - 1 : (r_))) * 256]
#define P2R_SCALE(r_) (((r_) >= 0 && (r_) < Ls) ? P2R_RS(r_) : 0.f)
    f32x4 S = {0.f, 0.f, 0.f, 0.f};
    { f32x4 v[16];
#pragma unroll
      for (int k = 0; k < 16; ++k) if (k < W) v[k] = P2R_LOAD(t0 - h + k);
#pragma unroll
      for (int k = 0; k < 16; ++k) if (k < W) { const int r = t0 - h + k; const f32x4 x = v[k] * P2R_SCALE(r); ring[((r + 64) & (W - 1)) * 64] = x; S = S + x; } }
    f32x4 nx[8];
#pragma unroll
    for (int k = 0; k < 8; ++k) nx[k] = P2R_LOAD(t0 + h + k);
    for (int tb = t0; tb < t0 + n; tb += 8) {
        f32x4 cu[8];
#pragma unroll
        for (int k = 0; k < 8; ++k) cu[k] = nx[k];
        if (tb + 8 < t0 + n) {
#pragma unroll
            for (int k = 0; k < 8; ++k) nx[k] = P2R_LOAD(tb + 8 + h + k); }
#pragma unroll
        for (int k = 0; k < 8; ++k) { const int t = tb + k;
            if (t < t0 + n) {
                const f32x4 own = ring[((t + 64) & (W - 1)) * 64];
                const int lo = t - h < 0 ? 0 : t - h, hi = t + h > Ls ? Ls : t + h;
                const f32x4 d = (S * (1.0f / (float)(hi - lo)) - own) * gm;
                ((GAS unsigned long long*)(Dm + (size_t)(s0 + t) * D) + lane)[64 * j] = (unsigned long long)pk2(d.x, d.y) | ((unsigned long long)pk2(d.z, d.w) << 32);
                const int slot = ((t + h + 64) & (W - 1)) * 64;
                const f32x4 oldv = ring[slot]; const f32x4 newv = cu[k] * P2R_SCALE(t + h);
                S = S + newv - oldv; ring[slot] = newv; } }
    }
    }
#undef P2R_RS
#undef P2R_LOAD
#undef P2R_SCALE
}
__device__ __forceinline__ void bias_dot(const float (&w)[16], const float* shb, int sidx, float* dst, int ld, int nn, int lane) {
#pragma unroll
    for (int kind = 0; kind < 3; ++kind) { const GAS f32x4* sp = (const GAS f32x4*)(shb + (kind * 6 + sidx) * D + 16 * lane); float s = 0.f;
#pragma unroll
        for (int q = 0; q < 4; ++q) { const f32x4 v = sp[q]; s = __builtin_fmaf(v.x, w[4 * q], s); s = __builtin_fmaf(v.y, w[4 * q + 1], s); s = __builtin_fmaf(v.z, w[4 * q + 2], s); s = __builtin_fmaf(v.w, w[4 * q + 3], s); }
        s = wave_sum(s); if (lane == 0) dst[(size_t)kind * ld + nn] = s; }
}
__device__ __forceinline__ void bias_phase(Frame& F) {
    const int gw = F.vcu * NWAVES + F.wave, NGW = F.G * NWAVES, lane = F.lane;
    const float* MODS0 = (const float*)(F.ws + WS_MODS); const float* MODS1 = MODS0 + 3 * 6 * D;
    for (int n = gw; n < 5632; n += NGW) {
        const GAS v4u* src = (const GAS v4u*)((const bf16*)(F.ws + WS_W13F) + (size_t)n * D + 16 * lane); const v4u a = src[0], b = src[1]; float w[16];
        w[0] = bf_lo(a.x); w[1] = bf_hi(a.x); w[2] = bf_lo(a.y); w[3] = bf_hi(a.y); w[4] = bf_lo(a.z); w[5] = bf_hi(a.z); w[6] = bf_lo(a.w); w[7] = bf_hi(a.w);
        w[8] = bf_lo(b.x); w[9] = bf_hi(b.x); w[10] = bf_lo(b.y); w[11] = bf_hi(b.y); w[12] = bf_lo(b.z); w[13] = bf_hi(b.z); w[14] = bf_lo(b.w); w[15] = bf_hi(b.w);
        bias_dot(w, MODS0, 3, (float*)(F.ws + WS_B13), 5632, n, lane);
    }
    for (int n = gw; n < NQKV; n += NGW) {
        const v4u a = *(const GAS v4u*)(F.ws + WS_WQKV + (size_t)n * D + 16 * lane); const float is = 1.0f / FP8_SW; float w[16];
        w[0] = __builtin_amdgcn_cvt_f32_fp8((int)a.x, 0) * is; w[1] = __builtin_amdgcn_cvt_f32_fp8((int)a.x, 1) * is; w[2] = __builtin_amdgcn_cvt_f32_fp8((int)a.x, 2) * is; w[3] = __builtin_amdgcn_cvt_f32_fp8((int)a.x, 3) * is;
        w[4] = __builtin_amdgcn_cvt_f32_fp8((int)a.y, 0) * is; w[5] = __builtin_amdgcn_cvt_f32_fp8((int)a.y, 1) * is; w[6] = __builtin_amdgcn_cvt_f32_fp8((int)a.y, 2) * is; w[7] = __builtin_amdgcn_cvt_f32_fp8((int)a.y, 3) * is;
        w[8] = __builtin_amdgcn_cvt_f32_fp8((int)a.z, 0) * is; w[9] = __builtin_amdgcn_cvt_f32_fp8((int)a.z, 1) * is; w[10] = __builtin_amdgcn_cvt_f32_fp8((int)a.z, 2) * is; w[11] = __builtin_amdgcn_cvt_f32_fp8((int)a.z, 3) * is;
        w[12] = __builtin_amdgcn_cvt_f32_fp8((int)a.w, 0) * is; w[13] = __builtin_amdgcn_cvt_f32_fp8((int)a.w, 1) * is; w[14] = __builtin_amdgcn_cvt_f32_fp8((int)a.w, 2) * is; w[15] = __builtin_amdgcn_cvt_f32_fp8((int)a.w, 3) * is;
        bias_dot(w, MODS1, 0, (float*)(F.ws + WS_BQ), NQKV, n, lane);
    }
}
__device__ __forceinline__ void normmod_phase(Frame& F, const bf16* xs, const float* cs, bf16* HX, const float* ng, const float* mods, int ish, int isc, int nrows, bool fp8out) {
    const int gw = F.vcu * NWAVES + F.wave, NGW = F.G * NWAVES;
#pragma unroll 1
    for (int seg = 0; seg < 3; ++seg) {
        const int lo = seg == 0 ? 0 : (seg == 1 ? LSEQ : TT), hi = seg == 0 ? LSEQ : (seg == 1 ? TT : MT), mi = seg;
        if (lo + gw >= hi) continue;
        f32x4 gm[4], sh[4];
#pragma unroll
        for (int j = 0; j < 4; ++j) { const f32x4 g = ((const GAS f32x4*)ng)[64 * j + F.lane]; const f32x4 sc = ((const GAS f32x4*)(mods + (mi * 6 + isc) * D))[64 * j + F.lane]; gm[j] = g * (sc + 1.0f);
            sh[j] = ((const GAS f32x4*)(mods + (mi * 6 + ish) * D))[64 * j + F.lane]; }
#define NM_ROW(r_) do { float s = 0.f; \
            _Pragma("unroll") for (int j = 0; j < 4; ++j) s += (v[j].x * v[j].x + v[j].y * v[j].y) + (v[j].z * v[j].z + v[j].w * v[j].w); \
            const float rstd = 1.0f / sqrtf(wave_sum(s) * (1.0f / D) + NORM_EPS); \
            GAS unsigned long long* o8 = (GAS unsigned long long*)(HX + (size_t)(r_) * D) + F.lane; \
            _Pragma("unroll") for (int j = 0; j < 4; ++j) { const f32x4 o = v[j] * rstd * gm[j] + sh[j]; \
                if (fp8out) ((GAS unsigned*)((unsigned char*)HX + (size_t)(r_) * D) + F.lane)[64 * j] = pg8::pk4_fp8(o.x * FP8_SA, o.y * FP8_SA, o.z * FP8_SA, o.w * FP8_SA); \
                else o8[64 * j] = (unsigned long long)pk2(o.x, o.y) | ((unsigned long long)pk2(o.z, o.w) << 32); } } while (0)
        if (seg < 2) {
            for (int rb = lo + gw; rb < hi; rb += 8 * NGW) {
                unsigned long long w[8][4];
#pragma unroll
                for (int u = 0; u < 8; ++u) { const int ru = rb + u * NGW < hi ? rb + u * NGW : rb; const GAS unsigned long long* xr = (const GAS unsigned long long*)(xs + (size_t)ru * D) + F.lane;
#pragma unroll
                    for (int j = 0; j < 4; ++j) w[u][j] = xr[64 * j]; }
#pragma unroll
                for (int u = 0; u < 8; ++u) if (rb + u * NGW < hi) { f32x4 v[4];
#pragma unroll
                    for (int j = 0; j < 4; ++j) v[j] = (f32x4){bf_lo((unsigned)w[u][j]), bf_hi((unsigned)w[u][j]), bf_lo((unsigned)(w[u][j] >> 32)), bf_hi((unsigned)(w[u][j] >> 32))};
                    NM_ROW(rb + u * NGW); }
            }
        } else {
            for (int r = lo + gw; r < hi; r += NGW) { f32x4 v[4];
                const GAS f32x4* xr = (const GAS f32x4*)(cs + (size_t)(r - TT) * D) + F.lane;
#pragma unroll
                for (int j = 0; j < 4; ++j) v[j] = xr[64 * j];
                NM_ROW(r); }
        }
#undef NM_ROW
    }
}
__device__ __forceinline__ float dpp_xor1(float v) { return __builtin_bit_cast(float, __builtin_amdgcn_update_dpp(0, __builtin_bit_cast(int, v), 0xB1, 0xF, 0xF, true)); }
__device__ __forceinline__ float dpp_xor2(float v) { return __builtin_bit_cast(float, __builtin_amdgcn_update_dpp(0, __builtin_bit_cast(int, v), 0x4E, 0xF, 0xF, true)); }
__device__ __forceinline__ void qk_norm_rope(float (&v)[16], const f32x4 (&gn)[4], const LAS float2* RT, int qt, int pos, bool rope, float scale) {
    float ss = 0.f;
#pragma unroll
    for (int i = 0; i < 16; ++i) ss += v[i] * v[i];
    ss += dpp_xor1(ss); ss += dpp_xor2(ss);
    const float rstd = 1.0f / sqrtf(ss * (1.0f / 64.0f) + NORM_EPS);
#pragma unroll
    for (int i = 0; i < 16; ++i) v[i] = v[i] * rstd * gn[i >> 2][i & 3];
    const LAS f32x4* rt = (const LAS f32x4*)(RT + pos * 16);
#pragma unroll
    for (int i = 0; i < 16; i += 2) { const f32x4 cs = rt[i >> 1];
        const float p0 = dpp_xor1(v[i]), p1 = dpp_xor1(v[i + 1]);
        const float r0 = v[i] * cs.x + ((qt & 1) ? p0 : -p0) * cs.y, r1 = v[i + 1] * cs.z + ((qt & 1) ? p1 : -p1) * cs.w;
        v[i] = (rope ? r0 : v[i]) * scale; v[i + 1] = (rope ? r1 : v[i + 1]) * scale; }
}
struct QkTask { const GAS v4u* p; GAS v4u* q; GAS v4u* q8; int pos; bool rope, isq; };
__device__ __forceinline__ QkTask qk_task(Frame& F, int task, int qt) {
    constexpr int NQT = TT; QkTask k; const int lane = F.lane;
    if (task < NQT) { const int t = task & (LSEQ - 1); k.pos = qt < 2 ? (t >> 6) : (t & 63); k.rope = true; k.isq = true; k.p = (const GAS v4u*)((bf16*)(F.ws + WS_Q) + (size_t)task * D + 16 * lane); k.q = (GAS v4u*)((bf16*)(F.ws + WS_QN) + (size_t)task * D + 16 * lane); k.q8 = (GAS v4u*)(F.ws + WS_QN + (size_t)task * D + 16 * lane); }
    else { const int kr = (task - NQT) * 4 + (lane >> 4), t = kr % LKV; k.rope = t < LSEQ; const int tc = k.rope ? t : 0; k.pos = qt < 2 ? (tc >> 6) : (tc & 63); k.isq = false; k.p = (const GAS v4u*)((bf16*)(F.ws + WS_K) + (size_t)kr * 256 + 16 * (lane & 15)); k.q = (GAS v4u*)((bf16*)(F.ws + WS_KN) + (size_t)kr * 256 + 16 * (lane & 15)); k.q8 = (GAS v4u*)(F.ws + WS_KN + (size_t)kr * 256 + 16 * (lane & 15)); }
    return k;
}
__device__ __forceinline__ void p9_qknorm(Frame& F, bool fp8out) {
    const int gw = F.vcu * NWAVES + F.wave, NGW = F.G * NWAVES, lane = F.lane;
    LAS float2* RT = (LAS float2*)(F.lds + RING_OFF + 65536);
    { const GAS f32x4* src = (const GAS f32x4*)(F.ws + WS_ROPE); for (int i = F.tid; i < 2048; i += NWAVES * 64) ((LAS f32x4*)RT)[i] = src[i]; }
    __syncthreads();
    const int qt = lane & 3;
    f32x4 gq[4], gk[4];
#pragma unroll
    for (int i = 0; i < 4; ++i) { gq[i] = ((const GAS f32x4*)(F.in[14]))[qt * 4 + i]; gk[i] = ((const GAS f32x4*)(F.in[15]))[qt * 4 + i]; }
    constexpr int NTASK = TT + (NBATCH * LKV) / 4;
    for (int t0 = gw; t0 < NTASK; t0 += 4 * NGW) {
        QkTask tk[4]; v4u w0[4], w1[4];
#pragma unroll
        for (int u = 0; u < 4; ++u) { const int task = t0 + u * NGW; const int tc = task < NTASK ? task : t0; tk[u] = qk_task(F, tc, qt); w0[u] = tk[u].p[0]; w1[u] = tk[u].p[1]; }
#pragma unroll
        for (int u = 0; u < 4; ++u) { if (t0 + u * NGW < NTASK) {
            const QkTask cur = tk[u]; const v4u a = w0[u], b = w1[u]; float v[16];
            v[0] = bf_lo(a.x); v[1] = bf_hi(a.x); v[2] = bf_lo(a.y); v[3] = bf_hi(a.y); v[4] = bf_lo(a.z); v[5] = bf_hi(a.z); v[6] = bf_lo(a.w); v[7] = bf_hi(a.w);
            v[8] = bf_lo(b.x); v[9] = bf_hi(b.x); v[10] = bf_lo(b.y); v[11] = bf_hi(b.y); v[12] = bf_lo(b.z); v[13] = bf_hi(b.z); v[14] = bf_lo(b.w); v[15] = bf_hi(b.w);
            if (cur.isq) qk_norm_rope(v, gq, RT, qt, cur.pos, cur.rope, fp8out ? QSCALE * attn_body::QF8 : QSCALE); else qk_norm_rope(v, gk, RT, qt, cur.pos, cur.rope, fp8out ? attn_body::KF8 : 1.0f);
            if (fp8out) { v4u o8; o8.x = pg8::pk4_fp8(v[0], v[1], v[2], v[3]); o8.y = pg8::pk4_fp8(v[4], v[5], v[6], v[7]); o8.z = pg8::pk4_fp8(v[8], v[9], v[10], v[11]); o8.w = pg8::pk4_fp8(v[12], v[13], v[14], v[15]); cur.q8[0] = o8; }
            else { v4u o0, o1; o0.x = pk2(v[0], v[1]); o0.y = pk2(v[2], v[3]); o0.z = pk2(v[4], v[5]); o0.w = pk2(v[6], v[7]); o1.x = pk2(v[8], v[9]); o1.y = pk2(v[10], v[11]); o1.z = pk2(v[12], v[13]); o1.w = pk2(v[14], v[15]); cur.q[0] = o0; cur.q[1] = o1; } } }
    }
}
__device__ __forceinline__ void p9_vtrans(Frame& F) {
    const int gw = F.vcu * NWAVES + F.wave, NGW = F.G * NWAVES, lane = F.lane;
    LAS unsigned char* scr = F.lds + RING_OFF + F.wave * 8192;
    const int dp = lane & 31, kh = lane >> 5;
    for (int it = 0; it * NGW < NBATCH * 4 * (LKV / 64); ++it) {
        const int task = it * NGW + ((it & 1) ? NGW - 1 - gw : gw); if (task >= NBATCH * 4 * (LKV / 64)) continue;
        const int bk = task / (LKV / 64), tile = task % (LKV / 64), b = bk >> 2, kvh = bk & 3;
        const bf16* src = (const bf16*)(F.ws + WS_V) + ((size_t)(b * LKV + tile * 64)) * 256 + kvh * 64;
#pragma unroll
        for (int i = 0; i < 8; ++i) { const int row = 8 * i + (lane >> 3), ch = lane & 7; const v4u w = *(const GAS v4u*)(src + (size_t)row * 256 + ch * 8); *(LAS v4u*)(scr + row * 128 + ch * 16) = w; }
        LDS_WAIT(); asm volatile("" ::: "memory");
        float lo[32], hi[32];
#pragma unroll
        for (int j = 0; j < 32; ++j) { const int jj = j & 15, key = (jj & 3) + 8 * (jj >> 2) + 4 * kh + 32 * (j >> 4); const unsigned w = *(const LAS unsigned*)(scr + key * 128 + dp * 4); lo[j] = bf_lo(w) * attn_body::VF8; hi[j] = bf_hi(w) * attn_body::VF8; }
        v4u o0, o1, o2, o3;
        o0.x = pg8::pk4_fp8(lo[0], lo[1], lo[2], lo[3]); o0.y = pg8::pk4_fp8(lo[4], lo[5], lo[6], lo[7]); o0.z = pg8::pk4_fp8(lo[8], lo[9], lo[10], lo[11]); o0.w = pg8::pk4_fp8(lo[12], lo[13], lo[14], lo[15]);
        o1.x = pg8::pk4_fp8(lo[16], lo[17], lo[18], lo[19]); o1.y = pg8::pk4_fp8(lo[20], lo[21], lo[22], lo[23]); o1.z = pg8::pk4_fp8(lo[24], lo[25], lo[26], lo[27]); o1.w = pg8::pk4_fp8(lo[28], lo[29], lo[30], lo[31]);
        o2.x = pg8::pk4_fp8(hi[0], hi[1], hi[2], hi[3]); o2.y = pg8::pk4_fp8(hi[4], hi[5], hi[6], hi[7]); o2.z = pg8::pk4_fp8(hi[8], hi[9], hi[10], hi[11]); o2.w = pg8::pk4_fp8(hi[12], hi[13], hi[14], hi[15]);
        o3.x = pg8::pk4_fp8(hi[16], hi[17], hi[18], hi[19]); o3.y = pg8::pk4_fp8(hi[20], hi[21], hi[22], hi[23]); o3.z = pg8::pk4_fp8(hi[24], hi[25], hi[26], hi[27]); o3.w = pg8::pk4_fp8(hi[28], hi[29], hi[30], hi[31]);
        unsigned char* dst = F.ws + WS_VT + ((size_t)(bk * 64 + 2 * dp)) * LKV + tile * 64 + 32 * kh;
        *(GAS v4u*)(dst) = o0; *(GAS v4u*)(dst + 16) = o1; *(GAS v4u*)(dst + LKV) = o2; *(GAS v4u*)(dst + LKV + 16) = o3;
        LDS_WAIT(); asm volatile("" ::: "memory");
    }
}
__device__ __forceinline__ void p12_router(Frame& F) {
    const int gw = F.vcu * NWAVES + F.wave, NGW = F.G * NWAVES, lane = F.lane;
    LAS float* RW = (LAS float*)(F.lds + RING_OFF);
    for (int c = F.tid; c < D; c += NWAVES * 64) { const f32x4 a = ((const GAS f32x4*)(F.in[16]))[2 * c], b = ((const GAS f32x4*)(F.in[16]))[2 * c + 1];
        RW[0 * D + c] = a.x; RW[1 * D + c] = a.y; RW[2 * D + c] = a.z; RW[3 * D + c] = a.w; RW[4 * D + c] = b.x; RW[5 * D + c] = b.y; RW[6 * D + c] = b.z; RW[7 * D + c] = b.w; }
    __syncthreads();
    const float* MODS = (const float*)(F.ws + WS_MODS) + 3 * 6 * D;
    const float* ng = F.in[6] + 3 * D;
    unsigned char* HX = F.ws + WS_BIG; int* EID = (int*)(F.ws + WS_EID); float* GATE = (float*)(F.ws + WS_GATE);
    const bf16* X3B = (const bf16*)(F.ws + WS_X3B);
    int* CNTW = (int*)(F.ws + WS_CNTW);
    const bool b5 = (lane & 32) != 0, b4 = (lane & 16) != 0, b3 = (lane & 8) != 0;
    constexpr int RST = TT / 16; static_assert(RST * 8 == LSEQ, "row interleave");
    for (int task = gw; task < TT / 16; task += NGW) {
        const int r0 = task;
        f32x4 gm[4], sh[4];
        f32x4 vn[4];
#pragma unroll
        for (int j = 0; j < 4; ++j) { const unsigned long long w = ((const GAS unsigned long long*)(X3B + (size_t)r0 * D) + lane)[64 * j]; vn[j] = (f32x4){bf_lo((unsigned)w), bf_hi((unsigned)w), bf_lo((unsigned)(w >> 32)), bf_hi((unsigned)(w >> 32))}; }
        int cnt0 = 0, cnt1 = 0, cnt2 = 0, cnt3 = 0, cnt4 = 0, cnt5 = 0, cnt6 = 0, cnt7 = 0;
        int myeid = 0; float mygate = 0.f;
        for (int rr = 0; rr < 16; ++rr) {
            const int r = r0 + rr * RST;
            if ((rr & 7) == 0) { const int mi = rr >> 3;
#pragma unroll
                for (int j = 0; j < 4; ++j) { const f32x4 g = ((const GAS f32x4*)ng)[64 * j + lane]; const f32x4 sc = ((const GAS f32x4*)(MODS + (mi * 6 + 4) * D))[64 * j + lane]; gm[j] = g * (sc + 1.0f);
                    sh[j] = ((const GAS f32x4*)(MODS + (mi * 6 + 3) * D))[64 * j + lane]; } }
            f32x4 v[4]; float s = 0.f;
#pragma unroll
            for (int j = 0; j < 4; ++j) { v[j] = vn[j]; s += (v[j].x * v[j].x + v[j].y * v[j].y) + (v[j].z * v[j].z + v[j].w * v[j].w); }
            if (rr < 15) {
#pragma unroll
                for (int j = 0; j < 4; ++j) { const unsigned long long w = ((const GAS unsigned long long*)(X3B + (size_t)(r + RST) * D) + lane)[64 * j]; vn[j] = (f32x4){bf_lo((unsigned)w), bf_hi((unsigned)w), bf_lo((unsigned)(w >> 32)), bf_hi((unsigned)(w >> 32))}; } }
            const float rstd = 1.0f / sqrtf(wave_sum(s) * (1.0f / D) + NORM_EPS);
            GAS unsigned* o4 = (GAS unsigned*)(HX + (size_t)r * D) + lane;
            float lg[8];
#pragma unroll
            for (int e = 0; e < 8; ++e) lg[e] = 0.f;
#pragma unroll
            for (int j = 0; j < 4; ++j) { const f32x4 o = v[j] * rstd * gm[j] + sh[j]; o4[64 * j] = pg8::pk4_fp8(o.x * FP8_SA, o.y * FP8_SA, o.z * FP8_SA, o.w * FP8_SA);
#pragma unroll
                for (int e = 0; e < 8; ++e) { const f32x4 w = *(const LAS f32x4*)(RW + e * D + 256 * j + 4 * lane); lg[e] = __builtin_fmaf(o.w, w.w, __builtin_fmaf(o.z, w.z, __builtin_fmaf(o.y, w.y, __builtin_fmaf(o.x, w.x, lg[e])))); } }
            float a4[4], a2[2], a1;
#pragma unroll
            for (int e = 0; e < 4; ++e) { const float send = b5 ? lg[e] : lg[e + 4], keep = b5 ? lg[e + 4] : lg[e]; a4[e] = keep + __shfl_xor(send, 32); }
#pragma unroll
            for (int e = 0; e < 2; ++e) { const float send = b4 ? a4[e] : a4[e + 2], keep = b4 ? a4[e + 2] : a4[e]; a2[e] = keep + __shfl_xor(send, 16); }
            { const float send = b3 ? a2[0] : a2[1], keep = b3 ? a2[1] : a2[0]; a1 = keep + __shfl_xor(send, 8); }
            a1 += __shfl_xor(a1, 4); a1 += __shfl_xor(a1, 2); a1 += __shfl_xor(a1, 1);
            float L[8];
#pragma unroll
            for (int e = 0; e < 8; ++e) L[e] = __builtin_bit_cast(float, __builtin_amdgcn_readlane(__builtin_bit_cast(int, a1), 8 * e));
            int e1 = 0; float l1 = L[0];
#pragma unroll
            for (int e = 1; e < 8; ++e) if (L[e] > l1) { l1 = L[e]; e1 = e; }
            int e2 = -1; float l2 = -INFINITY;
#pragma unroll
            for (int e = 0; e < 8; ++e) if (e != e1 && L[e] > l2) { l2 = L[e]; e2 = e; }
            const float dd = expf(l2 - l1), g1 = 1.0f / (1.0f + dd), g2 = dd / (1.0f + dd);
            if (lane == 2 * rr) { myeid = e1; mygate = g1; }
            if (lane == 2 * rr + 1) { myeid = e2; mygate = g2; }
            cnt0 += (e1 == 0) + (e2 == 0); cnt1 += (e1 == 1) + (e2 == 1); cnt2 += (e1 == 2) + (e2 == 2); cnt3 += (e1 == 3) + (e2 == 3);
            cnt4 += (e1 == 4) + (e2 == 4); cnt5 += (e1 == 5) + (e2 == 5); cnt6 += (e1 == 6) + (e2 == 6); cnt7 += (e1 == 7) + (e2 == 7);
        }
        if (lane < 32) { EID[32 * task + lane] = myeid; GATE[32 * task + lane] = mygate; }
        { const int mine = lane == 0 ? cnt0 : lane == 1 ? cnt1 : lane == 2 ? cnt2 : lane == 3 ? cnt3 : lane == 4 ? cnt4 : lane == 5 ? cnt5 : lane == 6 ? cnt6 : cnt7;
          if (lane < 8) CNTW[task * 8 + lane] = mine; }
    }
    __syncthreads();
}
__device__ __forceinline__ void p13_slots(Frame& F) {
    const int gw = F.vcu * NWAVES + F.wave, NGW = F.G * NWAVES, lane = F.lane;
    constexpr int NTASK = TT / 16;
    const int* CNTW = (const int*)(F.ws + WS_CNTW);
    int* PEXP = (int*)(F.ws + WS_PEXP);
    const int* EID = (const int*)(F.ws + WS_EID); int* SLOT = (int*)(F.ws + WS_SLOT);
    const unsigned char* HX = F.ws + WS_BIG; unsigned char* XS = F.ws + WS_XS;
    for (int task = gw; task < NTASK; task += NGW) {
        int tot[8], pre[8];
#pragma unroll
        for (int e = 0; e < 8; ++e) { tot[e] = 0; pre[e] = 0; }
#pragma unroll 8
        for (int k = 0; k < NTASK / 64; ++k) { const int t = 64 * k + lane; const v4u a = ((const GAS v4u*)CNTW)[2 * t], b = ((const GAS v4u*)CNTW)[2 * t + 1]; const int m = t < task ? -1 : 0;
            tot[0] += (int)a.x; tot[1] += (int)a.y; tot[2] += (int)a.z; tot[3] += (int)a.w; tot[4] += (int)b.x; tot[5] += (int)b.y; tot[6] += (int)b.z; tot[7] += (int)b.w;
            pre[0] += (int)a.x & m; pre[1] += (int)a.y & m; pre[2] += (int)a.z & m; pre[3] += (int)a.w & m; pre[4] += (int)b.x & m; pre[5] += (int)b.y & m; pre[6] += (int)b.z & m; pre[7] += (int)b.w & m; }
#pragma unroll
        for (int e = 0; e < 8; ++e)
#pragma unroll
            for (int o = 1; o < 64; o <<= 1) { tot[e] += __shfl_xor(tot[e], o); pre[e] += __shfl_xor(pre[e], o); }
        int pstart[8], ends[8]; { int run = 0;
#pragma unroll
            for (int e = 0; e < 8; ++e) { pstart[e] = run; run += (tot[e] + 255) & ~255; ends[e] = run; } }
        if (task == 0) {
            for (int p = lane; p < CAPP; p += 64) { int e = 0;
#pragma unroll
                for (int j = 0; j < 8; ++j) e += (ends[j] <= p * 256) ? 1 : 0;
                PEXP[p] = e > 7 ? 7 : e; }
            if (lane == 0) PEXP[512] = ends[7] >> 8; }
        constexpr int RST = TT / 16;
        const int e = lane < 32 ? EID[32 * task + lane] : -1; int slot = 0;
#pragma unroll
        for (int ee = 0; ee < 8; ++ee) { const unsigned long long mask = __ballot(e == ee); if (e == ee) slot = pstart[ee] + pre[ee] + __popcll(mask & ((1ull << lane) - 1ull)); }
        if (lane < 32) SLOT[32 * task + lane] = slot;
#pragma unroll
        for (int g = 0; g < 2; ++g) {
            v4u a[8];
#pragma unroll
            for (int i = 0; i < 8; ++i) a[i] = ((const GAS v4u*)(HX + (size_t)(task + (8 * g + i) * RST) * D))[lane];
#pragma unroll
            for (int i = 0; i < 8; ++i)
#pragma unroll
                for (int k = 0; k < 2; ++k) { const int s = __builtin_amdgcn_readlane(slot, 2 * (8 * g + i) + k); ((GAS v4u*)(XS + (size_t)s * D))[lane] = a[i]; }
        }
    }
}
struct CombRow { unsigned long long x[4], ya[4], yb[4]; };
__device__ __forceinline__ void comb_load(CombRow& R, const bf16* X, const bf16* Y, int r, int s0, int s1, int lane) {
    const GAS unsigned long long* xr = (const GAS unsigned long long*)(X + (size_t)r * D) + lane;
    const GAS unsigned long long* y0 = (const GAS unsigned long long*)(Y + (size_t)s0 * D) + lane; const GAS unsigned long long* y1 = (const GAS unsigned long long*)(Y + (size_t)s1 * D) + lane;
#pragma unroll
    for (int j = 0; j < 4; ++j) { R.x[j] = xr[64 * j]; R.ya[j] = y0[64 * j]; R.yb[j] = y1[64 * j]; }
}
__device__ __forceinline__ void p18_combine(Frame& F) {
    const int gw = F.vcu * NWAVES + F.wave, NGW = F.G * NWAVES, lane = F.lane;
    const float* MODS = (const float*)(F.ws + WS_MODS) + 3 * 6 * D;
    const int* SLOT = (const int*)(F.ws + WS_SLOT); const float* GATE = (const float*)(F.ws + WS_GATE); const bf16* Y = (const bf16*)(F.ws + WS_XS); const bf16* X3B = (const bf16*)(F.ws + WS_X3B);
    constexpr int RST = TT / 16;
    for (int task = gw; task < TT / 16; task += NGW) {
        const int r0 = task;
        const int slotv = lane < 32 ? SLOT[32 * task + lane] : 0; const float gatev = lane < 32 ? GATE[32 * task + lane] : 0.f;
        f32x4 g2[4], fg[4];
#pragma unroll
        for (int j = 0; j < 4; ++j) fg[j] = ((const GAS f32x4*)(F.in[20]))[64 * j + lane];
        CombRow nx; comb_load(nx, X3B, Y, r0, __builtin_amdgcn_readlane(slotv, 0), __builtin_amdgcn_readlane(slotv, 1), lane);
#pragma unroll 2
        for (int rr = 0; rr < 16; ++rr) {
            const int r = r0 + rr * RST; CombRow c = nx;
            if ((rr & 7) == 0) { const int mi = rr >> 3;
#pragma unroll
                for (int j = 0; j < 4; ++j) g2[j] = ((const GAS f32x4*)(MODS + (mi * 6 + 5) * D))[64 * j + lane]; }
            const float ga = __builtin_bit_cast(float, __builtin_amdgcn_readlane(__builtin_bit_cast(int, gatev), 2 * rr)), gb = __builtin_bit_cast(float, __builtin_amdgcn_readlane(__builtin_bit_cast(int, gatev), 2 * rr + 1));
            if (rr < 15) comb_load(nx, X3B, Y, r + RST, __builtin_amdgcn_readlane(slotv, 2 * rr + 2), __builtin_amdgcn_readlane(slotv, 2 * rr + 3), lane);
            f32x4 v[4]; float s = 0.f;
#pragma unroll
            for (int j = 0; j < 4; ++j) { const unsigned long long a = c.ya[j], b = c.yb[j], xw = c.x[j];
                const f32x4 xv = {bf_lo((unsigned)xw), bf_hi((unsigned)xw), bf_lo((unsigned)(xw >> 32)), bf_hi((unsigned)(xw >> 32))};
                const f32x4 ya = {bf_lo((unsigned)a), bf_hi((unsigned)a), bf_lo((unsigned)(a >> 32)), bf_hi((unsigned)(a >> 32))};
                const f32x4 yb = {bf_lo((unsigned)b), bf_hi((unsigned)b), bf_lo((unsigned)(b >> 32)), bf_hi((unsigned)(b >> 32))};
                v[j] = xv + g2[j] * (ya * ga + yb * gb); s += (v[j].x * v[j].x + v[j].y * v[j].y) + (v[j].z * v[j].z + v[j].w * v[j].w); }
            const float rstd = 1.0f / sqrtf(wave_sum(s) * (1.0f / D) + NORM_EPS);
            GAS f32x4* xo = (GAS f32x4*)(F.out + (size_t)r * D) + lane;
#pragma unroll
            for (int j = 0; j < 4; ++j) xo[64 * j] = v[j] * rstd * fg[j];
        }
    }
}

__device__ __forceinline__ bool attn_fast_ok(Frame& F, float& cref) {
    float mq = fabsf(F.in[14][F.lane]), mk = fabsf(F.in[15][F.lane]);
#pragma unroll
    for (int o = 1; o < 64; o <<= 1) { mq = fmaxf(mq, __shfl_xor(mq, o)); mk = fmaxf(mk, __shfl_xor(mk, o)); }
    const float bound = __builtin_bit_cast(float, __builtin_amdgcn_readfirstlane(__builtin_bit_cast(int, 64.0f * mq * mk * QSCALE)));
    cref = bound > 15.0f ? bound - 15.0f : 0.0f;
    return bound < 24.0f;
}
constexpr int MW_N1 = 10000, MW_N2 = MW_N1 + 18792;
__device__ __forceinline__ void tail_convert(Frame& F, int bx, int nunits, int lo, int hi) {
    const int nlong = nunits % F.G;
    if (nlong > 0) { if (bx >= nlong) moe_weights_phase(F, (bx - nlong) * NWAVES + F.wave, (F.G - nlong) * NWAVES, lo, hi); }
    else moe_weights_phase(F, F.vcu * NWAVES + F.wave, F.G * NWAVES, lo, hi);
}
#ifndef MK_SYNTH
#define MK_SYNTH 0
#endif
#if MK_SYNTH
typedef float sy_f16v __attribute__((ext_vector_type(16)));
typedef int sy_i8v __attribute__((ext_vector_type(8)));
typedef unsigned sy_u4v __attribute__((ext_vector_type(4)));
__device__ __forceinline__ void synth_phase(const Frame& F, int nsteps) {
    const int lane = mk_lane();
    sy_i8v kf0, kf1, vf0, vf1, q8, p8, ones8;
    { const int z = 0; kf0 = kf1 = vf0 = vf1 = q8 = p8 = (sy_i8v){z, z, z, z, z, z, z, z}; const int o_ = 0x38383838; ones8 = (sy_i8v){o_, o_, o_, o_, o_, o_, o_, o_}; }
    asm volatile("" : "+v"(kf0), "+v"(kf1), "+v"(vf0), "+v"(vf1), "+v"(q8), "+v"(p8), "+v"(ones8));
    sy_f16v negc, pA0, pA1, pB0, pB1, o0, o1, lacc;
    { const float m = -1.0f; negc = (sy_f16v){m, m, m, m, m, m, m, m, m, m, m, m, m, m, m, m}; pA0 = pA1 = pB0 = pB1 = negc; o0 = o1 = lacc = sy_f16v{}; }
    asm volatile("" : "+v"(negc), "+v"(pA0), "+v"(pA1), "+v"(pB0), "+v"(pB1), "+v"(o0), "+v"(o1), "+v"(lacc));
#if MK_SYNTH & 16
    const int sc = 0x7E7E7E7E;
    { LAS unsigned* l32 = (LAS unsigned*)(F.lds + RING_OFF); for (int i = F.wave * 64 + lane; i < 12288; i += NWAVES * 64) { unsigned h = (unsigned)i * 2654435761u; h ^= h >> 15; h *= 2246822519u; h ^= h >> 13; l32[i] = h & 0xBFBFBFBFu; }
      unsigned h = (unsigned)(lane + 77) * 2654435761u; h ^= h >> 15; h *= 2246822519u; h ^= h >> 13;
      _Pragma("unroll") for (int j = 0; j < 8; ++j) { h = h * 1664525u + 1013904223u; q8[j] = (int)((h ^ (h >> 11)) & 0xBFBFBFBFu); h = h * 1664525u + 1013904223u; kf0[j] = (int)((h ^ (h >> 11)) & 0xBFBFBFBFu);
        h = h * 1664525u + 1013904223u; kf1[j] = (int)((h ^ (h >> 11)) & 0xBFBFBFBFu); h = h * 1664525u + 1013904223u; vf0[j] = (int)((h ^ (h >> 11)) & 0xBFBFBFBFu); h = h * 1664525u + 1013904223u; vf1[j] = (int)((h ^ (h >> 11)) & 0xBFBFBFBFu); }
      _Pragma("unroll") for (int j = 0; j < 8; ++j) { h = h * 1664525u + 1013904223u; p8[j] = (int)((h ^ (h >> 11)) & 0xBFBFBFBFu); }
      asm volatile("" : "+v"(q8), "+v"(kf0), "+v"(kf1), "+v"(vf0), "+v"(vf1), "+v"(p8)); __syncthreads(); }
#else
    const int sc = 0x7F7F7F7F;
#endif
    LAS const unsigned char* lp = F.lds + RING_OFF + (lane & 31) * 16 + (lane >> 5) * 2048;
#define SY_SB() __builtin_amdgcn_sched_barrier(0)
#define SY_PIN(x) asm volatile("" : "+v"(x))
#if (MK_SYNTH & 33) == 33
    typedef float sy_f4v __attribute__((ext_vector_type(4)));
    sy_f4v t0, t1, t2, t3, t4, t5, t6, t7, t8, t9, nc4; { const float m = -1.0f; nc4 = (sy_f4v){m, m, m, m}; t0 = t1 = t2 = t3 = t4 = t5 = t6 = t7 = t8 = t9 = sy_f4v{}; }
    asm volatile("" : "+v"(nc4), "+v"(t0), "+v"(t1), "+v"(t2), "+v"(t3), "+v"(t4), "+v"(t5), "+v"(t6), "+v"(t7), "+v"(t8), "+v"(t9));
#define SY_M16(Dd, A, B, Cc) asm volatile("v_mfma_scale_f32_16x16x128_f8f6f4 %0, %1, %2, %3, %4, %4 op_sel_hi:[0,0,0]" : "=&v"(Dd) : "v"(A), "v"(B), "v"(Cc), "v"(sc))
#define SY_M16A(Dd, A, B) asm volatile("v_mfma_scale_f32_16x16x128_f8f6f4 %0, %1, %2, %0, %3, %3 op_sel_hi:[0,0,0] cbsz:1" : "+v"(Dd) : "v"(A), "v"(B), "v"(sc))
#define SY_AQK(C, kf, PT) do { if (&C == &pB0 || &C == &pA0) { SY_M16(t0, kf, q8, nc4); SY_M16(t1, q8, kf, nc4); } else { SY_M16(t2, kf, q8, nc4); SY_M16(t3, q8, kf, nc4); } } while (0)
#define SY_APV(O, vf, CT) do { if (&O == &o0) { SY_M16A(t4, p8, vf); SY_M16A(t5, vf, p8); } else if (&O == &o1) { SY_M16A(t6, p8, vf); SY_M16A(t7, vf, p8); } else { SY_M16A(t8, p8, vf); SY_M16A(t9, vf, p8); } } while (0)
#define SY_KEEP() asm volatile("" : "+v"(t0), "+v"(t1), "+v"(t2), "+v"(t3))
#elif MK_SYNTH & 1
#define SY_KEEP() do { } while (0)
#define SY_AQK(C, kf, PT) asm volatile("v_mfma_scale_f32_32x32x64_f8f6f4 %0, %2, %3, %4, %5, %5 op_sel_hi:[0,0,0]" : "=&v"(C), "+v"(PT) : "v"(kf), "v"(q8), "v"(negc), "v"(sc))
#define SY_APV(O, vf, CT) asm volatile("v_mfma_scale_f32_32x32x64_f8f6f4 %0, %2, %3, %0, %4, %4 op_sel_hi:[0,0,0] cbsz:1" : "+v"(O), "+v"(CT) : "v"(p8), "v"(vf), "v"(sc))
#else
#define SY_KEEP() do { } while (0)
#define SY_AQK(C, kf, PT) asm volatile("" : "+v"(C), "+v"(PT) : "v"(kf), "v"(q8), "v"(negc), "v"(sc))
#define SY_APV(O, vf, CT) asm volatile("" : "+v"(O), "+v"(CT) : "v"(p8), "v"(vf), "v"(sc))
#endif
#if MK_SYNTH & 2
#define SY_PK4(P, B, d) do { int w_; asm volatile("" : "=v"(w_)); w_ = __builtin_amdgcn_cvt_pk_bf8_f32(P[B], P[(B) + 1], w_, false); w_ = __builtin_amdgcn_cvt_pk_bf8_f32(P[(B) + 2], P[(B) + 3], w_, true); p8[d] = w_; } while (0)
#define SY_EXN(X, B) do { _Pragma("unroll") for (int e_ = 0; e_ < 8; ++e_) X[(B) + e_] = __builtin_amdgcn_exp2f(X[(B) + e_]); SY_PIN(X); } while (0)
#else
#define SY_PK4(P, B, d) do { } while (0)
#define SY_EXN(X, B) do { } while (0)
#endif
#if MK_SYNTH & 4
#define SY_KLD(dst, kp) do { const sy_u4v a_ = *(LAS const sy_u4v*)(kp), b_ = *(LAS const sy_u4v*)((kp) + 1024); dst = (sy_i8v){(int)a_.x, (int)a_.y, (int)a_.z, (int)a_.w, (int)b_.x, (int)b_.y, (int)b_.z, (int)b_.w}; } while (0)
#else
#define SY_KLD(dst, kp) do { } while (0)
#endif
#if MK_SYNTH & 8
#define SY_BAR() asm volatile("s_waitcnt vmcnt(0) lgkmcnt(0)\n\ts_barrier" ::: "memory")
#else
#define SY_BAR() do { } while (0)
#endif
#define SY_STEP(C0, C1, P0, P1) do { SY_SB(); \
    SY_AQK(C0, kf0, P0); SY_PK4(P0, 0, 0); SY_PK4(P0, 4, 1); SY_PK4(P0, 8, 2); SY_PK4(P0, 12, 3); SY_KLD(vf0, lp + 32768); SY_PIN(p8); SY_SB(); \
    SY_AQK(C1, kf1, P1); SY_PK4(P1, 0, 4); SY_PK4(P1, 4, 5); SY_PK4(P1, 8, 6); SY_PK4(P1, 12, 7); SY_KLD(vf1, lp + 32768 + 512); SY_PIN(p8); SY_SB(); \
    SY_APV(o0, vf0, C0); SY_EXN(C0, 0); SY_SB(); \
    SY_APV(o1, vf1, C0); SY_EXN(C0, 8); SY_KLD(kf0, lp); SY_SB(); \
    SY_APV(lacc, ones8, C1); SY_EXN(C1, 0); SY_KLD(kf1, lp + 512); SY_SB(); \
    SY_EXN(C1, 8); SY_SB(); } while (0)
#pragma nounroll
    for (int t = 0; t < nsteps; t += 2) {
        SY_STEP(pB0, pB1, pA0, pA1); SY_KEEP(); SY_BAR();
        SY_STEP(pA0, pA1, pB0, pB1); SY_KEEP(); SY_BAR();
    }
    asm volatile("s_nop 15\n\ts_nop 15" : "+v"(o0), "+v"(o1), "+v"(lacc), "+v"(pA0), "+v"(pA1), "+v"(pB0), "+v"(pB1));
#if (MK_SYNTH & 33) == 33
    asm volatile("" : "+v"(t0), "+v"(t1), "+v"(t2), "+v"(t3), "+v"(t4), "+v"(t5), "+v"(t6), "+v"(t7), "+v"(t8), "+v"(t9));
#endif
}
#endif
struct Args { const float* in[21]; float* out; unsigned char* ws; int ph_lo, ph_hi; };
__global__ void __launch_bounds__(NWAVES * 64, 2) mk_fwd(Args args) {
    extern __shared__ __attribute__((aligned(16))) unsigned char lds[];
    Frame F;
    F.lds = (LAS unsigned char*)lds;
    F.MISC = (volatile LAS unsigned*)(F.lds + MISC_OFF);
    F.wave = __builtin_amdgcn_readfirstlane((int)threadIdx.x >> 6); F.lane = mk_lane(); F.tid = F.wave * 64 + F.lane;
#define FRESH() do { F.lane = mk_lane(); F.tid = F.wave * 64 + F.lane; } while (0)
    F.G = gridDim.x; { const int bx = blockIdx.x; F.vcu = (F.G % 8 == 0) ? (bx % 8) * (F.G / 8) + bx / 8 : bx; }
    F.ws = args.ws; F.ctl = (gu32*)(args.ws + WS_CTL); F.out = args.out;
#pragma unroll
    for (int i = 0; i < 21; ++i) F.in[i] = args.in[i];
    for (int u = F.tid; u < (LDS_BYTES - LDSCTL_OFF) / 4; u += NWAVES * 64) ((LAS unsigned*)(F.lds + LDSCTL_OFF))[u] = 0u;
    __syncthreads();
    XcdBarrier bar; bar.bar = (unsigned*)(F.ctl + CW_BAR); bar.x = 0; bar.st = nullptr; bar.w = F.wave;
    if (N_LAUNCHES != PER_PHASE) bar = xcd_barrier_post((unsigned*)(F.ctl + CW_BAR), F.MISC + 8, F.wave);
#define GRID_BAR(seam) do { if (N_LAUNCHES == PER_PHASE) { if (F.tid == 0) __hip_atomic_store(F.ctl + CW_TMO, 0xBADBA0u | (unsigned)(seam), RLX_AGENT); } else { xcd_barrier(bar); } } while (0)
    const int lo = args.ph_lo, hi = args.ph_hi;
#define IN(k) (lo <= (k) && (k) < hi)
#define BOTH(k) (IN(k) && IN((k) + 1))
#ifndef MK_REPN
#define MK_REPN 1
#endif
#define NREP(k) (((MK_REPEAT >> (k)) & 1) * MK_REPN)
#define REPEAT(k) for (int rep_ = 0; rep_ <= NREP(k); ++rep_, (rep_ <= NREP(k) ? (void)xcd_barrier(bar) : (void)0))
    const int bx = (int)blockIdx.x;
    const float* MODS0 = (const float*)(F.ws + WS_MODS); const float* MODS1 = MODS0 + 3 * 6 * D;
    bf16* HXB = (bf16*)(F.ws + WS_XS); float* CTXB = (float*)(F.ws + WS_CTXB); float* CTXB2 = CTXB + (size_t)NCTX * D; bf16* HB = (bf16*)(F.ws + WS_BIG);
    bf16* X1B = (bf16*)F.out; bf16* X2B = X1B + (size_t)TT * D; bf16* X3B = (bf16*)(F.ws + WS_X3B);
    bf16* HXB2 = (bf16*)(F.ws + WS_QN);

#if MK_SYNTH
    if (IN(0)) { synth_phase(F, 2080); __syncthreads(); }
#endif
    if (IN(0)) { FRESH(); REPEAT(0) { p0_phase(F); } if (BOTH(0)) GRID_BAR(0); }
    if (IN(2)) { FRESH(); REPEAT(2) { p2_pooldiff_ring(F); } if (BOTH(2)) GRID_BAR(2); }
    if (IN(3)) { FRESH();
        pg8::Gemm g{HXB, (const bf16*)(F.ws + WS_POOL), 256, D, 256}; pg8::GridOrder S{NPT, 4, F.G, bx, 256, 1 + NREP(3)};
        pg8::EpiResB E{(const unsigned char*)F.in[0], F.in[2], (pg8::bf16_t*)X1B, CTXB, MODS0, F.in[8], 2, 0, 1.0f};
        pg8::gemm_phase<pg8::EpiResB, pg8::GridOrder, true, true>(F.lds + RING_OFF, g, S, E, F.wave);
        if (BOTH(3)) GRID_BAR(3);
    }
    if (IN(4)) { FRESH(); REPEAT(4) { normmod_phase(F, X1B, CTXB, HXB, F.in[6] + D, MODS0, 3, 4, MT, false); } if (BOTH(4)) GRID_BAR(4); }
    if (IN(5)) { FRESH();
        pg8::Gemm g{HXB, (const bf16*)(F.ws + WS_W13F), D, D, D}; pg8::GridOrder S{NPT, 22, F.G, bx, 0, 1 + NREP(5)};
        if (MK_FP8_DENSE) { pg8::EpiSwiGLU8 E{F.ws + WS_BIG, FF, 1.0f, FP8_SH};
            pg8::gemm_phase<pg8::EpiSwiGLU8, pg8::GridOrder, true, true>(F.lds + RING_OFF, g, S, E, F.wave); }
        else { pg8::EpiSwiGLU E{HB, FF};
            pg8::gemm_phase<pg8::EpiSwiGLU, pg8::GridOrder, true, true>(F.lds + RING_OFF, g, S, E, F.wave); }
        tail_convert(F, bx, NPT * 22, 0, MW_N1);
        if (BOTH(5)) GRID_BAR(5);
    }
    if (IN(6)) { FRESH();
        pg8::GridOrder S{NPT, 4, F.G, bx, 0, 1 + NREP(6)};
        if (MK_FP8_DENSE) { pg8::Gemm g{HB, (const bf16*)(F.ws + WS_W2F), FF / 2, FF / 2, FF / 2};
            pg8::EpiResB E{(const unsigned char*)X1B, CTXB, (pg8::bf16_t*)X2B, CTXB2, MODS0, nullptr, 5, 1, 1.0f / (FP8_SH * FP8_SW)};
            pg8::gemm_phase<pg8::EpiResB, pg8::GridOrder, true, true, true>(F.lds + RING_OFF, g, S, E, F.wave); }
        else { pg8::Gemm g{HB, (const bf16*)(F.ws + WS_W2F), FF, FF, FF};
            pg8::EpiResB E{(const unsigned char*)X1B, CTXB, (pg8::bf16_t*)X2B, CTXB2, MODS0, nullptr, 5, 1, 1.0f};
            pg8::gemm_phase<pg8::EpiResB, pg8::GridOrder, true, true>(F.lds + RING_OFF, g, S, E, F.wave); }
        tail_convert(F, bx, NPT * 4, MW_N1, MW_N2);
        if (BOTH(6)) GRID_BAR(6);
    }
    if (IN(7)) { FRESH(); REPEAT(7) { normmod_phase(F, X2B, CTXB2, HXB2, F.in[6] + 2 * D, MODS1, 0, 1, MT, MK_FP8_DENSE != 0); } if (BOTH(7)) GRID_BAR(7); }
    if (IN(8)) { FRESH();
        pg8::QkvOrder S{F.G, bx, 1 + NREP(8)};
        if (MK_FP8_DENSE) { pg8::Gemm g{HXB2, (const bf16*)(F.ws + WS_WQKV), D / 2, D / 2, D / 2};
            pg8::EpiQKV E{(bf16*)(F.ws + WS_Q), (bf16*)(F.ws + WS_K), (bf16*)(F.ws + WS_V), 1.0f / (FP8_SA * FP8_SW)};
            pg8::gemm_phase<pg8::EpiQKV, pg8::QkvOrder, true, true, true>(F.lds + RING_OFF, g, S, E, F.wave); }
        else { pg8::Gemm g{HXB2, (const bf16*)(F.ws + WS_WQKV), D, D, D};
            pg8::EpiQKV E{(bf16*)(F.ws + WS_Q), (bf16*)(F.ws + WS_K), (bf16*)(F.ws + WS_V), 1.0f};
            pg8::gemm_phase<pg8::EpiQKV, pg8::QkvOrder, true, true>(F.lds + RING_OFF, g, S, E, F.wave); }
        tail_convert(F, bx, 772, MW_N2, NE * 4224);
        if (BOTH(8)) GRID_BAR(8);
    }
    if (IN(9)) { FRESH(); REPEAT(9) { float cref_; const bool fast_ = attn_fast_ok(F, cref_); p9_qknorm(F, fast_); if (fast_) p9_vtrans(F); } if (BOTH(9)) GRID_BAR(9); }
    if (IN(10)) { FRESH(); REPEAT(10) {
        float cref; const bool fast = attn_fast_ok(F, cref);
        const attn_body::AttnTensors AT{(const attn_body::bf16*)(F.ws + WS_QN), (const attn_body::bf16*)(F.ws + WS_KN), (const attn_body::bf16*)(F.ws + WS_V), (attn_body::bf16*)(F.ws + WS_O), F.ws + WS_QN, F.ws + WS_KN, F.ws + WS_VT, cref};
        const attn_body::StaticOrder S((int)F.G, bx);
        attn_body::attn_phase<attn_body::StaticOrder>((char*)lds + RING_OFF, AT, S, fast, F.wave);
        } if (BOTH(10)) GRID_BAR(10);
    }
    if (IN(11)) { FRESH();
        pg8::Gemm g{(const bf16*)(F.ws + WS_O), (const bf16*)(F.ws + WS_WO), D, D, D}; pg8::GridOrder S{NPX, 4, F.G, bx, 0, 1 + NREP(11)};
        pg8::EpiResB E{(const unsigned char*)X2B, CTXB2, (pg8::bf16_t*)X3B, CTXB2, MODS1, nullptr, 2, 1, 1.0f};
        pg8::gemm_phase<pg8::EpiResB, pg8::GridOrder, true, true>(F.lds + RING_OFF, g, S, E, F.wave);
        if (BOTH(11)) GRID_BAR(11);
    }
    if (IN(12)) { FRESH(); REPEAT(12) { p12_router(F); } if (BOTH(12)) GRID_BAR(12); }
    if (IN(13)) { FRESH(); REPEAT(13) { p13_slots(F); } if (BOTH(13)) GRID_BAR(13); }
    if (IN(14)) { FRESH();
        const int* PEXP = (const int*)(F.ws + WS_PEXP); const int np = __builtin_amdgcn_readfirstlane(PEXP[512]);
        pg8::Gemm g{(const bf16*)(F.ws + WS_XS), (const bf16*)(F.ws + WS_W13M), D / 2, D / 2, D / 2}; pg8::MoeOrder S{np, 22, F.G, bx, 0, 0, 1 + NREP(14), PEXP};
        pg8::EpiSwiGLU8 E{F.ws + WS_BIG, FF, 1.0f / (FP8_SA * FP8_SW), FP8_SH};
        pg8::gemm_phase<pg8::EpiSwiGLU8, pg8::MoeOrder, true, true, true>(F.lds + RING_OFF, g, S, E, F.wave);
        if (BOTH(14)) GRID_BAR(14);
    }
    if (IN(15)) { FRESH();
        const int* PEXP = (const int*)(F.ws + WS_PEXP); const int np = __builtin_amdgcn_readfirstlane(PEXP[512]);
        pg8::Gemm g{(const bf16*)(F.ws + WS_BIG), (const bf16*)(F.ws + WS_W2M), FF / 2, FF / 2, FF / 2}; pg8::MoeOrder S{np, 4, F.G, bx, 0, 0, 1 + NREP(15), PEXP};
        pg8::EpiBf16 E{(bf16*)(F.ws + WS_XS), D, 1.0f / (FP8_SH * FP8_SW)};
        pg8::gemm_phase<pg8::EpiBf16, pg8::MoeOrder, true, true, true>(F.lds + RING_OFF, g, S, E, F.wave);
        if (BOTH(15)) GRID_BAR(15);
    }
    if (IN(16)) { FRESH(); REPEAT(16) { p18_combine(F); } }
#undef IN
#undef BOTH
}

extern "C" void kernel_launch(void* const* d_in, const int* in_sizes, int n_in, void* d_out, int out_size, void* d_ws, size_t ws_size, hipStream_t stream) {
    static int grid = 0;
    if (grid == 0) {
        if (n_in != 21 || in_sizes[0] != TT * D || out_size != TT * D || ws_size < WS_END) { fprintf(stderr, "kernel_launch: unexpected shapes (n_in %d, in0 %d, out %d, ws %zu); nothing launched\n", n_in, n_in > 0 ? in_sizes[0] : -1, out_size, ws_size); grid = -1; return; }
        int dev = 0, cus = 0, per_cu = 0;
        if (hipGetDevice(&dev) != hipSuccess || hipDeviceGetAttribute(&cus, hipDeviceAttributeMultiprocessorCount, dev) != hipSuccess) { grid = -1; return; }
        if (hipFuncSetAttribute((const void*)mk_fwd, hipFuncAttributeMaxDynamicSharedMemorySize, LDS_BYTES) != hipSuccess) { fprintf(stderr, "kernel_launch: hipFuncSetAttribute failed\n"); grid = -1; return; }
        if (hipOccupancyMaxActiveBlocksPerMultiprocessor(&per_cu, (const void*)mk_fwd, NWAVES * 64, LDS_BYTES) != hipSuccess || per_cu < 1)
            fprintf(stderr, "kernel_launch: note: occupancy query reports %d workgroups per CU\n", per_cu);
        (void)hipGetLastError();
        grid = cus;
    }
    if (grid < 0) return;
    if (hipMemsetAsync((char*)d_ws + WS_CTL, 0, CTL_ZERO_BYTES, stream) != hipSuccess) return;
    Args a{};
    for (int i = 0; i < 21; ++i) a.in[i] = (const float*)d_in[i];
    a.out = (float*)d_out; a.ws = (unsigned char*)d_ws;
    if (N_LAUNCHES == 1) { a.ph_lo = 0; a.ph_hi = PER_PHASE; hipLaunchKernelGGL(mk_fwd, dim3(grid), dim3(NWAVES * 64), LDS_BYTES, stream, a); }
    else for (int li = 0; li < PER_PHASE; ++li) { a.ph_lo = li; a.ph_hi = li + 1; hipLaunchKernelGGL(mk_fwd, dim3(grid), dim3(NWAVES * 64), LDS_BYTES, stream, a); }
}
```

```cpp
#ifndef MK_FP8_WO
#define MK_FP8_WO 1
#endif
#ifndef MK_QK_FP6
#define MK_QK_FP6 1
#endif
#include <hip/hip_runtime.h>
#include <hip/hip_bf16.h>
#include <cstdio>
#include <cstdint>
#include <cmath>
__device__ __forceinline__ int mk_lane() { int l; asm volatile("v_mbcnt_lo_u32_b32 %0, -1, 0\n\tv_mbcnt_hi_u32_b32 %0, -1, %0" : "=v"(l)); return l; }

namespace pg8 {
#define PG8_LAS __attribute__((address_space(3)))
typedef unsigned short bf16_t;
typedef short bf16x8 __attribute__((ext_vector_type(8)));
typedef float f32x4 __attribute__((ext_vector_type(4)));
typedef unsigned u32x4 __attribute__((ext_vector_type(4)));
constexpr int BM = 256, BK = 64, HALF = 128, HTB = HALF * BK * 2  , STAGE_BYTES = 8 * HTB, NXCD = 8, WGM = 8;

__host__ __device__ __forceinline__ int lds_byte(int r, int c) { const int st = (r >> 4) * 2 + (c >> 5), rr = r & 15, cc = c & 31, ob = rr * 64 + cc * 2; return st * 1024 + (ob ^ (((ob >> 9) & 1) << 5)); }
__host__ __device__ __forceinline__ void stage_rc(int b, int& R, int& C) { const int st = b / 1024, sb = b % 1024, swz = sb ^ (((sb >> 9) & 1) << 5); R = (st >> 1) * 16 + swz / 64; C = (st & 1) * 32 + (swz % 64) / 2; }
__host__ __device__ __forceinline__ int perm32(int rho) { const int n = rho >> 4, i = rho & 15; return 8 * (i >> 2) + 4 * n + (i & 3); }
__device__ __forceinline__ void glds_s(const char* sbase, unsigned voff, unsigned lds_dst) {
    unsigned keep;
    asm volatile("s_mov_b32 %0, m0\n\ts_mov_b32 m0, %1\n\ts_nop 0\n\tglobal_load_lds_dwordx4 %2, %3\n\ts_mov_b32 m0, %0" : "=&s"(keep) : "s"(lds_dst), "v"(voff), "s"(sbase) : "memory");
}
struct Unit { int pa, pb, pr, pc, ak, rp; };
struct Gemm { const bf16_t* A; const bf16_t* Bt; int K, lda, ldb; };

__device__ __forceinline__ void grid_order(int L, int nM, int nN, int& pm, int& pn) {
    const int nwg = nM * nN; int wgid = L;
    { const int q = nwg / NXCD, r = nwg % NXCD, xcd = wgid % NXCD, off = wgid / NXCD; wgid = (xcd < r ? xcd * (q + 1) : r * (q + 1) + (xcd - r) * q) + off; }
    const int nig = WGM * nN, gid = wgid / nig, fm = gid * WGM, gsz = (nM - fm) < WGM ? (nM - fm) : WGM;
    pm = fm + ((wgid % nig) % gsz); pn = (wgid % nig) / gsz;
}
struct GridOrder {
    int nM, nN, G, c, akmul, rep;
    __device__ __forceinline__ bool next(int i, Unit& u) const {
        int L = i * G + c; if (L >= nM * nN * rep) return false; u.rp = L / (nM * nN); L %= nM * nN;
        int pm, pn; grid_order(L, nM, nN, pm, pn);
        u.pa = pm; u.pb = pn; u.pr = pm; u.pc = pn; u.ak = akmul * pn; return true;
    }
    __device__ __forceinline__ void a_ready(const Unit&) const {}
    __device__ __forceinline__ void done(const Unit&) const {}
};
struct QkvOrder {
    int G, c, rep;
    __device__ __forceinline__ bool next(int i, Unit& u) const {
        int L = i * G + c; if (L >= 772 * rep) return false; L %= 772;
        int pm, pn;
        if (L < 768) grid_order(L, 128, 6, pm, pn); else { pm = 128 + ((L - 768) >> 1); pn = 4 + ((L - 768) & 1); }
        u.pa = pm; u.pb = pn; u.pr = pm; u.pc = pn; u.ak = 0; u.rp = 0; return true;
    }
    __device__ __forceinline__ void a_ready(const Unit&) const {}
    __device__ __forceinline__ void done(const Unit&) const {}
};
struct MoeOrder {
    int nM, nN, G, c, lo, a_rel, rep; const int* pexp;
    __device__ __forceinline__ bool next(int i, Unit& u) const {
        int L = i * G + c; if (L >= nM * nN * rep) return false; L %= nM * nN;
        int pm, pn; grid_order(L, nM, nN, pm, pn);
        const int e = __builtin_amdgcn_readfirstlane(pexp[lo + pm]);
        u.pa = a_rel ? pm : lo + pm; u.pb = e * nN + pn; u.pr = a_rel ? lo + pm : pm; u.pc = pn; u.ak = 0; u.rp = 0; return true;
    }
    __device__ __forceinline__ void a_ready(const Unit&) const {}
    __device__ __forceinline__ void done(const Unit&) const {}
};

__device__ __forceinline__ unsigned cvt_pk_bf16(float lo, float hi) { unsigned r; asm volatile("v_cvt_pk_bf16_f32 %0, %1, %2" : "=v"(r) : "v"(lo), "v"(hi)); return r; }
typedef int v8i __attribute__((ext_vector_type(8)));
typedef short s16x16 __attribute__((ext_vector_type(16)));
__device__ __forceinline__ v8i cat8(bf16x8 a, bf16x8 b) { const s16x16 t = __builtin_shufflevector(a, b, 0, 1, 2, 3, 4, 5, 6, 7, 8, 9, 10, 11, 12, 13, 14, 15); return __builtin_bit_cast(v8i, t); }
__device__ __forceinline__ unsigned pk4_fp8(float a, float b, float c, float d) {
    a = __builtin_fminf(__builtin_fmaxf(a, -448.f), 448.f); b = __builtin_fminf(__builtin_fmaxf(b, -448.f), 448.f); c = __builtin_fminf(__builtin_fmaxf(c, -448.f), 448.f); d = __builtin_fminf(__builtin_fmaxf(d, -448.f), 448.f);
    int w = 0; w = __builtin_amdgcn_cvt_pk_fp8_f32(a, b, w, false); w = __builtin_amdgcn_cvt_pk_fp8_f32(c, d, w, true); return (unsigned)w; }
__device__ __forceinline__ float silu_f(float a) { return a * __builtin_amdgcn_rcpf(1.0f + __builtin_amdgcn_exp2f(-1.4426950408889634f * a)); }

struct EpiBf16 {
    static constexpr bool PERM = true, AFTER_DRAIN = false;
    bf16_t* O; int ldc; float sc;
    __device__ __forceinline__ void operator()(const f32x4 (&acc)[2][2][4][2], const Unit& u, int wr, int wc, int fr, int fq) const {
        const int row0 = u.pr * BM + wr * 64 + fr, col0 = u.pc * BM + wc * 32 + 8 * fq;
#pragma unroll
        for (int ai = 0; ai < 2; ++ai)
#pragma unroll
            for (int m = 0; m < 4; ++m) { bf16_t* rowp = O + (size_t)(row0 + ai * HALF + m * 16) * ldc + col0;
#pragma unroll
                for (int bj = 0; bj < 2; ++bj) { const f32x4 v0 = acc[ai][bj][m][0] * sc, v1 = acc[ai][bj][m][1] * sc;
                    u32x4 w; w.x = cvt_pk_bf16(v0[0], v0[1]); w.y = cvt_pk_bf16(v0[2], v0[3]); w.z = cvt_pk_bf16(v1[0], v1[1]); w.w = cvt_pk_bf16(v1[2], v1[3]);
                    *(u32x4*)(rowp + bj * HALF) = w; } }
    }
};
struct EpiQKV {
    static constexpr bool PERM = true, AFTER_DRAIN = false;
    bf16_t* Q; bf16_t* Kb; bf16_t* Vb; float sc;
    __device__ __forceinline__ void operator()(const f32x4 (&acc)[2][2][4][2], const Unit& u, int wr, int wc, int fr, int fq) const {
        bf16_t* base; int ldc;
        if (u.pc < 4) { base = Q + (size_t)u.pr * BM * 1024 + u.pc * BM; ldc = 1024; }
        else { const int krow0 = u.pr < 128 ? (u.pr >> 6) * 16640 + (u.pr & 63) * 256 : (u.pr - 128) * 16640 + 16384; base = (u.pc == 4 ? Kb : Vb) + (size_t)krow0 * 256; ldc = 256; }
        const int row0 = wr * 64 + fr, col0 = wc * 32 + 8 * fq;
#pragma unroll
        for (int ai = 0; ai < 2; ++ai)
#pragma unroll
            for (int m = 0; m < 4; ++m) { bf16_t* rowp = base + (size_t)(row0 + ai * HALF + m * 16) * ldc + col0;
#pragma unroll
                for (int bj = 0; bj < 2; ++bj) { const f32x4 v0 = acc[ai][bj][m][0] * sc, v1 = acc[ai][bj][m][1] * sc;
                    u32x4 w; w.x = cvt_pk_bf16(v0[0], v0[1]); w.y = cvt_pk_bf16(v0[2], v0[3]); w.z = cvt_pk_bf16(v1[0], v1[1]); w.w = cvt_pk_bf16(v1[2], v1[3]);
                    *(u32x4*)(rowp + bj * HALF) = w; } }
    }
};
struct EpiSwiGLU {
    static constexpr bool PERM = true, AFTER_DRAIN = false;
    bf16_t* H; int ldh; float s;
    __device__ __forceinline__ void operator()(const f32x4 (&acc)[2][2][4][2], const Unit& u, int wr, int wc, int fr, int fq) const {
        const int row0 = u.pr * BM + wr * 64 + fr, col0 = u.pc * HALF + wc * 32 + 8 * fq;
#pragma unroll
        for (int ai = 0; ai < 2; ++ai)
#pragma unroll
            for (int m = 0; m < 4; ++m) { bf16_t* rowp = H + (size_t)(row0 + ai * HALF + m * 16) * ldh + col0;
                const f32x4 a0 = acc[ai][0][m][0] * s, a1 = acc[ai][0][m][1] * s, b0 = acc[ai][1][m][0] * s, b1 = acc[ai][1][m][1] * s;
                u32x4 w;
                w.x = cvt_pk_bf16(silu_f(a0[0]) * b0[0], silu_f(a0[1]) * b0[1]); w.y = cvt_pk_bf16(silu_f(a0[2]) * b0[2], silu_f(a0[3]) * b0[3]);
                w.z = cvt_pk_bf16(silu_f(a1[0]) * b1[0], silu_f(a1[1]) * b1[1]); w.w = cvt_pk_bf16(silu_f(a1[2]) * b1[2], silu_f(a1[3]) * b1[3]);
                *(u32x4*)rowp = w; }
    }
};
struct EpiSwiGLU8 {
    static constexpr bool PERM = true, AFTER_DRAIN = false;
    unsigned char* H; int ldh; float sin, sout;
    typedef float f32x2 __attribute__((ext_vector_type(2)));
    template <bool HI> __device__ __forceinline__ unsigned pk2h(f32x2 a, f32x2 b, float k1, float k2, unsigned old) const {
        const f32x2 e = a * k1; f32x2 d; d.x = __builtin_amdgcn_exp2f(e.x); d.y = __builtin_amdgcn_exp2f(e.y); d = d + 1.0f;
        f32x2 r; r.x = __builtin_amdgcn_rcpf(d.x); r.y = __builtin_amdgcn_rcpf(d.y);
        f32x2 h = ((a * b) * k2) * r;
        h.x = __builtin_amdgcn_fmed3f(h.x, -448.f, 448.f); h.y = __builtin_amdgcn_fmed3f(h.y, -448.f, 448.f);
        return (unsigned)__builtin_amdgcn_cvt_pk_fp8_f32(h.x, h.y, (int)old, HI);
    }
    __device__ __forceinline__ void operator()(const f32x4 (&acc)[2][2][4][2], const Unit& u, int wr, int wc, int fr, int fq) const {
        const int row0 = u.pr * BM + wr * 64 + fr, col0 = u.pc * HALF + wc * 32 + 8 * fq;
        const float k1 = -1.4426950408889634f * sin, k2 = sin * sin * sout;
#pragma unroll
        for (int ai = 0; ai < 2; ++ai)
#pragma unroll
            for (int m = 0; m < 4; ++m) { unsigned char* rowp = H + (size_t)(row0 + ai * HALF + m * 16) * ldh + col0;
                const f32x4 a0 = acc[ai][0][m][0], a1 = acc[ai][0][m][1], b0 = acc[ai][1][m][0], b1 = acc[ai][1][m][1];
                unsigned w0 = 0, w1 = 0;
                w0 = pk2h<false>((f32x2){a0[0], a0[1]}, (f32x2){b0[0], b0[1]}, k1, k2, w0); w0 = pk2h<true>((f32x2){a0[2], a0[3]}, (f32x2){b0[2], b0[3]}, k1, k2, w0);
                w1 = pk2h<false>((f32x2){a1[0], a1[1]}, (f32x2){b1[0], b1[1]}, k1, k2, w1); w1 = pk2h<true>((f32x2){a1[2], a1[3]}, (f32x2){b1[2], b1[3]}, k1, k2, w1);
                *(unsigned long long*)rowp = (unsigned long long)w0 | ((unsigned long long)w1 << 32); }
    }
};
struct EpiResB {
    static constexpr bool PERM = true, AFTER_DRAIN = false;
    const unsigned char* baseX; const float* baseC; bf16_t* outX; float* outC; const float* mods; const float* gate2; int gidx; int base_bf; float sc;
    __device__ __forceinline__ void operator()(const f32x4 (&acc)[2][2][4][2], const Unit& u, int wr, int wc, int fr, int fq) const {
        const int pr = u.pr; const bool isx = pr < 128; const int mi = pr < 64 ? 0 : (pr < 128 ? 1 : 2);
        const float* gv = mods + (mi * 6 + gidx) * 1024;
        const int col0 = u.pc * BM + wc * 32 + 8 * fq;
        f32x4 g[2][2];
#pragma unroll
        for (int bj = 0; bj < 2; ++bj)
#pragma unroll
            for (int n = 0; n < 2; ++n) { g[bj][n] = *(const f32x4*)(gv + col0 + bj * HALF + n * 4) * sc; if (gate2) g[bj][n] = g[bj][n] * *(const f32x4*)(gate2 + col0 + bj * HALF + n * 4); }
        if (isx) {
            const size_t rb = (size_t)pr * BM;
#pragma unroll
            for (int ai = 0; ai < 2; ++ai)
#pragma unroll
                for (int m = 0; m < 4; ++m) { const size_t off = (rb + ai * HALF + wr * 64 + m * 16 + fr) * 1024 + col0;
#pragma unroll
                    for (int bj = 0; bj < 2; ++bj) { f32x4 b0, b1;
                        if (base_bf) { const u32x4 w = *(const u32x4*)((const bf16_t*)baseX + off + bj * HALF);
                            b0 = (f32x4){__builtin_bit_cast(float, w.x << 16), __builtin_bit_cast(float, w.x & 0xffff0000u), __builtin_bit_cast(float, w.y << 16), __builtin_bit_cast(float, w.y & 0xffff0000u)};
                            b1 = (f32x4){__builtin_bit_cast(float, w.z << 16), __builtin_bit_cast(float, w.z & 0xffff0000u), __builtin_bit_cast(float, w.w << 16), __builtin_bit_cast(float, w.w & 0xffff0000u)}; }
                        else { b0 = *(const f32x4*)((const float*)baseX + off + bj * HALF); b1 = *(const f32x4*)((const float*)baseX + off + bj * HALF + 4); }
                        const f32x4 v0 = b0 + g[bj][0] * acc[ai][bj][m][0], v1 = b1 + g[bj][1] * acc[ai][bj][m][1];
                        u32x4 o; o.x = cvt_pk_bf16(v0[0], v0[1]); o.y = cvt_pk_bf16(v0[2], v0[3]); o.z = cvt_pk_bf16(v1[0], v1[1]); o.w = cvt_pk_bf16(v1[2], v1[3]);
                        *(u32x4*)(outX + off + bj * HALF) = o; }
                    if (m & 1) asm volatile("" ::: "memory"); }
        } else {
            const size_t rb = (size_t)(pr - 128) * BM;
#pragma unroll
            for (int ai = 0; ai < 2; ++ai)
#pragma unroll
                for (int m = 0; m < 4; ++m) { const size_t off = (rb + ai * HALF + wr * 64 + m * 16 + fr) * 1024 + col0;
#pragma unroll
                    for (int bj = 0; bj < 2; ++bj)
#pragma unroll
                        for (int n = 0; n < 2; ++n) { const f32x4 bs = *(const f32x4*)(baseC + off + bj * HALF + n * 4); *(f32x4*)(outC + off + bj * HALF + n * 4) = bs + g[bj][n] * acc[ai][bj][m][n]; }
                    if (m & 1) asm volatile("" ::: "memory"); }
        }
    }
};
struct EpiRes {
    static constexpr bool PERM = false, AFTER_DRAIN = false;
    const float* baseX; const float* baseC; float* outX; float* outC; const float* mods; int gidx; const float* gate2; float sc;
    __device__ __forceinline__ void operator()(const f32x4 (&acc)[2][2][4][2], const Unit& u, int wr, int wc, int fr, int fq) const {
        const int pr = u.pr; const bool isx = pr < 128; const int mi = pr < 64 ? 0 : (pr < 128 ? 1 : 2);
        const float* base = isx ? baseX + (size_t)pr * BM * 1024 : baseC + (size_t)(pr - 128) * BM * 1024;
        float* out = isx ? outX + (size_t)pr * BM * 1024 : outC + (size_t)(pr - 128) * BM * 1024;
        const float* gv = mods + (mi * 6 + gidx) * 1024;
        const int col0 = u.pc * BM + wc * 32 + 4 * fq;
        f32x4 g[2][2];
#pragma unroll
        for (int bj = 0; bj < 2; ++bj)
#pragma unroll
            for (int n = 0; n < 2; ++n) { g[bj][n] = *(const f32x4*)(gv + col0 + bj * HALF + n * 16) * sc; if (gate2) g[bj][n] = g[bj][n] * *(const f32x4*)(gate2 + col0 + bj * HALF + n * 16); }
#pragma unroll
        for (int ai = 0; ai < 2; ++ai)
#pragma unroll
            for (int m = 0; m < 4; ++m) { const size_t off = (size_t)(ai * HALF + wr * 64 + m * 16 + fr) * 1024 + col0;
#pragma unroll
                for (int bj = 0; bj < 2; ++bj)
#pragma unroll
                    for (int n = 0; n < 2; ++n) { const f32x4 bs = *(const f32x4*)(base + off + bj * HALF + n * 16); *(f32x4*)(out + off + bj * HALF + n * 16) = bs + g[bj][n] * acc[ai][bj][m][n]; }
                if (m & 1) asm volatile("" ::: "memory"); }
    }
};

__device__ __forceinline__ float row_rstd(const float* ssq, int row, float eps) {
    const f32x4* p = (const f32x4*)(ssq + (size_t)row * 16); const f32x4 a = p[0], b = p[1], c = p[2], d = p[3];
    const float s = (((a[0] + a[1]) + (a[2] + a[3])) + ((b[0] + b[1]) + (b[2] + b[3]))) + (((c[0] + c[1]) + (c[2] + c[3])) + ((d[0] + d[1]) + (d[2] + d[3])));
    return 1.0f / sqrtf(s * (1.0f / 1024.0f) + eps);
}
template <bool FP8A> struct EpiResN {
    static constexpr bool PERM = false, AFTER_DRAIN = false;
    const float* baseX; const float* baseC; float* outX; float* outC; const float* mods; const float* gate2;
    const float* ng; const float* nmods; unsigned char* aout; float* ssq; int gidx, nsc; float sc, a_scale;
    __device__ __forceinline__ void operator()(const f32x4 (&acc)[2][2][4][2], const Unit& u, int wr, int wc, int fr, int fq) const {
        const int pr = u.pr; const bool isx = pr < 128; const int mi = pr < 64 ? 0 : (pr < 128 ? 1 : 2);
        const float* base = isx ? baseX + (size_t)pr * BM * 1024 : baseC + (size_t)(pr - 128) * BM * 1024;
        float* out = isx ? outX + (size_t)pr * BM * 1024 : outC + (size_t)(pr - 128) * BM * 1024;
        const float* gv = mods + (mi * 6 + gidx) * 1024; const float* nsv = nmods + (mi * 6 + nsc) * 1024;
        const int col0 = u.pc * BM + wc * 32 + 4 * fq;
        f32x4 g[2][2], gm[2][2];
#pragma unroll
        for (int bj = 0; bj < 2; ++bj)
#pragma unroll
            for (int n = 0; n < 2; ++n) { g[bj][n] = *(const f32x4*)(gv + col0 + bj * HALF + n * 16) * sc; if (gate2) g[bj][n] = g[bj][n] * *(const f32x4*)(gate2 + col0 + bj * HALF + n * 16);
                gm[bj][n] = *(const f32x4*)(ng + col0 + bj * HALF + n * 16) * (*(const f32x4*)(nsv + col0 + bj * HALF + n * 16) + 1.0f) * a_scale; }
#pragma unroll
        for (int ai = 0; ai < 2; ++ai)
#pragma unroll
            for (int m = 0; m < 4; ++m) { const int rl = ai * HALF + wr * 64 + m * 16 + fr; const size_t off = (size_t)rl * 1024 + col0; const size_t rowg = (size_t)pr * BM + rl; float ss = 0.f;
#pragma unroll
                for (int bj = 0; bj < 2; ++bj)
#pragma unroll
                    for (int n = 0; n < 2; ++n) { const f32x4 bs = *(const f32x4*)(base + off + bj * HALF + n * 16); const f32x4 o = bs + g[bj][n] * acc[ai][bj][m][n]; *(f32x4*)(out + off + bj * HALF + n * 16) = o;
                        ss += (o[0] * o[0] + o[1] * o[1]) + (o[2] * o[2] + o[3] * o[3]); const f32x4 a = o * gm[bj][n];
                        if (FP8A) *(unsigned*)(aout + rowg * 1024 + col0 + bj * HALF + n * 16) = pk4_fp8(a[0], a[1], a[2], a[3]);
                        else { unsigned long long w = (unsigned long long)cvt_pk_bf16(a[0], a[1]) | ((unsigned long long)cvt_pk_bf16(a[2], a[3]) << 32); *(unsigned long long*)(aout + (rowg * 1024 + col0 + bj * HALF + n * 16) * 2) = w; } }
                ss += __shfl_xor(ss, 16); ss += __shfl_xor(ss, 32);
                if (fq == 0) ssq[rowg * 16 + u.pc * 4 + wc] = ss;
                if (m & 1) asm volatile("" ::: "memory"); }
    }
};
struct EpiSwiGLU8N {
    static constexpr bool PERM = true, AFTER_DRAIN = false;
    unsigned char* H; int ldh; float sin, sout; const float* ssq; const float* bias; float eps;
    __device__ __forceinline__ void operator()(const f32x4 (&acc)[2][2][4][2], const Unit& u, int wr, int wc, int fr, int fq) const {
        const int row0 = u.pr * BM + wr * 64 + fr, col0 = u.pc * HALF + wc * 32 + 8 * fq; const int mi = u.pr < 64 ? 0 : (u.pr < 128 ? 1 : 2);
        const float* bp = bias + (size_t)mi * 5632 + u.pc * BM + wc * 32 + 8 * fq;
        const f32x4 b1a = *(const f32x4*)(bp), b1b = *(const f32x4*)(bp + 4), b3a = *(const f32x4*)(bp + HALF), b3b = *(const f32x4*)(bp + HALF + 4);
#pragma unroll
        for (int ai = 0; ai < 2; ++ai)
#pragma unroll
            for (int m = 0; m < 4; ++m) { const int row = row0 + ai * HALF + m * 16; unsigned char* rowp = H + (size_t)row * ldh + col0; const float rs = row_rstd(ssq, row, eps) * sin;
                const f32x4 a0 = acc[ai][0][m][0] * rs + b1a, a1 = acc[ai][0][m][1] * rs + b1b, b0 = (acc[ai][1][m][0] * rs + b3a) * sout, b1 = (acc[ai][1][m][1] * rs + b3b) * sout;
                unsigned long long w = (unsigned long long)pk4_fp8(silu_f(a0[0]) * b0[0], silu_f(a0[1]) * b0[1], silu_f(a0[2]) * b0[2], silu_f(a0[3]) * b0[3])
                                     | ((unsigned long long)pk4_fp8(silu_f(a1[0]) * b1[0], silu_f(a1[1]) * b1[1], silu_f(a1[2]) * b1[2], silu_f(a1[3]) * b1[3]) << 32);
                *(unsigned long long*)rowp = w; }
    }
};
struct EpiQKVN {
    static constexpr bool PERM = true, AFTER_DRAIN = false;
    bf16_t* Q; bf16_t* Kb; bf16_t* Vb; float sc; const float* ssq; const float* bias; float eps;
    __device__ __forceinline__ void operator()(const f32x4 (&acc)[2][2][4][2], const Unit& u, int wr, int wc, int fr, int fq) const {
        bf16_t* base; int ldc; const int mi = u.pr < 64 ? 0 : (u.pr < 128 ? 1 : 2);
        if (u.pc < 4) { base = Q + (size_t)u.pr * BM * 1024 + u.pc * BM; ldc = 1024; }
        else { const int krow0 = u.pr < 128 ? (u.pr >> 6) * 16640 + (u.pr & 63) * 256 : (u.pr - 128) * 16640 + 16384; base = (u.pc == 4 ? Kb : Vb) + (size_t)krow0 * 256; ldc = 256; }
        const int row0 = wr * 64 + fr, col0 = wc * 32 + 8 * fq;
        const float* bp = bias + (size_t)mi * 1536 + u.pc * BM + col0; f32x4 bv[2][2];
#pragma unroll
        for (int bj = 0; bj < 2; ++bj)
#pragma unroll
            for (int n = 0; n < 2; ++n) bv[bj][n] = *(const f32x4*)(bp + bj * HALF + 4 * n);
#pragma unroll
        for (int ai = 0; ai < 2; ++ai)
#pragma unroll
            for (int m = 0; m < 4; ++m) { const int rl = row0 + ai * HALF + m * 16; bf16_t* rowp = base + (size_t)rl * ldc + col0; const float rs = row_rstd(ssq, u.pr * BM + rl, eps) * sc;
#pragma unroll
                for (int bj = 0; bj < 2; ++bj) { const f32x4 v0 = acc[ai][bj][m][0] * rs + bv[bj][0], v1 = acc[ai][bj][m][1] * rs + bv[bj][1];
                    u32x4 w; w.x = cvt_pk_bf16(v0[0], v0[1]); w.y = cvt_pk_bf16(v0[2], v0[3]); w.z = cvt_pk_bf16(v1[0], v1[1]); w.w = cvt_pk_bf16(v1[2], v1[3]);
                    *(u32x4*)(rowp + bj * HALF) = w; } }
    }
};

template <class Epi, class Sched, bool ALIGN_EPI = false, bool SP2 = false, bool FP8 = false>
__device__ __forceinline__ void gemm_phase(PG8_LAS unsigned char* lds, const Gemm g, const Sched& S, const Epi& E, const int wid) {
    const int lane = mk_lane(), tid = wid * 64 + lane, wr = wid >> 2, wc = wid & 3, fr = lane & 15, fq = lane >> 4;
    const int K = g.K, nt = K / BK;
    unsigned voffA[2], voffB[2];
#pragma unroll
    for (int i = 0; i < 2; ++i) { int R, C; stage_rc(tid * 16 + i * 8192, R, C); const int Rb = Epi::PERM ? ((R & ~31) + perm32(R & 31)) : R;
        voffA[i] = (unsigned)(R * g.lda + C) * 2u; voffB[i] = (unsigned)(Rb * g.ldb + C) * 2u; }
    const size_t kstep = (size_t)(BK * 2);
    const size_t hstepA = (size_t)HALF * g.lda * 2, hstepB = (size_t)HALF * g.ldb * 2;
    const size_t tstepA = 2 * hstepA, tstepB = 2 * hstepB;
    const unsigned ldsw = (unsigned)wid * 1024u; const unsigned lds32 = (unsigned)(uintptr_t)lds; const int sc1_ = 0x7f7f7f7f;
    const int aoff = lds_byte(wr * 64 + fr, fq * 8), boff = lds_byte(wc * 32 + fr, fq * 8);
#define PG8_SA(b, h) (((b) * 2 + (h)) * HTB)
#define PG8_SB(b, h) ((4 + (b) * 2 + (h)) * HTB)
#define PG8_STAGE(bufoff, gbase, voff) do { _Pragma("unroll") for (int _i = 0; _i < 2; ++_i) \
        glds_s((const char*)(gbase), (voff)[_i], (unsigned)__builtin_amdgcn_readfirstlane((int)(lds32 + (unsigned)(bufoff) + ldsw + _i * 8192))); } while (0)
#define PG8_LDF(dst, i_, k_, addr_) do { const u32x4 t_ = *(const PG8_LAS u32x4*)(addr_); \
        if constexpr (FP8) { dst##8[i_][4 * (k_)] = (int)t_.x; dst##8[i_][4 * (k_) + 1] = (int)t_.y; dst##8[i_][4 * (k_) + 2] = (int)t_.z; dst##8[i_][4 * (k_) + 3] = (int)t_.w; } \
        else dst[i_][k_] = __builtin_bit_cast(bf16x8, t_); } while (0)
#define PG8_LDA(dst, b, h) do { _Pragma("unroll") for (int m = 0; m < 4; ++m) _Pragma("unroll") for (int k = 0; k < 2; ++k) PG8_LDF(dst, m, k, lds + PG8_SA(b, h) + aoff + m * 2048 + k * 1024); } while (0)
#define PG8_LDB(dst, b, h) do { _Pragma("unroll") for (int n = 0; n < 2; ++n) _Pragma("unroll") for (int k = 0; k < 2; ++k) PG8_LDF(dst, n, k, lds + PG8_SB(b, h) + boff + n * 2048 + k * 1024); } while (0)
#define PG8_MMA(ai, bj, At, Bt) do { __builtin_amdgcn_s_setprio(1); \
        if constexpr (FP8) { _Pragma("unroll") for (int m = 0; m < 4; ++m) _Pragma("unroll") for (int n = 0; n < 2; ++n) \
            asm volatile("v_mfma_scale_f32_16x16x128_f8f6f4 %0, %1, %2, %0, %3, %3 op_sel_hi:[0,0,0]" : "+v"(acc[ai][bj][m][n]) : "v"(Bt##8[n]), "v"(At##8[m]), "v"(sc1_)); } \
        else { _Pragma("unroll") for (int m = 0; m < 4; ++m) _Pragma("unroll") for (int n = 0; n < 2; ++n) _Pragma("unroll") for (int k = 0; k < 2; ++k) \
            acc[ai][bj][m][n] = __builtin_amdgcn_mfma_f32_16x16x32_bf16(Bt[n][k], At[m][k], acc[ai][bj][m][n], 0, 0, 0); } \
        __builtin_amdgcn_s_setprio(0); } while (0)
#define PG8_WAIT_V(n) asm volatile("s_waitcnt vmcnt(" #n ")" ::: "memory")
#define PG8_WAIT_L(n) asm volatile("s_waitcnt lgkmcnt(" #n ")" ::: "memory")
#define PG8_BAR __builtin_amdgcn_s_barrier()
#define PG8_SCHED __builtin_amdgcn_sched_barrier(0)
    Unit cur, nxt; int ui = 0;
    if (!S.next(0, cur)) return;
    f32x4 acc[2][2][4][2];
#pragma unroll
    for (int a = 0; a < 2; ++a)
#pragma unroll
        for (int b = 0; b < 2; ++b)
#pragma unroll
            for (int m = 0; m < 4; ++m)
#pragma unroll
                for (int n = 0; n < 2; ++n) acc[a][b][m][n] = (f32x4){0.f, 0.f, 0.f, 0.f};
    bf16x8 At[4][2], B0[2][2], B1[2][2]; v8i At8[4], B08[2], B18[2];
    const char* cA = (const char*)g.A + (size_t)cur.pa * tstepA + (size_t)cur.ak * 2; const char* cB = (const char*)g.Bt + (size_t)cur.pb * tstepB;
    S.a_ready(cur);
    if constexpr (SP2) {
        PG8_STAGE(PG8_SB(0, 0), cB, voffB); PG8_STAGE(PG8_SB(0, 1), cB + hstepB, voffB); PG8_STAGE(PG8_SA(0, 0), cA, voffA); PG8_STAGE(PG8_SA(0, 1), cA + hstepA, voffA);
        if (wr == 1) PG8_BAR;
        PG8_WAIT_V(2); PG8_BAR;
        PG8_STAGE(PG8_SB(1, 0), cB + kstep, voffB); PG8_STAGE(PG8_SA(1, 0), cA + kstep, voffA); PG8_STAGE(PG8_SB(1, 1), cB + hstepB + kstep, voffB);
        PG8_WAIT_V(6); PG8_BAR;
    } else {
        PG8_STAGE(PG8_SB(0, 0), cB, voffB); PG8_STAGE(PG8_SA(0, 0), cA, voffA); PG8_STAGE(PG8_SB(0, 1), cB + hstepB, voffB); PG8_STAGE(PG8_SA(0, 1), cA + hstepA, voffA);
        if (wr == 1) PG8_BAR;
        PG8_WAIT_V(4); PG8_BAR;
        PG8_STAGE(PG8_SB(1, 0), cB + kstep, voffB); PG8_STAGE(PG8_SA(1, 0), cA + kstep, voffA); PG8_STAGE(PG8_SB(1, 1), cB + hstepB + kstep, voffB);
        PG8_WAIT_V(6); PG8_BAR;
    }
    for (;;) {
        const bool has_next = S.next(ui + 1, nxt);
        const char* nA = has_next ? (const char*)g.A + (size_t)nxt.pa * tstepA + (size_t)nxt.ak * 2 : cA; const char* nB = has_next ? (const char*)g.Bt + (size_t)nxt.pb * tstepB : cB;
        asm volatile(".p2align 6\n\t.rept 2\n\ts_nop 0\n\t.endr");
#pragma nounroll
        for (int t = 0; t < nt; t += 2) {
            const bool last = (t == nt - 2);
            const char* a1 = cA + (size_t)(t + 1) * kstep;
            const char* a2 = last ? nA : cA + (size_t)(t + 2) * kstep; const char* b2 = last ? nB : cB + (size_t)(t + 2) * kstep;
            const char* a3 = a2 + kstep; const char* b3 = b2 + kstep;
            if (last && has_next) S.a_ready(nxt);
            if constexpr (SP2) {
            PG8_LDB(B0, 0, 0); PG8_LDB(B1, 0, 1); PG8_SCHED; PG8_LDA(At, 0, 0); PG8_STAGE(PG8_SA(1, 1), a1 + hstepA, voffA);
            PG8_WAIT_V(8); PG8_WAIT_L(0); PG8_BAR; PG8_MMA(0, 0, At, B0); PG8_MMA(0, 1, At, B1); PG8_BAR; PG8_SCHED;
            PG8_LDA(At, 0, 1); PG8_STAGE(PG8_SB(0, 0), b2, voffB); PG8_STAGE(PG8_SB(0, 1), b2 + hstepB, voffB); PG8_STAGE(PG8_SA(0, 0), a2, voffA);
            PG8_WAIT_V(8); PG8_WAIT_L(0); PG8_BAR; PG8_MMA(1, 0, At, B0); PG8_MMA(1, 1, At, B1); PG8_BAR; PG8_SCHED;
            PG8_LDB(B0, 1, 0); PG8_LDB(B1, 1, 1); PG8_SCHED; PG8_LDA(At, 1, 0); PG8_STAGE(PG8_SA(0, 1), a2 + hstepA, voffA);
            PG8_WAIT_V(8); PG8_WAIT_L(0); PG8_BAR; PG8_MMA(0, 0, At, B0); PG8_MMA(0, 1, At, B1); PG8_BAR; PG8_SCHED;
            PG8_LDA(At, 1, 1); PG8_STAGE(PG8_SB(1, 0), b3, voffB); PG8_STAGE(PG8_SB(1, 1), b3 + hstepB, voffB); PG8_STAGE(PG8_SA(1, 0), a3, voffA);
            PG8_WAIT_V(8); PG8_WAIT_L(0); PG8_BAR; PG8_MMA(1, 0, At, B0); PG8_MMA(1, 1, At, B1); PG8_BAR; PG8_SCHED;
            } else {
            PG8_LDB(B0, 0, 0); PG8_SCHED; PG8_LDA(At, 0, 0); PG8_STAGE(PG8_SA(1, 1), a1 + hstepA, voffA);
            PG8_WAIT_L(8); PG8_BAR; PG8_WAIT_L(0); PG8_MMA(0, 0, At, B0); PG8_BAR; PG8_SCHED;
            PG8_LDB(B1, 0, 1); PG8_STAGE(PG8_SB(0, 0), b2, voffB);
            PG8_BAR; PG8_WAIT_L(0); PG8_MMA(0, 1, At, B1); PG8_BAR;
            PG8_LDA(At, 0, 1); PG8_STAGE(PG8_SA(0, 0), a2, voffA);
            PG8_BAR; PG8_WAIT_L(0); PG8_MMA(1, 0, At, B0); PG8_BAR; PG8_SCHED;
            PG8_STAGE(PG8_SB(0, 1), b2 + hstepB, voffB);
            PG8_WAIT_V(6); PG8_BAR; PG8_MMA(1, 1, At, B1); PG8_BAR;
            PG8_LDB(B0, 1, 0); PG8_SCHED; PG8_LDA(At, 1, 0); PG8_STAGE(PG8_SA(0, 1), a2 + hstepA, voffA);
            PG8_WAIT_L(8); PG8_BAR; PG8_WAIT_L(0); PG8_MMA(0, 0, At, B0); PG8_BAR; PG8_SCHED;
            PG8_LDB(B1, 1, 1); PG8_STAGE(PG8_SB(1, 0), b3, voffB);
            PG8_BAR; PG8_WAIT_L(0); PG8_MMA(0, 1, At, B1); PG8_BAR;
            PG8_LDA(At, 1, 1); PG8_STAGE(PG8_SA(1, 0), a3, voffA);
            PG8_BAR; PG8_WAIT_L(0); PG8_MMA(1, 0, At, B0); PG8_BAR; PG8_SCHED;
            PG8_STAGE(PG8_SB(1, 1), b3 + hstepB, voffB);
            PG8_WAIT_V(6); PG8_BAR; PG8_MMA(1, 1, At, B1); PG8_BAR;
            }
        }
        if constexpr (ALIGN_EPI) { if (wr == 0) PG8_BAR; }
        if constexpr (FP8) asm volatile("s_nop 15\n\ts_nop 15" ::: "memory");
        if constexpr (!Epi::AFTER_DRAIN) { const int l2_ = mk_lane(); E(acc, cur, wid >> 2, wid & 3, l2_ & 15, l2_ >> 4); S.done(cur); }
        if (!has_next) break;
#pragma unroll
        for (int a = 0; a < 2; ++a)
#pragma unroll
            for (int b = 0; b < 2; ++b)
#pragma unroll
                for (int m = 0; m < 4; ++m)
#pragma unroll
                    for (int n = 0; n < 2; ++n) acc[a][b][m][n] = (f32x4){0.f, 0.f, 0.f, 0.f};
        cur = nxt; cA = nA; cB = nB; ++ui;
        if constexpr (ALIGN_EPI) { if (wr == 1) PG8_BAR; }
    }
    PG8_WAIT_V(0);
    if constexpr (!ALIGN_EPI) { if (wr == 0) PG8_BAR; }
    PG8_BAR;
    if constexpr (Epi::AFTER_DRAIN) { E.fused(acc, cur, wr, wc, fr, fq, lds, wid, lane); S.done(cur); }
#undef PG8_SA
#undef PG8_SB
#undef PG8_STAGE
#undef PG8_LDF
#undef PG8_LDA
#undef PG8_LDB
#undef PG8_MMA
#undef PG8_WAIT_V
#undef PG8_WAIT_L
#undef PG8_BAR
#undef PG8_SCHED
}
}

#include <hip/hip_bf16.h>
#include <cmath>
namespace attn_body {
using bf16=__hip_bfloat16;
using bf16x8=__attribute__((ext_vector_type(8)))short;
using s16x4=__attribute__((ext_vector_type(4)))short;
using f32x16=__attribute__((ext_vector_type(16)))float;
using u32x4=__attribute__((ext_vector_type(4)))unsigned;
using v8i_t=__attribute__((ext_vector_type(8)))int;
using f32x4v=__attribute__((ext_vector_type(4)))float;
using v6i_t=__attribute__((ext_vector_type(6)))int;
constexpr float QF6=8.0f,KF6=2.0f; constexpr int QSC6=0x7C7C7C7C,KSC6=0x7E7E7E7E;
constexpr float QF8=16.0f,KF8=4.0f,VF8=8.0f; constexpr int QSC8=0x7B7B7B7B,KSC8=0x7D7D7D7D,VSC8=0x7C7C7C7C;
constexpr int BATCH=2,NHEAD=16,SEQ=16384,D=64,DM=NHEAD*D,KVP=256,LKV=16640;
constexpr int NW=8,QBLK=32,QB=QBLK*NW,KVBLK=64,NQB=SEQ/QB;
constexpr int ATTN_PITCH=DM, ATTN_UNIT_ROWS=QB;
__device__ __forceinline__ int crow(int r,int hi){return (r&3)+8*(r>>2)+4*hi;}
#define SBAR() __builtin_amdgcn_sched_barrier(0)
__device__ __forceinline__ void cmask(f32x16&p0,f32x16&p1,int jb,int qrel,int hi){
  const float NEG=-INFINITY; int kb=64*jb+4*hi;
  #pragma unroll
  for(int r=0;r<16;++r){int kv=kb+(r&3)+8*(r>>2); if(kv>qrel)p0[r]=NEG; if(kv+32>qrel)p1[r]=NEG;}
}

constexpr int NSLOT=3, SLOTB=8192;
constexpr int LDS_K=0, LDS_V=NSLOT*SLOTB, LDS_WS=2*NSLOT*SLOTB, LDS_OST=LDS_WS+NW*64*4, LDS_BYTES=LDS_OST+NW*4096;
constexpr float C2=0.125f*1.4426950408889634f;
__device__ __forceinline__ void glds16(const void*gsrc,unsigned lds_dst){unsigned keep;
  asm volatile("s_mov_b32 %0, m0\n\ts_mov_b32 m0, %2\n\ts_nop 0\n\tglobal_load_lds_dwordx4 %1, off\n\ts_mov_b32 m0, %0":"=&s"(keep):"v"(gsrc),"s"(lds_dst):"memory");}
__device__ __forceinline__ float max3f(float a,float b,float c){float r;asm("v_max3_f32 %0, %1, %2, %3":"=v"(r):"v"(a),"v"(b),"v"(c));return r;}
__device__ __forceinline__ float max2f(float a,float b){float r;asm("v_max_f32_e32 %0, %1, %2":"=v"(r):"v"(a),"v"(b));return r;}
__device__ __forceinline__ float fadd_s(float a,float b){float r;asm("v_add_f32_e32 %0, %1, %2":"=v"(r):"v"(a),"v"(b));return r;}
__device__ __forceinline__ float fsub_s(float a,float b){float r;asm("v_sub_f32_e32 %0, %1, %2":"=v"(r):"v"(a),"v"(b));return r;}
typedef float f32x2_t __attribute__((ext_vector_type(2))); typedef __bf16 bf16x2_t __attribute__((ext_vector_type(2)));
__device__ __forceinline__ unsigned cvtpk_s(float lo,float hi){f32x2_t v={lo,hi};bf16x2_t b=__builtin_convertvector(v,bf16x2_t);return __builtin_bit_cast(unsigned,b);}
#define WAIT_BAR(N) asm volatile("s_waitcnt vmcnt(" #N ") lgkmcnt(0)\n\ts_barrier":::"memory")

__device__ __forceinline__ void qkt(f32x16&p0,f32x16&p1,const char*Kslot,const bf16x8*qr,const f32x16&negm,int r32,int hi){
  const char*kb=Kslot+hi*1024+r32*16;
  #pragma unroll
  for(int d0=0;d0<4;++d0){
    const bf16x8 b0=*reinterpret_cast<const bf16x8*>(kb+d0*2048);
    const bf16x8 b1=*reinterpret_cast<const bf16x8*>(kb+d0*2048+512);
    if(d0==0){p0=__builtin_amdgcn_mfma_f32_32x32x16_bf16(b0,qr[0],negm,0,0,0);p1=__builtin_amdgcn_mfma_f32_32x32x16_bf16(b1,qr[0],negm,0,0,0);}
    else{p0=__builtin_amdgcn_mfma_f32_32x32x16_bf16(b0,qr[d0],p0,0,0,0);p1=__builtin_amdgcn_mfma_f32_32x32x16_bf16(b1,qr[d0],p1,0,0,0);}}
}
typedef __attribute__((address_space(3))) const char* lds_cptr;
typedef short v4i16_t __attribute__((ext_vector_type(4)));
__device__ __forceinline__ void kload8(bf16x8*kf,lds_cptr kp){
  kf[0]=*(const __attribute__((address_space(3))) bf16x8*)(kp);      kf[1]=*(const __attribute__((address_space(3))) bf16x8*)(kp+512);
  kf[2]=*(const __attribute__((address_space(3))) bf16x8*)(kp+2048); kf[3]=*(const __attribute__((address_space(3))) bf16x8*)(kp+2560);
  kf[4]=*(const __attribute__((address_space(3))) bf16x8*)(kp+4096); kf[5]=*(const __attribute__((address_space(3))) bf16x8*)(kp+4608);
  kf[6]=*(const __attribute__((address_space(3))) bf16x8*)(kp+6144); kf[7]=*(const __attribute__((address_space(3))) bf16x8*)(kp+6656);
}
__device__ __forceinline__ void kload2(bf16x8*kf,lds_cptr kp,int j){ kf[2*j]=*(const __attribute__((address_space(3))) bf16x8*)(kp+j*2048); kf[2*j+1]=*(const __attribute__((address_space(3))) bf16x8*)(kp+j*2048+512); }
__device__ __forceinline__ s16x4 vtr(lds_cptr p){ return __builtin_bit_cast(s16x4,__builtin_amdgcn_ds_read_tr16_b64_v4i16((__attribute__((address_space(3))) v4i16_t*)p)); }
__device__ __forceinline__ float rowmax(const f32x16&p0,const f32x16&p1){
  float a=max3f(p0[0],p0[1],p1[0]),b=max3f(p0[2],p0[3],p1[1]);a=max3f(a,p1[2],p1[3]);
  #pragma unroll
  for(int r=4;r<16;r+=4){a=max3f(a,p0[r],p0[r+1]);b=max3f(b,p0[r+2],p0[r+3]);a=max3f(a,p1[r],p1[r+1]);b=max3f(b,p1[r+2],p1[r+3]);}
  const float m=max2f(a,b);
  auto rr=__builtin_amdgcn_permlane32_swap(__float_as_uint(m),__float_as_uint(m),false,false);
  return max2f(__uint_as_float(rr[0]),__uint_as_float(rr[1]));
}
__device__ __forceinline__ void pv(f32x16*o,int vb,bf16x8 pa0,bf16x8 pa1,bf16x8 pa2,bf16x8 pa3){
  #pragma unroll
  for(int d0=0;d0<2;++d0){s16x4 lo[4],hi[4];
    #pragma unroll
    for(int ks=0;ks<4;++ks){
      asm volatile("ds_read_b64_tr_b16 %0,%1 offset:%c2":"=&v"(lo[ks]):"v"(vb),"i"(d0*4096+ks*1024):"memory");
      asm volatile("ds_read_b64_tr_b16 %0,%1 offset:%c2":"=&v"(hi[ks]):"v"(vb),"i"(d0*4096+ks*1024+512):"memory");}
    asm volatile("s_waitcnt lgkmcnt(0)":::"memory");SBAR();
    #define PK(k) (bf16x8){lo[k][0],lo[k][1],lo[k][2],lo[k][3],hi[k][0],hi[k][1],hi[k][2],hi[k][3]}
    o[d0]=__builtin_amdgcn_mfma_f32_32x32x16_bf16(pa0,PK(0),o[d0],0,0,0);
    o[d0]=__builtin_amdgcn_mfma_f32_32x32x16_bf16(pa1,PK(1),o[d0],0,0,0);
    o[d0]=__builtin_amdgcn_mfma_f32_32x32x16_bf16(pa2,PK(2),o[d0],0,0,0);
    o[d0]=__builtin_amdgcn_mfma_f32_32x32x16_bf16(pa3,PK(3),o[d0],0,0,0);
    #undef PK
  }
}

#ifndef ATTN_STORE16
#define ATTN_STORE16(p,v) (*(u32x4*)(p)=(v))
#endif
template<int THRL> __device__ __forceinline__ void attn_unit(int wv,int b,int h,int qb,const bf16*Q,const bf16*__restrict__ K,const bf16*__restrict__ V,bf16*O,char*shm){
  const int lane=mk_lane(),r32=lane&31,hi=lane>>5; const int wid=wv;
  const long rowbase=(long)b*SEQ; const long rowk=(long)b*LKV; const int q0=qb*QB;
  const bf16*Qw=Q+(rowbase+q0+wid*QBLK)*DM+h*D;
  const bf16*Kh=K+rowk*KVP+(h>>2)*D,*Vh=V+rowk*KVP+(h>>2)*D;
  const unsigned lds0=(unsigned)(uintptr_t)shm;
  float*wsf=(float*)(shm+LDS_WS)+wid*64;
  const bf16*ksrc=Kh+(long)lane*KVP+wid*8;
  const bf16*vsrc=Vh+(long)(16*(wid&3)+(lane>>2))*KVP+(wid>>2)*32+(lane&3)*8;
  const unsigned kdst=lds0+LDS_K+wid*1024, vdst=lds0+LDS_V+wid*1024;
  #define DMA_K(t,slot) glds16(ksrc+(long)(t)*KVBLK*KVP,(unsigned)__builtin_amdgcn_readfirstlane(kdst+(slot)))
  #define DMA_V(t,slot) glds16(vsrc+(long)(t)*KVBLK*KVP,(unsigned)__builtin_amdgcn_readfirstlane(vdst+(slot)))
  const int vb0=(int)(lds0+LDS_V)+((lane>>4)&1)*32+(lane&3)*8+(4*hi+((lane&15)>>2))*64;
  const char*Kbase=shm+LDS_K; bf16x8 kf[8];
  const lds_cptr shm3=(lds_cptr)shm; const lds_cptr kp0=shm3+LDS_K+hi*1024+r32*16; const lds_cptr vp0=shm3+LDS_V+((lane>>4)&1)*32+(lane&3)*8+(4*hi+((lane&15)>>2))*64;
  constexpr int NT=LKV/KVBLK;
  DMA_K(0,0);DMA_V(0,0);DMA_K(1,SLOTB);
  bf16x8 qr[4];
  #pragma unroll
  for(int d0=0;d0<4;++d0)qr[d0]=*reinterpret_cast<const bf16x8*>(&Qw[(long)r32*DM+d0*16+hi*8]);
  float mhat=0.f,l_reg=0.f;f32x16 o[2];o[0]=f32x16{};o[1]=f32x16{};f32x16 negm=f32x16{};asm volatile("":"+v"(negm));

  #define CMASK(P0,P1,t) do{}while(0)
  bool resc=false;
  #define START(P0,P1) do{ const float rm=rowmax(P0,P1); resc=false; \
    { const float dl=rm; mhat=fadd_s(mhat,dl); \
      _Pragma("unroll") for(int r=0;r<16;++r){P0[r]=fsub_s(P0[r],dl);P1[r]=fsub_s(P1[r],dl);} \
      _Pragma("unroll") for(int r=0;r<16;++r)negm[r]=-mhat; asm volatile("":"+v"(negm)); } \
    _Pragma("unroll") for(int r=0;r<16;++r)P0[r]=__builtin_amdgcn_exp2f(P0[r]); }while(0)
  #define RESC() do{ if(resc){ asm volatile("s_waitcnt lgkmcnt(0)":::"memory"); \
      _Pragma("unroll") for(int d_=0;d_<2;++d_) _Pragma("unroll") for(int r=0;r<16;++r)o[d_][r]*=wsf[crow(r,hi)]; } }while(0)
  f32x16 pA0,pA1,pB0,pB1;
  int sl_prev=0,sl_cur=0,sl_next=SLOTB;
  #define ROT() do{sl_prev=sl_cur;sl_cur=sl_next;sl_next=(sl_next==(NSLOT-1)*SLOTB)?0:sl_next+SLOTB;}while(0)
  DMA_K(2,2*SLOTB);
  WAIT_BAR(3);
  qkt(pA0,pA1,Kbase,qr,negm,r32,hi);asm volatile("s_nop 15\n\ts_nop 7":"+v"(pA0),"+v"(pA1));CMASK(pA0,pA1,0);
  START(pA0,pA1);
  _Pragma("unroll") for(int r=0;r<16;++r)pA1[r]=__builtin_amdgcn_exp2f(pA1[r]);
  WAIT_BAR(0);
  DMA_K(3,0);DMA_V(1,SLOTB);
  ROT();
  kload8(kf,kp0+sl_cur);
  WAIT_BAR(2);
  s16x4 vlo[8],vhi[8]; u32x4 pw0,pw1,pw2,pw3;
  #define PKW(P,B) cvtpk_s(P[B],P[B+1])
  #define PAF(k) __builtin_bit_cast(bf16x8,pw##k)
  #define VFR(i) (bf16x8){vlo[i][0],vlo[i][1],vlo[i][2],vlo[i][3],vhi[i][0],vhi[i][1],vhi[i][2],vhi[i][3]}
  #define PIN(x) asm volatile("":"+v"(x))
  #define MX3(a,b,c) __builtin_fmaxf(__builtin_fmaxf((a),(b)),(c))
  #define GAPA(MF,A0,A1,A2,A3,W0,W1,PW) do{ MF; sacc+=A0; sacc+=A1; sacc+=A2; sacc+=A3; PIN(sacc); W0; W1; PIN(PW); SBAR(); }while(0)
  #define EX(v) __builtin_amdgcn_exp2f(v)
  #define GAPB(MF,X,B) do{ MF; X[B]=EX(X[B]); X[B+1]=EX(X[B+1]); X[B+2]=EX(X[B+2]); X[B+3]=EX(X[B+3]); PIN(X); SBAR(); }while(0)
  #define VRD(i) do{ vlo[i]=vtr(vp_+(((i)>>2)*4096+((i)&3)*1024)); vhi[i]=vtr(vp_+(((i)>>2)*4096+((i)&3)*1024+512)); }while(0)
  #define KRD(G,j) do{ if(G){ kload2(kf,kp0+sl_next,j); SBAR(); } }while(0)
  #define STEP(C0,C1,P0,P1,t,GK,GV,GL) do{ SBAR(); \
    const lds_cptr vp_=vp0+sl_prev; \
    VRD(0); SBAR(); float sacc=(P0[0]+P0[1]); \
    GAPA(C0=__builtin_amdgcn_mfma_f32_32x32x16_bf16(kf[0],qr[0],negm,0,0,0), P0[2],P0[3],P0[4],P0[5],     pw0[0]=PKW(P0,0), pw0[1]=PKW(P0,2), pw0); \
    VRD(4); SBAR(); GAPA(C1=__builtin_amdgcn_mfma_f32_32x32x16_bf16(kf[1],qr[0],negm,0,0,0), P0[6],P0[7],P0[8],P0[9],     pw0[2]=PKW(P0,4), pw0[3]=PKW(P0,6), pw0); \
    VRD(1); SBAR(); GAPA(C0=__builtin_amdgcn_mfma_f32_32x32x16_bf16(kf[2],qr[1],C0,0,0,0),   P0[10],P0[11],P0[12],P0[13], pw1[0]=PKW(P0,8), pw1[1]=PKW(P0,10), pw1); \
    VRD(5); SBAR(); GAPA(C1=__builtin_amdgcn_mfma_f32_32x32x16_bf16(kf[3],qr[1],C1,0,0,0),   P0[14],P0[15],P1[0],P1[1],   pw1[2]=PKW(P0,12),pw1[3]=PKW(P0,14), pw1); \
    VRD(2); SBAR(); GAPA(C0=__builtin_amdgcn_mfma_f32_32x32x16_bf16(kf[4],qr[2],C0,0,0,0),   P1[2],P1[3],P1[4],P1[5],     pw2[0]=PKW(P1,0), pw2[1]=PKW(P1,2), pw2); \
    VRD(6); SBAR(); GAPA(C1=__builtin_amdgcn_mfma_f32_32x32x16_bf16(kf[5],qr[2],C1,0,0,0),   P1[6],P1[7],P1[8],P1[9],     pw2[2]=PKW(P1,4), pw2[3]=PKW(P1,6), pw2); \
    VRD(3); SBAR(); GAPA(C0=__builtin_amdgcn_mfma_f32_32x32x16_bf16(kf[6],qr[3],C0,0,0,0),   P1[10],P1[11],P1[12],P1[13], pw3[0]=PKW(P1,8), pw3[1]=PKW(P1,10), pw3); \
    VRD(7); SBAR(); GAPA(C1=__builtin_amdgcn_mfma_f32_32x32x16_bf16(kf[7],qr[3],C1,0,0,0),   P1[14],P1[15],0.f,0.f,       pw3[2]=PKW(P1,12),pw3[3]=PKW(P1,14), pw3); \
    l_reg+=sacc; \
    if(GK){DMA_K((t)+3,sl_cur);} if(GV){DMA_V((t)+1,sl_next);} \
    CMASK(C0,C1,t); \
    { float a=MX3(C0[0],C0[1],C1[0]),b=MX3(C0[2],C0[3],C1[1]); a=MX3(a,C1[2],C1[3]); \
      _Pragma("unroll") for(int r=4;r<16;r+=4){a=MX3(a,C0[r],C0[r+1]);b=MX3(b,C0[r+2],C0[r+3]);a=MX3(a,C1[r],C1[r+1]);b=MX3(b,C1[r+2],C1[r+3]);} \
      float rm=__builtin_fmaxf(a,b); { auto rr=__builtin_amdgcn_permlane32_swap(__float_as_uint(rm),__float_as_uint(rm),false,false); rm=__builtin_fmaxf(__uint_as_float(rr[0]),__uint_as_float(rr[1])); } \
      resc=false; \
      if(__builtin_expect(__any(rm>(float)THRL),0)){ const float dl=__builtin_fmaxf(rm,0.f); mhat+=dl; \
        _Pragma("unroll") for(int r=0;r<16;++r){C0[r]-=dl;C1[r]-=dl;} \
        _Pragma("unroll") for(int r=0;r<16;++r)negm[r]=-mhat; asm volatile("":"+v"(negm)); \
        const float f=__builtin_amdgcn_exp2f(-dl); l_reg*=f; if(hi==0)wsf[r32]=f; resc=true; } } \
    SBAR(); \
    GAPB(o[0]=__builtin_amdgcn_mfma_f32_32x32x16_bf16(PAF(0),VFR(0),o[0],0,0,0), C0,0); \
    GAPB(o[1]=__builtin_amdgcn_mfma_f32_32x32x16_bf16(PAF(0),VFR(4),o[1],0,0,0), C0,4); \
    KRD(GL,0); GAPB(o[0]=__builtin_amdgcn_mfma_f32_32x32x16_bf16(PAF(1),VFR(1),o[0],0,0,0), C0,8); \
    KRD(GL,1); GAPB(o[1]=__builtin_amdgcn_mfma_f32_32x32x16_bf16(PAF(1),VFR(5),o[1],0,0,0), C0,12); \
    KRD(GL,2); GAPB(o[0]=__builtin_amdgcn_mfma_f32_32x32x16_bf16(PAF(2),VFR(2),o[0],0,0,0), C1,0); \
    KRD(GL,3); GAPB(o[1]=__builtin_amdgcn_mfma_f32_32x32x16_bf16(PAF(2),VFR(6),o[1],0,0,0), C1,4); \
    GAPB(o[0]=__builtin_amdgcn_mfma_f32_32x32x16_bf16(PAF(3),VFR(3),o[0],0,0,0), C1,8); \
    GAPB(o[1]=__builtin_amdgcn_mfma_f32_32x32x16_bf16(PAF(3),VFR(7),o[1],0,0,0), C1,12); \
    }while(0)
  int t=1;
  #undef CMASK
  #define CMASK(P0,P1,t) do{}while(0)
  for(;t+5<NT;t+=2){
    STEP(pB0,pB1,pA0,pA1,t,true,true,true);     WAIT_BAR(2); RESC(); ROT();
    STEP(pA0,pA1,pB0,pB1,t+1,true,true,true);   WAIT_BAR(2); RESC(); ROT();
  }
  #undef CMASK
  #define CMASK(P0,P1,t) do{}while(0)
  #define ENDW(tt) do{ if((tt)+3<NT){WAIT_BAR(2);} else if((tt)+2<NT){WAIT_BAR(1);} else {WAIT_BAR(0);} }while(0)
  for(;t+1<NT;t+=2){
    STEP(pB0,pB1,pA0,pA1,t,(t+3<NT),(t+1<NT),(t+1<NT));       ENDW(t);   RESC(); ROT();
    STEP(pA0,pA1,pB0,pB1,t+1,(t+4<NT),(t+2<NT),(t+2<NT));     ENDW(t+1); RESC(); ROT();
  }
  STEP(pB0,pB1,pA0,pA1,NT-1,false,false,false); RESC();
  { float sacc=pB0[0]+pB0[1]; _Pragma("unroll") for(int r=2;r<16;++r)sacc+=pB0[r]; _Pragma("unroll") for(int r=0;r<16;++r)sacc+=pB1[r]; l_reg+=sacc;
    pw0=(u32x4){PKW(pB0,0),PKW(pB0,2),PKW(pB0,4),PKW(pB0,6)};pw1=(u32x4){PKW(pB0,8),PKW(pB0,10),PKW(pB0,12),PKW(pB0,14)};pw2=(u32x4){PKW(pB1,0),PKW(pB1,2),PKW(pB1,4),PKW(pB1,6)};pw3=(u32x4){PKW(pB1,8),PKW(pB1,10),PKW(pB1,12),PKW(pB1,14)};
    SBAR(); pv(o,vb0+sl_cur,PAF(0),PAF(1),PAF(2),PAF(3)); }
  #undef PKW
  #undef PAF
  #undef VFR
  #undef PIN
  #undef MX3
  #undef GAPA
  #undef GAPB
  #undef EX
  #undef VRD
  #undef KRD
  #undef STEP
  #undef ENDW
  {auto rr=__builtin_amdgcn_permlane32_swap(__float_as_uint(l_reg),__float_as_uint(l_reg),false,false);l_reg=__uint_as_float(rr[0])+__uint_as_float(rr[1]);}
  if(hi==0)wsf[32+r32]=l_reg;asm volatile("s_waitcnt lgkmcnt(0)":::"memory");
  float rli[16];
  #pragma unroll
  for(int r=0;r<16;++r)rli[r]=__builtin_amdgcn_rcpf(wsf[32+crow(r,hi)]);
  bf16*Ow=O+(rowbase+q0+wid*QBLK)*DM+h*D;
  { bf16*stg=(bf16*)(shm+LDS_OST)+wid*2048;
    #pragma unroll
    for(int r=0;r<16;++r){const int orow=crow(r,hi);
      #pragma unroll
      for(int d0=0;d0<2;++d0)stg[orow*64+d0*32+r32]=__float2bfloat16(o[d0][r]*rli[r]);}
    asm volatile("s_waitcnt lgkmcnt(0)":::"memory");
    #pragma unroll
    for(int i=0;i<4;++i){const int row=i*8+(lane>>3),ch=lane&7; const u32x4 v=*(const u32x4*)(stg+row*64+ch*8); ATTN_STORE16(Ow+(long)row*DM+ch*8,v);} }
  asm volatile("s_waitcnt lgkmcnt(0)\n\ts_barrier":::"memory");
  #undef DMA_K
  #undef DMA_V
  #undef CMASK
  #undef START
  #undef RESC
  #undef ROT
}
constexpr int F_LDS_K=0, F_LDS_V=4*SLOTB, F_LDS_OST=8*SLOTB, F_LDS_BYTES=F_LDS_OST+NW*4096;
__device__ __forceinline__ void attn_unit_fast(int wv,int b,int h,int qb,const unsigned char*Q,const unsigned char*__restrict__ K,const unsigned char*__restrict__ VT,bf16*O,char*shm,float cref){
  const int lane=mk_lane(),r32=lane&31,hi=lane>>5; const int wid=wv; const bool kwave=wid<4;
  const long rowbase=(long)b*SEQ; const long rowk=(long)b*LKV; const int q0=qb*QB;
  const unsigned char*Qw=Q+(rowbase+q0+wid*QBLK)*DM+h*D;
  const unsigned char*Kh=K+rowk*KVP+(h>>2)*D;
  const unsigned char*Vh=VT+(long)((b*4+(h>>2))*D)*LKV;
  const unsigned lds0=(unsigned)(uintptr_t)shm;
  const unsigned char*ksrc=Kh+(long)lane*KVP+(wid&3)*16;
  const unsigned char*vsrc=Vh+(long)lane*LKV+(wid&3)*16;
  const unsigned kdst=lds0+F_LDS_K+(wid&3)*1024, vdst=lds0+F_LDS_V+(wid&3)*1024;
  #define SL4(t) (((t)&3)*SLOTB)
  #define DMA_K(t) glds16(ksrc+(long)(t)*KVBLK*KVP,(unsigned)__builtin_amdgcn_readfirstlane(kdst+SL4(t)))
  #define DMA_V(t) glds16(vsrc+(long)(t)*KVBLK,(unsigned)__builtin_amdgcn_readfirstlane(vdst+SL4(t)))
#if MK_QK_FP6
  v6i_t kf0,kf1; v8i_t vf0,vf1;
#else
  v8i_t kf0,kf1,vf0,vf1;
#endif
  const lds_cptr shm3=(lds_cptr)shm; const lds_cptr kp0=shm3+F_LDS_K+hi*2048+r32*16; const lds_cptr vp0=shm3+F_LDS_V+hi*2048+r32*16;
  constexpr int NT=LKV/KVBLK;
  if(kwave){DMA_K(0);DMA_K(1);DMA_K(2);DMA_K(3);} else {DMA_V(0);DMA_V(1);}
#if MK_QK_FP6
  v6i_t q8; { const u32x4 a_=*reinterpret_cast<const u32x4*>(&Qw[(long)r32*DM+hi*32]); const unsigned long long b_=*reinterpret_cast<const unsigned long long*>(&Qw[(long)r32*DM+hi*32+16]);
    q8=(v6i_t){(int)a_.x,(int)a_.y,(int)a_.z,(int)a_.w,(int)(unsigned)b_,(int)(unsigned)(b_>>32)}; }
#else
  v8i_t q8; { const u32x4 a_=*reinterpret_cast<const u32x4*>(&Qw[(long)r32*DM+hi*32]),b_=*reinterpret_cast<const u32x4*>(&Qw[(long)r32*DM+hi*32+16]);
    q8=(v8i_t){(int)a_.x,(int)a_.y,(int)a_.z,(int)a_.w,(int)b_.x,(int)b_.y,(int)b_.z,(int)b_.w}; }
#endif
  f32x16 o[2];o[0]=f32x16{};o[1]=f32x16{};f32x4v lacc=f32x4v{};
  f32x16 negc; { const float nc_=-cref; negc=(f32x16){nc_,nc_,nc_,nc_,nc_,nc_,nc_,nc_,nc_,nc_,nc_,nc_,nc_,nc_,nc_,nc_}; } asm volatile("":"+v"(negc));
  v8i_t ones8; { const int o_=(((lane&15)<8)==(((lane>>4)&1)==0))?0x38383838:0; ones8=(v8i_t){o_,o_,o_,o_,o_,o_,o_,o_}; } asm volatile("":"+v"(ones8));
  f32x16 pA0,pA1,pB0,pB1;
  #define KLD8(dst,kp) do{ const u32x4 a_=*(const __attribute__((address_space(3))) u32x4*)(kp),b_=*(const __attribute__((address_space(3))) u32x4*)((kp)+1024); \
    dst=(v8i_t){(int)a_.x,(int)a_.y,(int)a_.z,(int)a_.w,(int)b_.x,(int)b_.y,(int)b_.z,(int)b_.w}; }while(0)
#if MK_QK_FP6
  #define W8_(x) ((v8i_t){(x)[0],(x)[1],(x)[2],(x)[3],(x)[4],(x)[5],0,0})
  #define MFQK(a,b) __builtin_amdgcn_mfma_scale_f32_32x32x64_f8f6f4(W8_(a),W8_(b),negc,2,2,0,KSC6,0,QSC6)
  #define KLDK(dst,kp) do{ const u32x4 a_=*(const __attribute__((address_space(3))) u32x4*)(kp); const unsigned long long b_=*(const __attribute__((address_space(3))) unsigned long long*)((kp)+1024); \
    dst=(v6i_t){(int)a_.x,(int)a_.y,(int)a_.z,(int)a_.w,(int)(unsigned)b_,(int)(unsigned)(b_>>32)}; }while(0)
#else
  #define MFQK(a,b) __builtin_amdgcn_mfma_scale_f32_32x32x64_f8f6f4(a,b,negc,0,0,0,KSC8,0,QSC8)
  #define KLDK(dst,kp) KLD8(dst,kp)
#endif
  #define MFPV(p,v,c) __builtin_amdgcn_mfma_scale_f32_32x32x64_f8f6f4(p,v,c,1,0,0,0x7F7F7F7F,0,VSC8)
  #define MFPL(p,c) __builtin_amdgcn_mfma_scale_f32_32x32x64_f8f6f4(p,ones8,c,1,0,0,0x7F7F7F7F,0,0x7F7F7F7F)
  WAIT_BAR(2);
  KLDK(kf0,kp0); KLDK(kf1,kp0+512); pA0=MFQK(kf0,q8); pA1=MFQK(kf1,q8);
  _Pragma("unroll") for(int r=0;r<16;++r){pA0[r]=__builtin_amdgcn_exp2f(pA0[r]);pA1[r]=__builtin_amdgcn_exp2f(pA1[r]);}
  WAIT_BAR(2);
  if(kwave){DMA_K(4);} else {DMA_V(2);}
  WAIT_BAR(2);
  KLDK(kf0,kp0+SL4(1)); KLDK(kf1,kp0+SL4(1)+512);
  v8i_t p8;
  #define PK8(P,B,old,hi_) __builtin_amdgcn_cvt_pk_bf8_f32(P[B],P[B+1],old,hi_)
  #define PIN(x) asm volatile("":"+v"(x))
  #define EX(v) __builtin_amdgcn_exp2f(v)
  #define EXN(X,B,N) do{ _Pragma("unroll") for(int e_=0;e_<(N);++e_) X[(B)+e_]=EX(X[(B)+e_]); PIN(X); }while(0)
  #define UND(w_) asm volatile("":"=v"(w_))
  #define PK4(P,B,d) do{ int w_; UND(w_); w_=PK8(P,B,w_,false); w_=PK8(P,(B)+2,w_,true); p8[d]=w_; }while(0)
#if MK_QK_FP6
  const int sc_one=0x7F7F7F7F, sc_k=KSC6, sc_q=QSC6, sc_v=VSC8;
  #define QKFMT " cbsz:2 blgp:2"
#else
  const int sc_one=0x7F7F7F7F, sc_k=KSC8, sc_q=QSC8, sc_v=VSC8;
  #define QKFMT ""
#endif
  #define AQK(C,kf,PT) asm volatile("v_mfma_scale_f32_32x32x64_f8f6f4 %0, %2, %3, %4, %5, %6 op_sel_hi:[0,0,0]" QKFMT : "=&v"(C), "+v"(PT) : "v"(kf), "v"(q8), "v"(negc), "v"(sc_k), "v"(sc_q))
  #define APV(O,vf,CT) asm volatile("v_mfma_scale_f32_32x32x64_f8f6f4 %0, %2, %3, %0, %4, %5 op_sel_hi:[0,0,0] cbsz:1" : "+v"(O), "+v"(CT) : "v"(p8), "v"(vf), "v"(sc_one), "v"(sc_v))
  #define APL(CT) asm volatile("v_mfma_scale_f32_16x16x128_f8f6f4 %0, %2, %3, %0, %4, %4 op_sel_hi:[0,0,0] cbsz:1" : "+v"(lacc), "+v"(CT) : "v"(p8), "v"(ones8), "v"(sc_one))
  #define STEP(C0,C1,P0,P1,t,GK,GV,GL) do{ SBAR(); \
    AQK(C0,kf0,P0); PK4(P0,0,0); PK4(P0,4,1); PK4(P0,8,2); PK4(P0,12,3); KLD8(vf0,vp0+SL4((t)-1)); PIN(p8); SBAR(); \
    AQK(C1,kf1,P1); PK4(P1,0,4); PK4(P1,4,5); PK4(P1,8,6); PK4(P1,12,7); KLD8(vf1,vp0+SL4((t)-1)+512); PIN(p8); SBAR(); \
    if(kwave){ if(GK){DMA_K((t)+4);} } else { if(GV){DMA_V((t)+2);} } SBAR(); \
    APV(o[0],vf0,C0); EXN(C0,0,8); SBAR(); \
    APV(o[1],vf1,C0); EXN(C0,8,8); if(GL){ KLDK(kf0,kp0+SL4((t)+1)); } SBAR(); \
    APL(C1); EXN(C1,0,8); if(GL){ KLDK(kf1,kp0+SL4((t)+1)+512); } SBAR(); \
    EXN(C1,8,8); SBAR(); \
    }while(0)
  int t=1;
  asm volatile(".p2align 6\n\t.rept 15\n\ts_nop 0\n\t.endr");
  for(;t+5<NT;t+=2){
    STEP(pB0,pB1,pA0,pA1,t,true,true,true);     WAIT_BAR(2);
    STEP(pA0,pA1,pB0,pB1,t+1,true,true,true);   WAIT_BAR(2);
  }
  #define ENDW(i) do{ const int n_=kwave?((((i)+4<NT)?1:0)+(((i)+3<NT)?1:0)):((((i)+2<NT)?1:0)+(((i)+1<NT)?1:0)); if(n_==2){WAIT_BAR(2);} else if(n_==1){WAIT_BAR(1);} else {WAIT_BAR(0);} }while(0)
  for(;t+1<NT;t+=2){
    STEP(pB0,pB1,pA0,pA1,t,(t+4<NT),(t+2<NT),(t+1<NT));       ENDW(t);
    STEP(pA0,pA1,pB0,pB1,t+1,(t+5<NT),(t+3<NT),(t+2<NT));     ENDW(t+1);
  }
  STEP(pB0,pB1,pA0,pA1,NT-1,false,false,false); WAIT_BAR(0);
  { int w_=0; w_=PK8(pB0,0,w_,false); w_=PK8(pB0,2,w_,true); p8[0]=w_; w_=PK8(pB0,4,w_,false); w_=PK8(pB0,6,w_,true); p8[1]=w_; w_=PK8(pB0,8,w_,false); w_=PK8(pB0,10,w_,true); p8[2]=w_; w_=PK8(pB0,12,w_,false); w_=PK8(pB0,14,w_,true); p8[3]=w_;
    w_=PK8(pB1,0,w_,false); w_=PK8(pB1,2,w_,true); p8[4]=w_; w_=PK8(pB1,4,w_,false); w_=PK8(pB1,6,w_,true); p8[5]=w_; w_=PK8(pB1,8,w_,false); w_=PK8(pB1,10,w_,true); p8[6]=w_; w_=PK8(pB1,12,w_,false); w_=PK8(pB1,14,w_,true); p8[7]=w_;
    KLD8(vf0,vp0+SL4(NT-1)); KLD8(vf1,vp0+SL4(NT-1)+512);
    asm volatile("s_nop 3":"+v"(p8)); APV(o[0],vf0,pB0); APV(o[1],vf1,pB0); APL(pB1); }
  #undef PK8
  #undef PIN
  #undef EX
  #undef EXN
  #undef STEP
  #undef UND
  #undef PK4
  #undef AQK
  #undef APV
  #undef APL
  #undef ENDW
  asm volatile("s_nop 15\n\ts_nop 15":"+v"(o[0]),"+v"(o[1]),"+v"(lacc));
  float rli[16];
  { float*lt=(float*)(shm+F_LDS_OST)+wid*1024;
    if((lane&7)==0){ const int qb_=((lane&8)?16:0)+4*(lane>>4); lt[qb_]=lacc[0]; lt[qb_+1]=lacc[1]; lt[qb_+2]=lacc[2]; lt[qb_+3]=lacc[3]; }
    asm volatile("s_waitcnt lgkmcnt(0)":::"memory");
    #pragma unroll
    for(int r=0;r<16;++r)rli[r]=__builtin_amdgcn_rcpf(lt[crow(r,hi)]);
    asm volatile("s_waitcnt lgkmcnt(0)":::"memory"); }
#if MK_FP8_WO
  { unsigned char*Ow8=(unsigned char*)O+(rowbase+q0+wid*QBLK)*DM+h*D;
    unsigned char*stg8=(unsigned char*)(shm+F_LDS_OST)+wid*4096;
    #pragma unroll
    for(int r=0;r<16;++r){const int orow=crow(r,hi);
      #pragma unroll
      for(int d0=0;d0<2;++d0){ float val=o[d0][r]*rli[r]*64.0f; val=__builtin_fminf(__builtin_fmaxf(val,-448.f),448.f); stg8[orow*64+d0*32+r32]=(unsigned char)__builtin_amdgcn_cvt_pk_fp8_f32(val,val,0,false); } }
    asm volatile("s_waitcnt lgkmcnt(0)":::"memory");
    #pragma unroll
    for(int i=0;i<2;++i){const int row=i*16+(lane>>2),ch=lane&3; const u32x4 v=*(const u32x4*)(stg8+row*64+ch*16); ATTN_STORE16(Ow8+(long)row*DM+ch*16,v);} }
#else
  bf16*Ow=O+(rowbase+q0+wid*QBLK)*DM+h*D;
  { bf16*stg=(bf16*)(shm+F_LDS_OST)+wid*2048;
    #pragma unroll
    for(int r=0;r<16;++r){const int orow=crow(r,hi);
      #pragma unroll
      for(int d0=0;d0<2;++d0)stg[orow*64+d0*32+r32]=__float2bfloat16(o[d0][r]*rli[r]);}
    asm volatile("s_waitcnt lgkmcnt(0)":::"memory");
    #pragma unroll
    for(int i=0;i<4;++i){const int row=i*8+(lane>>3),ch=lane&7; const u32x4 v=*(const u32x4*)(stg+row*64+ch*8); ATTN_STORE16(Ow+(long)row*DM+ch*8,v);} }
#endif
  asm volatile("s_waitcnt lgkmcnt(0)\n\ts_barrier":::"memory");
  #undef KLD8
  #undef KLDK
  #undef QKFMT
  #undef MFQK
  #undef MFPV
  #undef MFPL
  #undef DMA_K
  #undef DMA_V
  #undef SL4
}

constexpr int ATTN_LDS_BYTES=LDS_BYTES;
struct AttnTensors { const bf16* Q; const bf16* K; const bf16* V; bf16* O; const unsigned char* Q8; const unsigned char* K8; const unsigned char* VT8; float cref; };
struct AttnUnit { int bh; int qb; };
struct StaticOrder {
  int vcu, G;
  __device__ __forceinline__ explicit StaticOrder(int grid,int block):vcu((grid%8==0)?(block%8)*(grid/8)+block/8:block),G(grid){}
  __device__ __forceinline__ bool next(int i,AttnUnit&u)const{
    if(G==256){ if(i>=8)return false; const int bkv=vcu>>5,j=vcu&31,un=i*32+j; u.bh=(bkv>>2)*16+(bkv&3)*4+(un>>6); u.qb=un&63; return true; }
    const int un=i*G+vcu; if(un>=BATCH*NHEAD*NQB)return false; u.bh=un/NQB; u.qb=un%NQB; return true; }
  __device__ __forceinline__ void a_ready(const AttnUnit&)const{}
  __device__ __forceinline__ void done(const AttnUnit&)const{}
};
template<class Sched,int THRL=8> __device__ __forceinline__ void attn_phase(char*lds,const AttnTensors&T,const Sched&S,bool fast,int wv){
  AttnUnit u;
  if(fast){ for(int i=0;S.next(i,u);++i){ S.a_ready(u); attn_unit_fast(wv,u.bh/NHEAD,u.bh%NHEAD,u.qb,T.Q8,T.K8,T.VT8,T.O,lds,T.cref); S.done(u); } }
  else{ for(int i=0;S.next(i,u);++i){ S.a_ready(u); attn_unit<THRL>(wv,u.bh/NHEAD,u.bh%NHEAD,u.qb,T.Q,T.K,T.V,T.O,lds); S.done(u); } }
}
#undef SBAR
#undef WAIT_BAR
}
constexpr int NWAVES = 8;
#ifndef MK_REPEAT
#define MK_REPEAT 0
#endif
#ifndef MK_FP8_DENSE
#define MK_FP8_DENSE 1
#endif
#ifndef MK_FFN_SWAP
#define MK_FFN_SWAP 1
#endif
#ifndef MK_FP8_POOL
#define MK_FP8_POOL 0
#endif
#ifndef MK_N_LAUNCHES
#define MK_N_LAUNCHES 1
#endif
constexpr int PER_PHASE = 17;
constexpr int N_LAUNCHES = MK_N_LAUNCHES;

constexpr int D = 1024, LSEQ = 16384, NBATCH = 2, TT = NBATCH * LSEQ, CTXL = 256, NCTX = NBATCH * CTXL, MT = TT + NCTX;
constexpr int FF = 2816, NE = 8, NQKV = 1536, LKV = LSEQ + CTXL;
constexpr int NPX = TT / 256, NPT = MT / 256;
constexpr int CAPP = (2 * TT) / 256 + NE;
constexpr float FP8_SA = 4.0f, FP8_SW = 64.0f, FP8_SH = 4.0f;
constexpr float NORM_EPS = 1e-6f;
constexpr float QSCALE = 0.125f * 1.4426950408889634f;

constexpr size_t MiB = 1u << 20, KiB = 1u << 10;
constexpr size_t WS_CTL = 0, CTL_ZERO_BYTES = 1 * MiB;
constexpr size_t WS_PART = 1 * MiB;
constexpr size_t WS_MODS = 3 * MiB;
constexpr size_t WS_RSTD = 3 * MiB + 256 * KiB;
constexpr size_t WS_ROPE = 3 * MiB + 512 * KiB;
constexpr size_t WS_EID = 3 * MiB + 640 * KiB, WS_GATE = 2 * MiB + 768 * KiB, WS_SLOT = 2 * MiB + 256 * KiB, WS_PEXP = 2 * MiB + 512 * KiB;
constexpr size_t WS_CNTW = 3 * MiB + 896 * KiB;
constexpr size_t WS_CTXB = 4 * MiB;
constexpr size_t WS_W13M = 8 * MiB, WS_W2M = 52 * MiB;
constexpr size_t WS_W13F = 74 * MiB, WS_W2F = 85 * MiB;
constexpr size_t WS_WQKV = 91 * MiB, WS_WO = 94 * MiB, WS_POOL = 96 * MiB;
constexpr size_t WS_XS = 98 * MiB;
constexpr size_t WS_BIG = 230 * MiB;
constexpr size_t WS_Q = WS_BIG, WS_K = WS_BIG + 64 * MiB, WS_V = WS_BIG + 81 * MiB, WS_QN = WS_BIG + 100 * MiB, WS_VT = WS_BIG + 140 * MiB, WS_KN = WS_BIG + 164 * MiB, WS_O = WS_BIG;
constexpr size_t WS_SSQ1 = 412 * MiB, WS_SSQ2 = 415 * MiB, WS_B13 = 418 * MiB, WS_BQ = 418 * MiB + 128 * KiB;
constexpr size_t WS_A1 = WS_XS + 66 * MiB;
constexpr size_t WS_WO8 = WS_PART;
constexpr size_t WS_X3B = 419 * MiB;
constexpr size_t WS_END = 483 * MiB;
static_assert(WS_W13M + (size_t)NE * 5632 * 1024 <= WS_W2M && WS_W2M + (size_t)NE * 1024 * 2816 <= WS_W13F && WS_W13F + (size_t)5632 * 1024 * 2 <= WS_W2F && WS_W2F + (size_t)1024 * 2816 * 2 <= WS_WQKV && WS_POOL + 4 * 65536 * 2 <= WS_XS, "ws map 1");
static_assert(WS_XS + (size_t)CAPP * 256 * 1024 * 2 <= WS_BIG && WS_XS + (size_t)TT * 1024 * 4 <= WS_BIG && WS_BIG + (size_t)CAPP * 256 * 2816 <= WS_END && WS_BIG + (size_t)MT * FF * 2 <= WS_END, "ws map 2");
static_assert(WS_K + (size_t)NBATCH * LKV * 256 * 2 <= WS_V && WS_Q + (size_t)TT * 1024 * 2 <= WS_K && WS_V + (size_t)NBATCH * LKV * 256 * 2 <= WS_QN && WS_QN + (size_t)TT * 1024 * 2 <= WS_KN && WS_QN + (size_t)MT * 1024 * 2 <= WS_END && WS_KN + (size_t)NBATCH * LKV * 256 * 2 <= WS_END, "ws map 3");
constexpr int CW_TMO = 0, CW_CODE = 1;
constexpr int CW_BAR = 4096;
constexpr int CW_CNT = 16384, CW_FILL = 16384 + 64 * 8;

constexpr int RING_OFF = 0, RING_BYTES = 131072;
constexpr int LDSCTL_OFF = RING_BYTES, MISC_OFF = LDSCTL_OFF + 320;
constexpr int LDS_BYTES = 147456;
static_assert(MISC_OFF + 128 <= LDS_BYTES, "LDS map");

#define GAS __attribute__((address_space(1)))
#define LAS __attribute__((address_space(3)))
typedef unsigned short bf16;
typedef unsigned v4u __attribute__((ext_vector_type(4)));
typedef float f32x4 __attribute__((ext_vector_type(4)));
typedef short bf16x8 __attribute__((ext_vector_type(8)));
typedef GAS unsigned gu32;
typedef GAS unsigned long long gu64;
#define RLX_AGENT __ATOMIC_RELAXED, __HIP_MEMORY_SCOPE_AGENT
#define LDS_WAIT() asm volatile("s_waitcnt lgkmcnt(0)" ::: "memory")
#define VM_WAIT() asm volatile("s_waitcnt vmcnt(0)" ::: "memory")
__device__ __forceinline__ unsigned long long rt() { return __builtin_amdgcn_s_memrealtime(); }
__device__ __forceinline__ unsigned f2bf(float f) { unsigned u = __builtin_bit_cast(unsigned, f); return (u + 0x7fffu + ((u >> 16) & 1u)) >> 16; }
__device__ __forceinline__ unsigned pk2(float lo, float hi) { return f2bf(lo) | (f2bf(hi) << 16); }

#define XB_TMO      128
#define XB_XCNT(j)  (256  + 64 * (j))
#define XB_XSUB(j)  (1280 + 64 * (j))
#define XB_XGEN(j)  (2304 + 64 * (j))
#define XB_TOP      3328
#define XB_TOPGEN   3392
#define XCD_BAR_WORDS 3456
#define XB_SPIN_CAP (1u << 18)

__device__ __forceinline__ unsigned xb_ld(unsigned* p)              { return __hip_atomic_load(p, __ATOMIC_RELAXED, __HIP_MEMORY_SCOPE_AGENT); }
__device__ __forceinline__ unsigned xb_add(unsigned* p, unsigned v) { return __hip_atomic_fetch_add(p, v, __ATOMIC_RELAXED, __HIP_MEMORY_SCOPE_AGENT); }
__device__ __forceinline__ unsigned xb_xcc_id() { return (unsigned)__builtin_amdgcn_s_getreg((3 << 11) | 20) & 0xFu; }
#define XB_SPIN(cond, bar) do { unsigned _sp = 0; while (cond) { __builtin_amdgcn_s_sleep(1); \
    if ((++_sp & 255u) == 0u) { if (xb_ld(&(bar)[XB_TMO])) break; if (_sp > XB_SPIN_CAP) { atomicAdd(&(bar)[XB_TMO], 1u); break; } } } } while (0)

struct XcdBarrier {
    unsigned* bar; unsigned x; int w;
    volatile LAS unsigned* st;
};

__device__ __forceinline__ XcdBarrier xcd_barrier_post(unsigned* bar, volatile LAS unsigned* st, int wave) {
    XcdBarrier b; b.bar = bar; b.x = xb_xcc_id(); b.st = st; b.w = wave;
    if (b.w == 0 && mk_lane() == 0) (void)xb_add(&bar[XB_XCNT(b.x)], 1u);
    return b;
}
__device__ __forceinline__ void xcd_barrier_complete(unsigned* bar, unsigned x, unsigned& nloc, unsigned& nx) {
    const unsigned G = gridDim.x * gridDim.y * gridDim.z;
    unsigned sum, cnt, mine, sp = 0u;
    for (;;) {
        sum = 0u; cnt = 0u; mine = 0u;
#pragma unroll
        for (unsigned j = 0; j < 16; ++j) { const unsigned c = xb_ld(&bar[XB_XCNT(j)]); sum += c; cnt += (c > 0u) ? 1u : 0u; mine = (j == x) ? c : mine; }
        if (sum == G) break;
        __builtin_amdgcn_s_sleep(1);
        if ((++sp & 255u) == 0u) { if (xb_ld(&bar[XB_TMO])) break; if (sp > XB_SPIN_CAP) { atomicAdd(&bar[XB_TMO], 1u); break; } }
    }
    nloc = mine > 0u ? mine : 1u; nx = cnt > 0u ? cnt : 1u;
}

__device__ __forceinline__ void xcd_barrier(const XcdBarrier& b) {
    asm volatile("s_waitcnt vmcnt(0)" ::: "memory");
    __syncthreads();
    if (b.w == 0 && mk_lane() == 0) {
        unsigned* bar = b.bar;
        __builtin_amdgcn_s_waitcnt(0);
        unsigned nloc = b.st[0], nx = b.st[1];
        if (nloc == 0u) { xcd_barrier_complete(bar, b.x, nloc, nx); b.st[0] = nloc; b.st[1] = nx; }
        const unsigned old = xb_add(&bar[XB_XSUB(b.x)], 1u);
        const unsigned gen = old / nloc;
        if (old + 1u == (gen + 1u) * nloc) {
            __builtin_amdgcn_fence(__ATOMIC_RELEASE, "agent");
            asm volatile("s_waitcnt vmcnt(0)" ::: "memory");
            const unsigned og = xb_add(&bar[XB_TOP], 1u);
            const unsigned tg = og / nx;
            if (og + 1u == (tg + 1u) * nx) xb_add(&bar[XB_TOPGEN], 1u);
            else XB_SPIN(xb_ld(&bar[XB_TOPGEN]) == tg, bar);
            __builtin_amdgcn_fence(__ATOMIC_ACQUIRE, "agent");
            xb_add(&bar[XB_XGEN(b.x)], 1u);
            asm volatile("s_waitcnt vmcnt(0)" ::: "memory");
        } else {
            XB_SPIN(xb_ld(&bar[XB_XGEN(b.x)]) == gen, bar);
            __builtin_amdgcn_fence(__ATOMIC_ACQUIRE, "agent");
            asm volatile("s_waitcnt vmcnt(0)" ::: "memory");
        }
    }
    __syncthreads();
}

struct Frame {
    LAS unsigned char* lds;
    volatile LAS unsigned* MISC;
    gu32* ctl;
    int tid, lane, wave;
    int vcu, G;
    unsigned char* ws;
    const float* in[21]; float* out;
};
__device__ __forceinline__ float wave_sum(float v) {
#pragma unroll
    for (int o = 1; o < 64; o <<= 1) v += __shfl_xor(v, o);
    return v;
}
__device__ __forceinline__ float bf_lo(unsigned w) { return __builtin_bit_cast(float, w << 16); }
__device__ __forceinline__ float bf_hi(unsigned w) { return __builtin_bit_cast(float, w & 0xffff0000u); }
__device__ __forceinline__ float silu_acc(float a) { return a / (1.0f + expf(-a)); }
__device__ __forceinline__ const float* row_src(const float* xs, const float* cs, int r) { return r < TT ? xs + (size_t)r * D : cs + (size_t)(r - TT) * D; }
__device__ __forceinline__ int row_kind(int r) { return r < LSEQ ? 0 : (r < TT ? 1 : 2); }

__device__ __forceinline__ void tr_item(const float* W, int N, int k0, int n0, bf16* WT, int ldt, int drow0, LAS float* scr, int lane) {
#pragma unroll 8
    for (int i = 0; i < 32; ++i) { const int kk = 2 * i + (lane >> 5); scr[kk * 33 + (lane & 31)] = W[(size_t)(k0 + kk) * N + n0 + (lane & 31)]; }
    LDS_WAIT(); asm volatile("" ::: "memory");
    const int c = lane & 7;
#pragma unroll
    for (int j = 0; j < 4; ++j) { const int n = (lane >> 3) + 8 * j; const LAS float* s = scr + (8 * c) * 33 + n;
        v4u o; o.x = pk2(s[0 * 33], s[1 * 33]); o.y = pk2(s[2 * 33], s[3 * 33]); o.z = pk2(s[4 * 33], s[5 * 33]); o.w = pk2(s[6 * 33], s[7 * 33]);
        *(GAS v4u*)(WT + (size_t)(drow0 + n) * ldt + k0 + 8 * c) = o; }
    LDS_WAIT(); asm volatile("" ::: "memory");
}
__device__ __forceinline__ void tr_item8(const float* W, int N, int k0, int n0, unsigned char* WT, int ldt, int drow0, LAS float* scr, int lane) {
#pragma unroll 8
    for (int i = 0; i < 32; ++i) { const int kk = 2 * i + (lane >> 5); scr[kk * 33 + (lane & 31)] = W[(size_t)(k0 + kk) * N + n0 + (lane & 31)] * FP8_SW; }
    LDS_WAIT(); asm volatile("" ::: "memory");
    const int c = lane & 7;
#pragma unroll
    for (int j = 0; j < 4; ++j) { const int n = (lane >> 3) + 8 * j; const LAS float* s = scr + (8 * c) * 33 + n;
        const unsigned long long o = (unsigned long long)pg8::pk4_fp8(s[0 * 33], s[1 * 33], s[2 * 33], s[3 * 33]) | ((unsigned long long)pg8::pk4_fp8(s[4 * 33], s[5 * 33], s[6 * 33], s[7 * 33]) << 32);
        *(GAS unsigned long long*)(WT + (size_t)(drow0 + n) * ldt + k0 + 8 * c) = o; }
    LDS_WAIT(); asm volatile("" ::: "memory");
}
__device__ __forceinline__ void tr_w13(const float* W, bf16* WT, int which, int q, LAS float* scr, int lane) {
    const int kb = q / 88, nb = q % 88, n0 = 32 * nb;
    tr_item(W, FF, 64 * kb, n0, WT, D, (n0 >> 7) * 256 + (n0 & 127) + which * 128, scr, lane);
}
__device__ __forceinline__ void tr_w2(const float* W, bf16* WT, int q, LAS float* scr, int lane) {
    const int kb = q >> 5, nb = q & 31;
    tr_item(W, D, 64 * kb, 32 * nb, WT, FF, 32 * nb, scr, lane);
}

__device__ __forceinline__ void p0_phase(Frame& F) {
    LAS float* scr = (LAS float*)(F.lds + RING_OFF + F.wave * 16384);
    const int gw = F.vcu * NWAVES + F.wave, NGW = F.G * NWAVES;
    static_assert(NWAVES == 8, "adaLN k-splits = the waves of a workgroup");
    for (int task = gw; task < 2 * 96 * 8; task += NGW) {
        const int ks = task & 7, cg = (task >> 3) % 96, layer = task / 768, k0 = ks * 128, col = cg * 64 + F.lane;
        float sa[3][2];
#pragma unroll
        for (int v = 0; v < 3; ++v)
#pragma unroll
            for (int h = 0; h < 2; ++h) { const float* cv = v < 2 ? F.in[1] + v * D : F.in[3]; sa[v][h] = silu_acc(cv[k0 + h * 64 + F.lane]); }
        const float* W = F.in[4] + (size_t)layer * D * 6144 + (size_t)k0 * 6144 + col;
        float a0 = 0.f, a1 = 0.f, a2 = 0.f;
#pragma unroll
        for (int h = 0; h < 2; ++h)
#pragma unroll 8
            for (int kk = 0; kk < 64; ++kk) { const float w = W[(size_t)(h * 64 + kk) * 6144];
                a0 += __shfl(sa[0][h], kk) * w; a1 += __shfl(sa[1][h], kk) * w; a2 += __shfl(sa[2][h], kk) * w; }
        LAS float* red = (LAS float*)(F.lds + RING_OFF);
        red[(ks * 3 + 0) * 64 + F.lane] = a0; red[(ks * 3 + 1) * 64 + F.lane] = a1; red[(ks * 3 + 2) * 64 + F.lane] = a2;
        __syncthreads();
        if (ks < 3) { float sacc = F.in[5][layer * 6144 + col];
#pragma unroll
            for (int q = 0; q < 8; ++q) sacc += red[(q * 3 + ks) * 64 + F.lane];
            ((float*)(F.ws + WS_MODS))[layer * 18432 + ks * 6144 + col] = sacc; }
        __syncthreads();
    }
    constexpr int I_POOL = 4 * 4 * 8, I_13 = 16 * 88, I_2 = 44 * 32, I_QKV = 16 * 48, I_O = 16 * 32;
    constexpr int NITEMS = I_POOL + 2 * I_13 + I_2 + I_QKV + I_O + (MK_FP8_WO ? I_O : 0);
    for (int it = gw; it < NITEMS; it += NGW) {
        int r = it;
        if (r < I_POOL) { const int g = r >> 5, q = r & 31;
            if (MK_FP8_POOL) tr_item8(F.in[7] + (size_t)g * 65536, 256, 64 * (q >> 3), 32 * (q & 7), F.ws + WS_POOL + (size_t)g * 65536, 256, 32 * (q & 7), scr, F.lane);
            else tr_item(F.in[7] + (size_t)g * 65536, 256, 64 * (q >> 3), 32 * (q & 7), (bf16*)(F.ws + WS_POOL) + (size_t)g * 65536, 256, 32 * (q & 7), scr, F.lane);
            continue; } r -= I_POOL;
        if (r < 2 * I_13) { const int which = r >= I_13, q = r - which * I_13;
            if (MK_FFN_SWAP) { const int kb = q / 88, nb = q % 88, n0 = 32 * nb; tr_item8(which ? F.in[10] : F.in[9], FF, 64 * kb, n0, F.ws + WS_W13F, D, (n0 >> 7) * 256 + (n0 & 127) + which * 128, scr, F.lane); }
            else tr_w13(which ? F.in[10] : F.in[9], (bf16*)(F.ws + WS_W13F), which, q, scr, F.lane);
            continue; } r -= 2 * I_13;
        if (r < I_2) { if (MK_FP8_DENSE && !MK_FFN_SWAP) { const int kb = r >> 5, nb = r & 31; tr_item8(F.in[11], D, 64 * kb, 32 * nb, F.ws + WS_W2F, FF, 32 * nb, scr, F.lane); } else tr_w2(F.in[11], (bf16*)(F.ws + WS_W2F), r, scr, F.lane); continue; } r -= I_2;
        if (r < I_QKV) { const int kb = r / 48, nb = r % 48; if (MK_FP8_DENSE) tr_item8(F.in[12], NQKV, 64 * kb, 32 * nb, F.ws + WS_WQKV, D, 32 * nb, scr, F.lane); else tr_item(F.in[12], NQKV, 64 * kb, 32 * nb, (bf16*)(F.ws + WS_WQKV), D, 32 * nb, scr, F.lane); continue; } r -= I_QKV;
        if (r < I_O) { const int kb = r >> 5, nb = r & 31; tr_item(F.in[13], D, 64 * kb, 32 * nb, (bf16*)(F.ws + WS_WO), D, 32 * nb, scr, F.lane); continue; } r -= I_O;
        { const int kb = r >> 5, nb = r & 31; tr_item8(F.in[13], D, 64 * kb, 32 * nb, F.ws + WS_WO8, D, 32 * nb, scr, F.lane); }
    }
    float* RS = (float*)(F.ws + WS_RSTD);
    for (int r = gw; r < MT; r += NGW) {
        const GAS f32x4* xr = (const GAS f32x4*)row_src(F.in[0], F.in[2], r) + F.lane; float s = 0.f;
#pragma unroll
        for (int j = 0; j < 4; ++j) { const f32x4 v = xr[64 * j]; s += (v.x * v.x + v.y * v.y) + (v.z * v.z + v.w * v.w); }
        s = wave_sum(s);
        if (F.lane == 0) RS[r] = 1.0f / sqrtf(s * (1.0f / D) + NORM_EPS);
    }
    { const int gt = (F.vcu * NWAVES + F.wave) * 64 + F.lane;
      if (gt < 4096) { const int pos = gt >> 4, i = gt & 15; const float fr = powf(10000.0f, -(float)i * (1.0f / 16.0f)); const float ang = (float)pos * fr;
          float2* RT = (float2*)(F.ws + WS_ROPE); RT[gt] = make_float2(cosf(ang), sinf(ang)); } }
}
__device__ __forceinline__ void p1_phase(Frame& F) {
    LAS float* scr = (LAS float*)(F.lds + RING_OFF + F.wave * 16384);
    const int gw = F.vcu * NWAVES + F.wave, NGW = F.G * NWAVES;
    { const int gt = gw * 64 + F.lane;
      if (gt < 2 * 3 * 6144) { const int layer = gt / 18432, v = (gt % 18432) / 6144, n = gt % 6144; const float* PART = (const float*)(F.ws + WS_PART);
          float s = F.in[5][layer * 6144 + n];
#pragma unroll
          for (int ks = 0; ks < 8; ++ks) s += PART[(size_t)((layer * 8 + ks) * 3 + v) * 6144 + n];
          ((float*)(F.ws + WS_MODS))[gt] = s; } }
}
__device__ __forceinline__ void moe_weights_phase(Frame& F, int w, int NW, int it_lo, int it_hi) {
    LAS float* scr = (LAS float*)(F.lds + RING_OFF + F.wave * 16384);
    for (int it = it_lo + w; it < it_hi; it += NW) {
        const int e = it / 4224, r = it % 4224, m = r / 1408, q = r % 1408;
        if (m < 2) { const int kb = q / 88, nb = q % 88, n0 = 32 * nb;
            tr_item8((m == 0 ? F.in[17] : F.in[18]) + (size_t)e * D * FF, FF, 64 * kb, n0, F.ws + WS_W13M + (size_t)e * 5632 * D, D, (n0 >> 7) * 256 + (n0 & 127) + m * 128, scr, F.lane); }
        else { const int kb = q >> 5, nb = q & 31; tr_item8(F.in[19] + (size_t)e * FF * D, D, 64 * kb, 32 * nb, F.ws + WS_W2M + (size_t)e * D * FF, FF, 32 * nb, scr, F.lane); }
    }
}
struct RowSpan { int s0, Ls, t0, n; };
__device__ __forceinline__ RowSpan row_span(int gw, int NGW) {
    const int W0 = (NGW * 63) >> 7, Wr = NGW - 2 * W0, Wc0 = Wr >> 1, Wc1 = Wr - Wc0;
    int sq, i, W;
    if (gw < W0) { sq = 0; i = gw; W = W0; } else if (gw < 2 * W0) { sq = 1; i = gw - W0; W = W0; } else if (gw < 2 * W0 + Wc0) { sq = 2; i = gw - 2 * W0; W = Wc0; } else { sq = 3; i = gw - 2 * W0 - Wc0; W = Wc1; }
    RowSpan sp; sp.Ls = sq < 2 ? LSEQ : CTXL; sp.s0 = sq == 0 ? 0 : (sq == 1 ? LSEQ : (sq == 2 ? TT : TT + CTXL));
    const int lo = (int)(((long)i * sp.Ls) / W), hi = (int)(((long)(i + 1) * sp.Ls) / W);
    sp.t0 = lo; sp.n = hi - lo; return sp;
}
__device__ __forceinline__ void p2_pooldiff(Frame& F) {
    const int gw = F.vcu * NWAVES + F.wave, NGW = F.G * NWAVES, lane = F.lane;
    const float* RS = (const float*)(F.ws + WS_RSTD); const float* MODS = (const float*)(F.ws + WS_MODS);
    bf16* Dm = (bf16*)(F.ws + WS_XS);
    const RowSpan sp = row_span(gw, NGW);
    for (int c0 = 0; c0 < sp.n; c0 += 32) {
        const int s0 = sp.s0, Ls = sp.Ls, t0 = sp.t0 + c0, nn = sp.n - c0 < 32 ? sp.n - c0 : 32;
        const int mi = row_kind(s0);
        const GAS f32x4* X0 = (const GAS f32x4*)row_src(F.in[0], F.in[2], s0) + lane;
        f32x4 gm[4];
#pragma unroll
        for (int j = 0; j < 4; ++j) { const f32x4 g = ((const GAS f32x4*)(F.in[6]))[64 * j + lane]; const f32x4 sc = ((const GAS f32x4*)(MODS + (mi * 6 + 1) * D))[64 * j + lane]; gm[j] = g * (sc + 1.0f); }
        int rsv; { int tt = t0 - 9 + lane; tt = tt < 0 ? 0 : (tt >= Ls ? Ls - 1 : tt); rsv = __builtin_bit_cast(int, RS[s0 + tt]); }
#define P2_RS(tt) __builtin_bit_cast(float, __builtin_amdgcn_readlane(rsv, (tt) - (t0 - 9)))
        f32x4 S[4];
#pragma unroll
        for (int j = 0; j < 4; ++j) { const int h = 1 << j; f32x4 acc = {0.f, 0.f, 0.f, 0.f};
#pragma unroll
            for (int k = 0; k < 2 * h; ++k) { const int tt = t0 - h + k; const bool ok = tt >= 0 && tt < Ls; const int tc = ok ? tt : t0; const f32x4 v = X0[(size_t)tc * 256 + 64 * j]; acc = acc + v * (ok ? P2_RS(tc) : 0.f); }
            S[j] = acc; }
        f32x4 n_own[4], n_add[4], n_sub[4];
#pragma unroll
        for (int j = 0; j < 4; ++j) { n_own[j] = X0[(size_t)t0 * 256 + 64 * j]; n_add[j] = n_own[j]; n_sub[j] = n_own[j]; }
        for (int rr = 0; rr < nn; ++rr) {
            const int t = t0 + rr;
            f32x4 c_own[4], c_add[4], c_sub[4];
#pragma unroll
            for (int j = 0; j < 4; ++j) { c_own[j] = n_own[j]; c_add[j] = n_add[j]; c_sub[j] = n_sub[j]; }
            if (rr < nn - 1) {
#pragma unroll
                for (int j = 0; j < 4; ++j) { const int h = 1 << j; const int ta = t + h, tb = t - h;
                    n_own[j] = X0[(size_t)(t + 1) * 256 + 64 * j];
                    n_add[j] = X0[(size_t)(ta < Ls ? ta : t) * 256 + 64 * j]; n_sub[j] = X0[(size_t)(tb >= 0 ? tb : t) * 256 + 64 * j]; } }
            GAS unsigned long long* o8 = (GAS unsigned long long*)(Dm + (size_t)(s0 + t) * D) + lane;
            const float rs = P2_RS(t);
#pragma unroll
            for (int j = 0; j < 4; ++j) { const int h = 1 << j;
                if (rr > 0) { const int ta = t + h - 1, tb = t - h - 1;
                    S[j] = S[j] + c_add[j] * (ta < Ls ? P2_RS(ta) : 0.f) - c_sub[j] * (tb >= 0 ? P2_RS(tb) : 0.f); }
                const int lo = t - h < 0 ? 0 : t - h, hi = t + h > Ls ? Ls : t + h;
                const f32x4 d = (S[j] * (1.0f / (float)(hi - lo)) - c_own[j] * rs) * gm[j];
                o8[64 * j] = (unsigned long long)pk2(d.x, d.y) | ((unsigned long long)pk2(d.z, d.w) << 32); }
        }
#undef P2_RS
    }
}
__device__ __forceinline__ void p2_pooldiff_ring(Frame& F) {
    const int gw = F.vcu * NWAVES + F.wave, NGW = F.G * NWAVES, lane = F.lane;
    const float* RS = (const float*)(F.ws + WS_RSTD); const float* MODS = (const float*)(F.ws + WS_MODS);
    bf16* Dm = (bf16*)(F.ws + WS_XS);
    const int j = gw & 3, h = 1 << j, W = 2 * h;
    const RowSpan sp = row_span(gw >> 2, NGW >> 2);
    const int s0 = sp.s0, Ls = sp.Ls, mi = row_kind(s0);
    LAS f32x4* ring = (LAS f32x4*)(F.lds + RING_OFF + F.wave * 16384) + lane;
    const GAS f32x4* X0 = (const GAS f32x4*)row_src(F.in[0], F.in[2], s0) + lane + 64 * j;
    f32x4 gm; { const f32x4 g = ((const GAS f32x4*)(F.in[6]))[64 * j + lane]; const f32x4 sc = ((const GAS f32x4*)(MODS + (mi * 6 + 1) * D))[64 * j + lane]; gm = g * (sc + 1.0f); }
    for (int c0 = 0; c0 < sp.n; c0 += 96) {
    const int t0 = sp.t0 + c0, n = sp.n - c0 < 96 ? sp.n - c0 : 96;
    const int rb = t0 - 8;
    int rsv0, rsv1; { int tt = rb + lane; tt = tt < 0 ? 0 : (tt >= Ls ? Ls - 1 : tt); rsv0 = __builtin_bit_cast(int, RS[s0 + tt]); tt = rb + 64 + lane; tt = tt < 0 ? 0 : (tt >= Ls ? Ls - 1 : tt); rsv1 = __builtin_bit_cast(int, RS[s0 + tt]); }
#define P2R_RS(r_) __builtin_bit_cast(float, ((r_) - rb) < 64 ? __builtin_amdgcn_readlane(rsv0, ((r_) - rb) & 63) : __builtin_amdgcn_readlane(rsv1, ((r_) - rb) & 63))
#define P2R_LOAD(r_) X0[(size_t)((r_) < 0 ? 0 : ((r_) >= Ls ? Ls - 1 : (r_))) * 256]
#define P2R_SCALE(r_) (((r_) >= 0 && (r_) < Ls) ? P2R_RS(r_) : 0.f)
    f32x4 S = {0.f, 0.f, 0.f, 0.f};
    { f32x4 v[16];
#pragma unroll
      for (int k = 0; k < 16; ++k) if (k < W) v[k] = P2R_LOAD(t0 - h + k);
#pragma unroll
      for (int k = 0; k < 16; ++k) if (k < W) { const int r = t0 - h + k; const f32x4 x = v[k] * P2R_SCALE(r); ring[((r + 64) & (W - 1)) * 64] = x; S = S + x; } }
    f32x4 nx[8];
#pragma unroll
    for (int k = 0; k < 8; ++k) nx[k] = P2R_LOAD(t0 + h + k);
    for (int tb = t0; tb < t0 + n; tb += 8) {
        f32x4 cu[8];
#pragma unroll
        for (int k = 0; k < 8; ++k) cu[k] = nx[k];
        if (tb + 8 < t0 + n) {
#pragma unroll
            for (int k = 0; k < 8; ++k) nx[k] = P2R_LOAD(tb + 8 + h + k); }
#pragma unroll
        for (int k = 0; k < 8; ++k) { const int t = tb + k;
            if (t < t0 + n) {
                const f32x4 own = ring[((t + 64) & (W - 1)) * 64];
                const int lo = t - h < 0 ? 0 : t - h, hi = t + h > Ls ? Ls : t + h;
                const f32x4 d = (S * (1.0f / (float)(hi - lo)) - own) * gm;
                if (MK_FP8_POOL) ((GAS unsigned*)((unsigned char*)Dm + (size_t)(s0 + t) * D) + lane)[64 * j] = pg8::pk4_fp8(d.x * FP8_SA, d.y * FP8_SA, d.z * FP8_SA, d.w * FP8_SA);
                else ((GAS unsigned long long*)(Dm + (size_t)(s0 + t) * D) + lane)[64 * j] = (unsigned long long)pk2(d.x, d.y) | ((unsigned long long)pk2(d.z, d.w) << 32);
                const int slot = ((t + h + 64) & (W - 1)) * 64;
                const f32x4 oldv = ring[slot]; const f32x4 newv = cu[k] * P2R_SCALE(t + h);
                S = S + newv - oldv; ring[slot] = newv; } }
    }
    }
#undef P2R_RS
#undef P2R_LOAD
#undef P2R_SCALE
}
__device__ __forceinline__ void bias_dot(const float (&w)[16], const float* shb, int sidx, float* dst, int ld, int nn, int lane) {
#pragma unroll
    for (int kind = 0; kind < 3; ++kind) { const GAS f32x4* sp = (const GAS f32x4*)(shb + (kind * 6 + sidx) * D + 16 * lane); float s = 0.f;
#pragma unroll
        for (int q = 0; q < 4; ++q) { const f32x4 v = sp[q]; s = __builtin_fmaf(v.x, w[4 * q], s); s = __builtin_fmaf(v.y, w[4 * q + 1], s); s = __builtin_fmaf(v.z, w[4 * q + 2], s); s = __builtin_fmaf(v.w, w[4 * q + 3], s); }
        s = wave_sum(s); if (lane == 0) dst[(size_t)kind * ld + nn] = s; }
}
__device__ __forceinline__ void bias_phase(Frame& F) {
    const int gw = F.vcu * NWAVES + F.wave, NGW = F.G * NWAVES, lane = F.lane;
    const float* MODS0 = (const float*)(F.ws + WS_MODS); const float* MODS1 = MODS0 + 3 * 6 * D;
    for (int n = gw; n < 5632; n += NGW) {
        const GAS v4u* src = (const GAS v4u*)((const bf16*)(F.ws + WS_W13F) + (size_t)n * D + 16 * lane); const v4u a = src[0], b = src[1]; float w[16];
        w[0] = bf_lo(a.x); w[1] = bf_hi(a.x); w[2] = bf_lo(a.y); w[3] = bf_hi(a.y); w[4] = bf_lo(a.z); w[5] = bf_hi(a.z); w[6] = bf_lo(a.w); w[7] = bf_hi(a.w);
        w[8] = bf_lo(b.x); w[9] = bf_hi(b.x); w[10] = bf_lo(b.y); w[11] = bf_hi(b.y); w[12] = bf_lo(b.z); w[13] = bf_hi(b.z); w[14] = bf_lo(b.w); w[15] = bf_hi(b.w);
        bias_dot(w, MODS0, 3, (float*)(F.ws + WS_B13), 5632, n, lane);
    }
    for (int n = gw; n < NQKV; n += NGW) {
        const v4u a = *(const GAS v4u*)(F.ws + WS_WQKV + (size_t)n * D + 16 * lane); const float is = 1.0f / FP8_SW; float w[16];
        w[0] = __builtin_amdgcn_cvt_f32_fp8((int)a.x, 0) * is; w[1] = __builtin_amdgcn_cvt_f32_fp8((int)a.x, 1) * is; w[2] = __builtin_amdgcn_cvt_f32_fp8((int)a.x, 2) * is; w[3] = __builtin_amdgcn_cvt_f32_fp8((int)a.x, 3) * is;
        w[4] = __builtin_amdgcn_cvt_f32_fp8((int)a.y, 0) * is; w[5] = __builtin_amdgcn_cvt_f32_fp8((int)a.y, 1) * is; w[6] = __builtin_amdgcn_cvt_f32_fp8((int)a.y, 2) * is; w[7] = __builtin_amdgcn_cvt_f32_fp8((int)a.y, 3) * is;
        w[8] = __builtin_amdgcn_cvt_f32_fp8((int)a.z, 0) * is; w[9] = __builtin_amdgcn_cvt_f32_fp8((int)a.z, 1) * is; w[10] = __builtin_amdgcn_cvt_f32_fp8((int)a.z, 2) * is; w[11] = __builtin_amdgcn_cvt_f32_fp8((int)a.z, 3) * is;
        w[12] = __builtin_amdgcn_cvt_f32_fp8((int)a.w, 0) * is; w[13] = __builtin_amdgcn_cvt_f32_fp8((int)a.w, 1) * is; w[14] = __builtin_amdgcn_cvt_f32_fp8((int)a.w, 2) * is; w[15] = __builtin_amdgcn_cvt_f32_fp8((int)a.w, 3) * is;
        bias_dot(w, MODS1, 0, (float*)(F.ws + WS_BQ), NQKV, n, lane);
    }
}
__device__ __forceinline__ void normmod_phase(Frame& F, const bf16* xs, const float* cs, bf16* HX, const float* ng, const float* mods, int ish, int isc, int nrows, bool fp8out) {
    const int gw = F.vcu * NWAVES + F.wave, NGW = F.G * NWAVES;
#pragma unroll 1
    for (int seg = 0; seg < 3; ++seg) {
        const int lo = seg == 0 ? 0 : (seg == 1 ? LSEQ : TT), hi = seg == 0 ? LSEQ : (seg == 1 ? TT : MT), mi = seg;
        if (lo + gw >= hi) continue;
        f32x4 gm[4], sh[4];
#pragma unroll
        for (int j = 0; j < 4; ++j) { const f32x4 g = ((const GAS f32x4*)ng)[64 * j + F.lane]; const f32x4 sc = ((const GAS f32x4*)(mods + (mi * 6 + isc) * D))[64 * j + F.lane]; gm[j] = g * (sc + 1.0f);
            sh[j] = ((const GAS f32x4*)(mods + (mi * 6 + ish) * D))[64 * j + F.lane]; }
#define NM_ROW(r_) do { float s = 0.f; \
            _Pragma("unroll") for (int j = 0; j < 4; ++j) s += (v[j].x * v[j].x + v[j].y * v[j].y) + (v[j].z * v[j].z + v[j].w * v[j].w); \
            const float rstd = 1.0f / sqrtf(wave_sum(s) * (1.0f / D) + NORM_EPS); \
            GAS unsigned long long* o8 = (GAS unsigned long long*)(HX + (size_t)(r_) * D) + F.lane; \
            _Pragma("unroll") for (int j = 0; j < 4; ++j) { const f32x4 o = v[j] * rstd * gm[j] + sh[j]; \
                if (fp8out) ((GAS unsigned*)((unsigned char*)HX + (size_t)(r_) * D) + F.lane)[64 * j] = pg8::pk4_fp8(o.x * FP8_SA, o.y * FP8_SA, o.z * FP8_SA, o.w * FP8_SA); \
                else o8[64 * j] = (unsigned long long)pk2(o.x, o.y) | ((unsigned long long)pk2(o.z, o.w) << 32); } } while (0)
        if (seg < 2) {
            for (int rb = lo + gw; rb < hi; rb += 8 * NGW) {
                unsigned long long w[8][4];
#pragma unroll
                for (int u = 0; u < 8; ++u) { const int ru = rb + u * NGW < hi ? rb + u * NGW : rb; const GAS unsigned long long* xr = (const GAS unsigned long long*)(xs + (size_t)ru * D) + F.lane;
#pragma unroll
                    for (int j = 0; j < 4; ++j) w[u][j] = xr[64 * j]; }
#pragma unroll
                for (int u = 0; u < 8; ++u) if (rb + u * NGW < hi) { f32x4 v[4];
#pragma unroll
                    for (int j = 0; j < 4; ++j) v[j] = (f32x4){bf_lo((unsigned)w[u][j]), bf_hi((unsigned)w[u][j]), bf_lo((unsigned)(w[u][j] >> 32)), bf_hi((unsigned)(w[u][j] >> 32))};
                    NM_ROW(rb + u * NGW); }
            }
        } else {
            for (int r = lo + gw; r < hi; r += NGW) { f32x4 v[4];
                const GAS f32x4* xr = (const GAS f32x4*)(cs + (size_t)(r - TT) * D) + F.lane;
#pragma unroll
                for (int j = 0; j < 4; ++j) v[j] = xr[64 * j];
                NM_ROW(r); }
        }
#undef NM_ROW
    }
}
__device__ __forceinline__ float dpp_xor1(float v) { return __builtin_bit_cast(float, __builtin_amdgcn_update_dpp(0, __builtin_bit_cast(int, v), 0xB1, 0xF, 0xF, true)); }
__device__ __forceinline__ float dpp_xor2(float v) { return __builtin_bit_cast(float, __builtin_amdgcn_update_dpp(0, __builtin_bit_cast(int, v), 0x4E, 0xF, 0xF, true)); }
__device__ __forceinline__ void qk_norm_rope(float (&v)[16], const f32x4 (&gn)[4], const LAS float2* RT, int qt, int pos, bool rope, float scale) {
    float ss = 0.f;
#pragma unroll
    for (int i = 0; i < 16; ++i) ss += v[i] * v[i];
    ss += dpp_xor1(ss); ss += dpp_xor2(ss);
    const float rstd = 1.0f / sqrtf(ss * (1.0f / 64.0f) + NORM_EPS);
#pragma unroll
    for (int i = 0; i < 16; ++i) v[i] = v[i] * rstd * gn[i >> 2][i & 3];
    const LAS f32x4* rt = (const LAS f32x4*)(RT + pos * 16);
#pragma unroll
    for (int i = 0; i < 16; i += 2) { const f32x4 cs = rt[i >> 1];
        const float p0 = dpp_xor1(v[i]), p1 = dpp_xor1(v[i + 1]);
        const float r0 = v[i] * cs.x + ((qt & 1) ? p0 : -p0) * cs.y, r1 = v[i + 1] * cs.z + ((qt & 1) ? p1 : -p1) * cs.w;
        v[i] = (rope ? r0 : v[i]) * scale; v[i + 1] = (rope ? r1 : v[i + 1]) * scale; }
}
struct QkTask { const GAS v4u* p; GAS v4u* q; GAS v4u* q8; int pos; bool rope, isq; };
__device__ __forceinline__ QkTask qk_task(Frame& F, int task, int qt) {
    constexpr int NQT = TT; QkTask k; const int lane = F.lane;
    if (task < NQT) { const int t = task & (LSEQ - 1); k.pos = qt < 2 ? (t >> 6) : (t & 63); k.rope = true; k.isq = true; k.p = (const GAS v4u*)((bf16*)(F.ws + WS_Q) + (size_t)task * D + 16 * lane); k.q = (GAS v4u*)((bf16*)(F.ws + WS_QN) + (size_t)task * D + 16 * lane); k.q8 = (GAS v4u*)(F.ws + WS_QN + (size_t)task * D + 16 * lane); }
    else { const int kr = (task - NQT) * 4 + (lane >> 4), t = kr % LKV; k.rope = t < LSEQ; const int tc = k.rope ? t : 0; k.pos = qt < 2 ? (tc >> 6) : (tc & 63); k.isq = false; k.p = (const GAS v4u*)((bf16*)(F.ws + WS_K) + (size_t)kr * 256 + 16 * (lane & 15)); k.q = (GAS v4u*)((bf16*)(F.ws + WS_KN) + (size_t)kr * 256 + 16 * (lane & 15)); k.q8 = (GAS v4u*)(F.ws + WS_KN + (size_t)kr * 256 + 16 * (lane & 15)); }
    return k;
}
__device__ __forceinline__ void p9_qknorm(Frame& F, bool fp8out) {
    const int gw = F.vcu * NWAVES + F.wave, NGW = F.G * NWAVES, lane = F.lane;
    LAS float2* RT = (LAS float2*)(F.lds + RING_OFF + 65536);
    { const GAS f32x4* src = (const GAS f32x4*)(F.ws + WS_ROPE); for (int i = F.tid; i < 2048; i += NWAVES * 64) ((LAS f32x4*)RT)[i] = src[i]; }
    __syncthreads();
    const int qt = lane & 3;
    f32x4 gq[4], gk[4];
#pragma unroll
    for (int i = 0; i < 4; ++i) { gq[i] = ((const GAS f32x4*)(F.in[14]))[qt * 4 + i]; gk[i] = ((const GAS f32x4*)(F.in[15]))[qt * 4 + i]; }
    constexpr int NTASK = TT + (NBATCH * LKV) / 4;
    for (int t0 = gw; t0 < NTASK; t0 += 4 * NGW) {
        QkTask tk[4]; v4u w0[4], w1[4];
#pragma unroll
        for (int u = 0; u < 4; ++u) { const int task = t0 + u * NGW; const int tc = task < NTASK ? task : t0; tk[u] = qk_task(F, tc, qt); w0[u] = tk[u].p[0]; w1[u] = tk[u].p[1]; }
#pragma unroll
        for (int u = 0; u < 4; ++u) { if (t0 + u * NGW < NTASK) {
            const QkTask cur = tk[u]; const v4u a = w0[u], b = w1[u]; float v[16];
            v[0] = bf_lo(a.x); v[1] = bf_hi(a.x); v[2] = bf_lo(a.y); v[3] = bf_hi(a.y); v[4] = bf_lo(a.z); v[5] = bf_hi(a.z); v[6] = bf_lo(a.w); v[7] = bf_hi(a.w);
            v[8] = bf_lo(b.x); v[9] = bf_hi(b.x); v[10] = bf_lo(b.y); v[11] = bf_hi(b.y); v[12] = bf_lo(b.z); v[13] = bf_hi(b.z); v[14] = bf_lo(b.w); v[15] = bf_hi(b.w);
            if (cur.isq) qk_norm_rope(v, gq, RT, qt, cur.pos, cur.rope, fp8out ? QSCALE * (MK_QK_FP6 ? attn_body::QF6 : attn_body::QF8) : QSCALE); else qk_norm_rope(v, gk, RT, qt, cur.pos, cur.rope, fp8out ? (MK_QK_FP6 ? attn_body::KF6 : attn_body::KF8) : 1.0f);
#if MK_QK_FP6
            if (fp8out) {
                typedef float v16f_ __attribute__((ext_vector_type(16))); v16f_ A_, B_;
#pragma unroll
                for (int i = 0; i < 16; ++i) { A_[i] = v[i]; B_[i] = dpp_xor1(v[i]); }
                const auto r6 = __builtin_amdgcn_cvt_scalef32_2xpk16_fp6_f32(A_, B_, 1.0f);
                if ((qt & 1) == 0) { v4u o8; o8.x = r6[0]; o8.y = r6[1]; o8.z = r6[2]; o8.w = r6[3]; cur.q8[0] = o8;
                    *(GAS unsigned long long*)((GAS unsigned char*)cur.q8 + 16) = (unsigned long long)r6[4] | ((unsigned long long)r6[5] << 32); } }
            else
#endif
            if (fp8out) { v4u o8; o8.x = pg8::pk4_fp8(v[0], v[1], v[2], v[3]); o8.y = pg8::pk4_fp8(v[4], v[5], v[6], v[7]); o8.z = pg8::pk4_fp8(v[8], v[9], v[10], v[11]); o8.w = pg8::pk4_fp8(v[12], v[13], v[14], v[15]); cur.q8[0] = o8; }
            else { v4u o0, o1; o0.x = pk2(v[0], v[1]); o0.y = pk2(v[2], v[3]); o0.z = pk2(v[4], v[5]); o0.w = pk2(v[6], v[7]); o1.x = pk2(v[8], v[9]); o1.y = pk2(v[10], v[11]); o1.z = pk2(v[12], v[13]); o1.w = pk2(v[14], v[15]); cur.q[0] = o0; cur.q[1] = o1; } } }
    }
}
__device__ __forceinline__ void p9_vtrans(Frame& F) {
    const int gw = F.vcu * NWAVES + F.wave, NGW = F.G * NWAVES, lane = F.lane;
    LAS unsigned char* scr = F.lds + RING_OFF + F.wave * 8192;
    const int dp = lane & 31, kh = lane >> 5;
    for (int it = 0; it * NGW < NBATCH * 4 * (LKV / 64); ++it) {
        const int task = it * NGW + ((it & 1) ? NGW - 1 - gw : gw); if (task >= NBATCH * 4 * (LKV / 64)) continue;
        const int bk = task / (LKV / 64), tile = task % (LKV / 64), b = bk >> 2, kvh = bk & 3;
        const bf16* src = (const bf16*)(F.ws + WS_V) + ((size_t)(b * LKV + tile * 64)) * 256 + kvh * 64;
#pragma unroll
        for (int i = 0; i < 8; ++i) { const int row = 8 * i + (lane >> 3), ch = lane & 7; const v4u w = *(const GAS v4u*)(src + (size_t)row * 256 + ch * 8); *(LAS v4u*)(scr + row * 128 + ch * 16) = w; }
        LDS_WAIT(); asm volatile("" ::: "memory");
        float lo[32], hi[32];
#pragma unroll
        for (int j = 0; j < 32; ++j) { const int jj = j & 15, key = (jj & 3) + 8 * (jj >> 2) + 4 * kh + 32 * (j >> 4); const unsigned w = *(const LAS unsigned*)(scr + key * 128 + dp * 4); lo[j] = bf_lo(w) * attn_body::VF8; hi[j] = bf_hi(w) * attn_body::VF8; }
        v4u o0, o1, o2, o3;
        o0.x = pg8::pk4_fp8(lo[0], lo[1], lo[2], lo[3]); o0.y = pg8::pk4_fp8(lo[4], lo[5], lo[6], lo[7]); o0.z = pg8::pk4_fp8(lo[8], lo[9], lo[10], lo[11]); o0.w = pg8::pk4_fp8(lo[12], lo[13], lo[14], lo[15]);
        o1.x = pg8::pk4_fp8(lo[16], lo[17], lo[18], lo[19]); o1.y = pg8::pk4_fp8(lo[20], lo[21], lo[22], lo[23]); o1.z = pg8::pk4_fp8(lo[24], lo[25], lo[26], lo[27]); o1.w = pg8::pk4_fp8(lo[28], lo[29], lo[30], lo[31]);
        o2.x = pg8::pk4_fp8(hi[0], hi[1], hi[2], hi[3]); o2.y = pg8::pk4_fp8(hi[4], hi[5], hi[6], hi[7]); o2.z = pg8::pk4_fp8(hi[8], hi[9], hi[10], hi[11]); o2.w = pg8::pk4_fp8(hi[12], hi[13], hi[14], hi[15]);
        o3.x = pg8::pk4_fp8(hi[16], hi[17], hi[18], hi[19]); o3.y = pg8::pk4_fp8(hi[20], hi[21], hi[22], hi[23]); o3.z = pg8::pk4_fp8(hi[24], hi[25], hi[26], hi[27]); o3.w = pg8::pk4_fp8(hi[28], hi[29], hi[30], hi[31]);
        unsigned char* dst = F.ws + WS_VT + ((size_t)(bk * 64 + 2 * dp)) * LKV + tile * 64 + 32 * kh;
        *(GAS v4u*)(dst) = o0; *(GAS v4u*)(dst + 16) = o1; *(GAS v4u*)(dst + LKV) = o2; *(GAS v4u*)(dst + LKV + 16) = o3;
        LDS_WAIT(); asm volatile("" ::: "memory");
    }
}
__device__ __forceinline__ void p12_router(Frame& F) {
    const int gw = F.vcu * NWAVES + F.wave, NGW = F.G * NWAVES, lane = F.lane;
    LAS float* RW = (LAS float*)(F.lds + RING_OFF);
    for (int c = F.tid; c < D; c += NWAVES * 64) { const f32x4 a = ((const GAS f32x4*)(F.in[16]))[2 * c], b = ((const GAS f32x4*)(F.in[16]))[2 * c + 1];
        RW[0 * D + c] = a.x; RW[1 * D + c] = a.y; RW[2 * D + c] = a.z; RW[3 * D + c] = a.w; RW[4 * D + c] = b.x; RW[5 * D + c] = b.y; RW[6 * D + c] = b.z; RW[7 * D + c] = b.w; }
    __syncthreads();
    const float* MODS = (const float*)(F.ws + WS_MODS) + 3 * 6 * D;
    const float* ng = F.in[6] + 3 * D;
    unsigned char* HX = F.ws + WS_BIG; int* EID = (int*)(F.ws + WS_EID); float* GATE = (float*)(F.ws + WS_GATE);
    const bf16* X3B = (const bf16*)(F.ws + WS_X3B);
    int* CNTW = (int*)(F.ws + WS_CNTW);
    const bool b5 = (lane & 32) != 0, b4 = (lane & 16) != 0, b3 = (lane & 8) != 0;
    constexpr int RST = TT / 16; static_assert(RST * 8 == LSEQ, "row interleave");
    for (int task = gw; task < TT / 16; task += NGW) {
        const int r0 = task;
        f32x4 gm[4], sh[4];
        f32x4 vn[4];
#pragma unroll
        for (int j = 0; j < 4; ++j) { const unsigned long long w = ((const GAS unsigned long long*)(X3B + (size_t)r0 * D) + lane)[64 * j]; vn[j] = (f32x4){bf_lo((unsigned)w), bf_hi((unsigned)w), bf_lo((unsigned)(w >> 32)), bf_hi((unsigned)(w >> 32))}; }
        int cnt0 = 0, cnt1 = 0, cnt2 = 0, cnt3 = 0, cnt4 = 0, cnt5 = 0, cnt6 = 0, cnt7 = 0;
        int myeid = 0; float mygate = 0.f;
        for (int rr = 0; rr < 16; ++rr) {
            const int r = r0 + rr * RST;
            if ((rr & 7) == 0) { const int mi = rr >> 3;
#pragma unroll
                for (int j = 0; j < 4; ++j) { const f32x4 g = ((const GAS f32x4*)ng)[64 * j + lane]; const f32x4 sc = ((const GAS f32x4*)(MODS + (mi * 6 + 4) * D))[64 * j + lane]; gm[j] = g * (sc + 1.0f);
                    sh[j] = ((const GAS f32x4*)(MODS + (mi * 6 + 3) * D))[64 * j + lane]; } }
            f32x4 v[4]; float s = 0.f;
#pragma unroll
            for (int j = 0; j < 4; ++j) { v[j] = vn[j]; s += (v[j].x * v[j].x + v[j].y * v[j].y) + (v[j].z * v[j].z + v[j].w * v[j].w); }
            if (rr < 15) {
#pragma unroll
                for (int j = 0; j < 4; ++j) { const unsigned long long w = ((const GAS unsigned long long*)(X3B + (size_t)(r + RST) * D) + lane)[64 * j]; vn[j] = (f32x4){bf_lo((unsigned)w), bf_hi((unsigned)w), bf_lo((unsigned)(w >> 32)), bf_hi((unsigned)(w >> 32))}; } }
            const float rstd = 1.0f / sqrtf(wave_sum(s) * (1.0f / D) + NORM_EPS);
            GAS unsigned* o4 = (GAS unsigned*)(HX + (size_t)r * D) + lane;
            float lg[8];
#pragma unroll
            for (int e = 0; e < 8; ++e) lg[e] = 0.f;
#pragma unroll
            for (int j = 0; j < 4; ++j) { const f32x4 o = v[j] * rstd * gm[j] + sh[j]; o4[64 * j] = pg8::pk4_fp8(o.x * FP8_SA, o.y * FP8_SA, o.z * FP8_SA, o.w * FP8_SA);
#pragma unroll
                for (int e = 0; e < 8; ++e) { const f32x4 w = *(const LAS f32x4*)(RW + e * D + 256 * j + 4 * lane); lg[e] = __builtin_fmaf(o.w, w.w, __builtin_fmaf(o.z, w.z, __builtin_fmaf(o.y, w.y, __builtin_fmaf(o.x, w.x, lg[e])))); } }
            float a4[4], a2[2], a1;
#pragma unroll
            for (int e = 0; e < 4; ++e) { const float send = b5 ? lg[e] : lg[e + 4], keep = b5 ? lg[e + 4] : lg[e]; a4[e] = keep + __shfl_xor(send, 32); }
#pragma unroll
            for (int e = 0; e < 2; ++e) { const float send = b4 ? a4[e] : a4[e + 2], keep = b4 ? a4[e + 2] : a4[e]; a2[e] = keep + __shfl_xor(send, 16); }
            { const float send = b3 ? a2[0] : a2[1], keep = b3 ? a2[1] : a2[0]; a1 = keep + __shfl_xor(send, 8); }
            a1 += __shfl_xor(a1, 4); a1 += __shfl_xor(a1, 2); a1 += __shfl_xor(a1, 1);
            float L[8];
#pragma unroll
            for (int e = 0; e < 8; ++e) L[e] = __builtin_bit_cast(float, __builtin_amdgcn_readlane(__builtin_bit_cast(int, a1), 8 * e));
            int e1 = 0; float l1 = L[0];
#pragma unroll
            for (int e = 1; e < 8; ++e) if (L[e] > l1) { l1 = L[e]; e1 = e; }
            int e2 = -1; float l2 = -INFINITY;
#pragma unroll
            for (int e = 0; e < 8; ++e) if (e != e1 && L[e] > l2) { l2 = L[e]; e2 = e; }
            const float dd = expf(l2 - l1), g1 = 1.0f / (1.0f + dd), g2 = dd / (1.0f + dd);
            if (lane == 2 * rr) { myeid = e1; mygate = g1; }
            if (lane == 2 * rr + 1) { myeid = e2; mygate = g2; }
            cnt0 += (e1 == 0) + (e2 == 0); cnt1 += (e1 == 1) + (e2 == 1); cnt2 += (e1 == 2) + (e2 == 2); cnt3 += (e1 == 3) + (e2 == 3);
            cnt4 += (e1 == 4) + (e2 == 4); cnt5 += (e1 == 5) + (e2 == 5); cnt6 += (e1 == 6) + (e2 == 6); cnt7 += (e1 == 7) + (e2 == 7);
        }
        if (lane < 32) { EID[32 * task + lane] = myeid; GATE[32 * task + lane] = mygate; }
        { const int mine = lane == 0 ? cnt0 : lane == 1 ? cnt1 : lane == 2 ? cnt2 : lane == 3 ? cnt3 : lane == 4 ? cnt4 : lane == 5 ? cnt5 : lane == 6 ? cnt6 : cnt7;
          if (lane < 8) CNTW[task * 8 + lane] = mine; }
    }
    __syncthreads();
}
__device__ __forceinline__ void p13_slots(Frame& F) {
    const int gw = F.vcu * NWAVES + F.wave, NGW = F.G * NWAVES, lane = F.lane;
    constexpr int NTASK = TT / 16;
    const int* CNTW = (const int*)(F.ws + WS_CNTW);
    int* PEXP = (int*)(F.ws + WS_PEXP);
    const int* EID = (const int*)(F.ws + WS_EID); int* SLOT = (int*)(F.ws + WS_SLOT);
    const unsigned char* HX = F.ws + WS_BIG; unsigned char* XS = F.ws + WS_XS;
    for (int task = gw; task < NTASK; task += NGW) {
        int tot[8], pre[8];
#pragma unroll
        for (int e = 0; e < 8; ++e) { tot[e] = 0; pre[e] = 0; }
#pragma unroll 8
        for (int k = 0; k < NTASK / 64; ++k) { const int t = 64 * k + lane; const v4u a = ((const GAS v4u*)CNTW)[2 * t], b = ((const GAS v4u*)CNTW)[2 * t + 1]; const int m = t < task ? -1 : 0;
            tot[0] += (int)a.x; tot[1] += (int)a.y; tot[2] += (int)a.z; tot[3] += (int)a.w; tot[4] += (int)b.x; tot[5] += (int)b.y; tot[6] += (int)b.z; tot[7] += (int)b.w;
            pre[0] += (int)a.x & m; pre[1] += (int)a.y & m; pre[2] += (int)a.z & m; pre[3] += (int)a.w & m; pre[4] += (int)b.x & m; pre[5] += (int)b.y & m; pre[6] += (int)b.z & m; pre[7] += (int)b.w & m; }
#pragma unroll
        for (int e = 0; e < 8; ++e)
#pragma unroll
            for (int o = 1; o < 64; o <<= 1) { tot[e] += __shfl_xor(tot[e], o); pre[e] += __shfl_xor(pre[e], o); }
        int pstart[8], ends[8]; { int run = 0;
#pragma unroll
            for (int e = 0; e < 8; ++e) { pstart[e] = run; run += (tot[e] + 255) & ~255; ends[e] = run; } }
        if (task == 0) {
            for (int p = lane; p < CAPP; p += 64) { int e = 0;
#pragma unroll
                for (int j = 0; j < 8; ++j) e += (ends[j] <= p * 256) ? 1 : 0;
                PEXP[p] = e > 7 ? 7 : e; }
            if (lane == 0) PEXP[512] = ends[7] >> 8; }
        constexpr int RST = TT / 16;
        const int e = lane < 32 ? EID[32 * task + lane] : -1; int slot = 0;
#pragma unroll
        for (int ee = 0; ee < 8; ++ee) { const unsigned long long mask = __ballot(e == ee); if (e == ee) slot = pstart[ee] + pre[ee] + __popcll(mask & ((1ull << lane) - 1ull)); }
        if (lane < 32) SLOT[32 * task + lane] = slot;
#pragma unroll
        for (int g = 0; g < 2; ++g) {
            v4u a[8];
#pragma unroll
            for (int i = 0; i < 8; ++i) a[i] = ((const GAS v4u*)(HX + (size_t)(task + (8 * g + i) * RST) * D))[lane];
#pragma unroll
            for (int i = 0; i < 8; ++i)
#pragma unroll
                for (int k = 0; k < 2; ++k) { const int s = __builtin_amdgcn_readlane(slot, 2 * (8 * g + i) + k); ((GAS v4u*)(XS + (size_t)s * D))[lane] = a[i]; }
        }
    }
}
struct CombRow { unsigned long long x[4], ya[4], yb[4]; };
__device__ __forceinline__ void comb_load(CombRow& R, const bf16* X, const bf16* Y, int r, int s0, int s1, int lane) {
    const GAS unsigned long long* xr = (const GAS unsigned long long*)(X + (size_t)r * D) + lane;
    const GAS unsigned long long* y0 = (const GAS unsigned long long*)(Y + (size_t)s0 * D) + lane; const GAS unsigned long long* y1 = (const GAS unsigned long long*)(Y + (size_t)s1 * D) + lane;
#pragma unroll
    for (int j = 0; j < 4; ++j) { R.x[j] = xr[64 * j]; R.ya[j] = y0[64 * j]; R.yb[j] = y1[64 * j]; }
}
__device__ __forceinline__ void p18_combine(Frame& F) {
    const int gw = F.vcu * NWAVES + F.wave, NGW = F.G * NWAVES, lane = F.lane;
    const float* MODS = (const float*)(F.ws + WS_MODS) + 3 * 6 * D;
    const int* SLOT = (const int*)(F.ws + WS_SLOT); const float* GATE = (const float*)(F.ws + WS_GATE); const bf16* Y = (const bf16*)(F.ws + WS_XS); const bf16* X3B = (const bf16*)(F.ws + WS_X3B);
    constexpr int RST = TT / 16;
    for (int task = gw; task < TT / 16; task += NGW) {
        const int r0 = task;
        const int slotv = lane < 32 ? SLOT[32 * task + lane] : 0; const float gatev = lane < 32 ? GATE[32 * task + lane] : 0.f;
        f32x4 g2[4], fg[4];
#pragma unroll
        for (int j = 0; j < 4; ++j) fg[j] = ((const GAS f32x4*)(F.in[20]))[64 * j + lane];
        CombRow nx; comb_load(nx, X3B, Y, r0, __builtin_amdgcn_readlane(slotv, 0), __builtin_amdgcn_readlane(slotv, 1), lane);
#pragma unroll 2
        for (int rr = 0; rr < 16; ++rr) {
            const int r = r0 + rr * RST; CombRow c = nx;
            if ((rr & 7) == 0) { const int mi = rr >> 3;
#pragma unroll
                for (int j = 0; j < 4; ++j) g2[j] = ((const GAS f32x4*)(MODS + (mi * 6 + 5) * D))[64 * j + lane]; }
            const float ga = __builtin_bit_cast(float, __builtin_amdgcn_readlane(__builtin_bit_cast(int, gatev), 2 * rr)), gb = __builtin_bit_cast(float, __builtin_amdgcn_readlane(__builtin_bit_cast(int, gatev), 2 * rr + 1));
            if (rr < 15) comb_load(nx, X3B, Y, r + RST, __builtin_amdgcn_readlane(slotv, 2 * rr + 2), __builtin_amdgcn_readlane(slotv, 2 * rr + 3), lane);
            f32x4 v[4]; float s = 0.f;
#pragma unroll
            for (int j = 0; j < 4; ++j) { const unsigned long long a = c.ya[j], b = c.yb[j], xw = c.x[j];
                const f32x4 xv = {bf_lo((unsigned)xw), bf_hi((unsigned)xw), bf_lo((unsigned)(xw >> 32)), bf_hi((unsigned)(xw >> 32))};
                const f32x4 ya = {bf_lo((unsigned)a), bf_hi((unsigned)a), bf_lo((unsigned)(a >> 32)), bf_hi((unsigned)(a >> 32))};
                const f32x4 yb = {bf_lo((unsigned)b), bf_hi((unsigned)b), bf_lo((unsigned)(b >> 32)), bf_hi((unsigned)(b >> 32))};
                v[j] = xv + g2[j] * (ya * ga + yb * gb); s += (v[j].x * v[j].x + v[j].y * v[j].y) + (v[j].z * v[j].z + v[j].w * v[j].w); }
            const float rstd = 1.0f / sqrtf(wave_sum(s) * (1.0f / D) + NORM_EPS);
            GAS f32x4* xo = (GAS f32x4*)(F.out + (size_t)r * D) + lane;
#pragma unroll
            for (int j = 0; j < 4; ++j) xo[64 * j] = v[j] * rstd * fg[j];
        }
    }
}

__device__ __forceinline__ bool attn_fast_ok(Frame& F, float& cref) {
    float mq = fabsf(F.in[14][F.lane]), mk = fabsf(F.in[15][F.lane]);
#pragma unroll
    for (int o = 1; o < 64; o <<= 1) { mq = fmaxf(mq, __shfl_xor(mq, o)); mk = fmaxf(mk, __shfl_xor(mk, o)); }
    const float bound = __builtin_bit_cast(float, __builtin_amdgcn_readfirstlane(__builtin_bit_cast(int, 64.0f * mq * mk * QSCALE)));
    cref = bound > 15.0f ? bound - 15.0f : 0.0f;
    return bound < 24.0f;
}
constexpr int MW_N1 = MK_FFN_SWAP ? 1000 : 10000, MW_N2 = MK_FFN_SWAP ? 33000 : MW_N1 + 18792;
__device__ __forceinline__ void tail_convert(Frame& F, int bx, int nunits, int lo, int hi) {
    const int nlong = nunits % F.G;
    if (nlong > 0) { if (bx >= nlong) moe_weights_phase(F, (bx - nlong) * NWAVES + F.wave, (F.G - nlong) * NWAVES, lo, hi); }
    else moe_weights_phase(F, F.vcu * NWAVES + F.wave, F.G * NWAVES, lo, hi);
}
#ifndef MK_SYNTH
#define MK_SYNTH 0
#endif
#if MK_SYNTH
typedef float sy_f16v __attribute__((ext_vector_type(16)));
typedef int sy_i8v __attribute__((ext_vector_type(8)));
typedef unsigned sy_u4v __attribute__((ext_vector_type(4)));
__device__ __forceinline__ void synth_phase(const Frame& F, int nsteps) {
    const int lane = mk_lane();
    sy_i8v kf0, kf1, vf0, vf1, q8, p8, ones8;
    { const int z = 0; kf0 = kf1 = vf0 = vf1 = q8 = p8 = (sy_i8v){z, z, z, z, z, z, z, z}; const int o_ = 0x38383838; ones8 = (sy_i8v){o_, o_, o_, o_, o_, o_, o_, o_}; }
    asm volatile("" : "+v"(kf0), "+v"(kf1), "+v"(vf0), "+v"(vf1), "+v"(q8), "+v"(p8), "+v"(ones8));
    sy_f16v negc, pA0, pA1, pB0, pB1, o0, o1, lacc;
    { const float m = -1.0f; negc = (sy_f16v){m, m, m, m, m, m, m, m, m, m, m, m, m, m, m, m}; pA0 = pA1 = pB0 = pB1 = negc; o0 = o1 = lacc = sy_f16v{}; }
    asm volatile("" : "+v"(negc), "+v"(pA0), "+v"(pA1), "+v"(pB0), "+v"(pB1), "+v"(o0), "+v"(o1), "+v"(lacc));
#if MK_SYNTH & 16
    const int sc = 0x7E7E7E7E;
    { LAS unsigned* l32 = (LAS unsigned*)(F.lds + RING_OFF); for (int i = F.wave * 64 + lane; i < 12288; i += NWAVES * 64) { unsigned h = (unsigned)i * 2654435761u; h ^= h >> 15; h *= 2246822519u; h ^= h >> 13; l32[i] = h & 0xBFBFBFBFu; }
      unsigned h = (unsigned)(lane + 77) * 2654435761u; h ^= h >> 15; h *= 2246822519u; h ^= h >> 13;
      _Pragma("unroll") for (int j = 0; j < 8; ++j) { h = h * 1664525u + 1013904223u; q8[j] = (int)((h ^ (h >> 11)) & 0xBFBFBFBFu); h = h * 1664525u + 1013904223u; kf0[j] = (int)((h ^ (h >> 11)) & 0xBFBFBFBFu);
        h = h * 1664525u + 1013904223u; kf1[j] = (int)((h ^ (h >> 11)) & 0xBFBFBFBFu); h = h * 1664525u + 1013904223u; vf0[j] = (int)((h ^ (h >> 11)) & 0xBFBFBFBFu); h = h * 1664525u + 1013904223u; vf1[j] = (int)((h ^ (h >> 11)) & 0xBFBFBFBFu); }
      _Pragma("unroll") for (int j = 0; j < 8; ++j) { h = h * 1664525u + 1013904223u; p8[j] = (int)((h ^ (h >> 11)) & 0xBFBFBFBFu); }
      asm volatile("" : "+v"(q8), "+v"(kf0), "+v"(kf1), "+v"(vf0), "+v"(vf1), "+v"(p8)); __syncthreads(); }
#else
    const int sc = 0x7F7F7F7F;
#endif
    LAS const unsigned char* lp = F.lds + RING_OFF + (lane & 31) * 16 + (lane >> 5) * 2048;
#define SY_SB() __builtin_amdgcn_sched_barrier(0)
#define SY_PIN(x) asm volatile("" : "+v"(x))
#if (MK_SYNTH & 33) == 33
    typedef float sy_f4v __attribute__((ext_vector_type(4)));
    sy_f4v t0, t1, t2, t3, t4, t5, t6, t7, t8, t9, nc4; { const float m = -1.0f; nc4 = (sy_f4v){m, m, m, m}; t0 = t1 = t2 = t3 = t4 = t5 = t6 = t7 = t8 = t9 = sy_f4v{}; }
    asm volatile("" : "+v"(nc4), "+v"(t0), "+v"(t1), "+v"(t2), "+v"(t3), "+v"(t4), "+v"(t5), "+v"(t6), "+v"(t7), "+v"(t8), "+v"(t9));
#define SY_M16(Dd, A, B, Cc) asm volatile("v_mfma_scale_f32_16x16x128_f8f6f4 %0, %1, %2, %3, %4, %4 op_sel_hi:[0,0,0]" : "=&v"(Dd) : "v"(A), "v"(B), "v"(Cc), "v"(sc))
#define SY_M16A(Dd, A, B) asm volatile("v_mfma_scale_f32_16x16x128_f8f6f4 %0, %1, %2, %0, %3, %3 op_sel_hi:[0,0,0] cbsz:1" : "+v"(Dd) : "v"(A), "v"(B), "v"(sc))
#define SY_AQK(C, kf, PT) do { if (&C == &pB0 || &C == &pA0) { SY_M16(t0, kf, q8, nc4); SY_M16(t1, q8, kf, nc4); } else { SY_M16(t2, kf, q8, nc4); SY_M16(t3, q8, kf, nc4); } } while (0)
#define SY_APV(O, vf, CT) do { if (&O == &o0) { SY_M16A(t4, p8, vf); SY_M16A(t5, vf, p8); } else if (&O == &o1) { SY_M16A(t6, p8, vf); SY_M16A(t7, vf, p8); } else { SY_M16A(t8, p8, vf); SY_M16A(t9, vf, p8); } } while (0)
#define SY_KEEP() asm volatile("" : "+v"(t0), "+v"(t1), "+v"(t2), "+v"(t3))
#elif MK_SYNTH & 1
#define SY_KEEP() do { } while (0)
#define SY_AQK(C, kf, PT) asm volatile("v_mfma_scale_f32_32x32x64_f8f6f4 %0, %2, %3, %4, %5, %5 op_sel_hi:[0,0,0]" : "=&v"(C), "+v"(PT) : "v"(kf), "v"(q8), "v"(negc), "v"(sc))
#define SY_APV(O, vf, CT) asm volatile("v_mfma_scale_f32_32x32x64_f8f6f4 %0, %2, %3, %0, %4, %4 op_sel_hi:[0,0,0] cbsz:1" : "+v"(O), "+v"(CT) : "v"(p8), "v"(vf), "v"(sc))
#else
#define SY_KEEP() do { } while (0)
#define SY_AQK(C, kf, PT) asm volatile("" : "+v"(C), "+v"(PT) : "v"(kf), "v"(q8), "v"(negc), "v"(sc))
#define SY_APV(O, vf, CT) asm volatile("" : "+v"(O), "+v"(CT) : "v"(p8), "v"(vf), "v"(sc))
#endif
#if MK_SYNTH & 2
#define SY_PK4(P, B, d) do { int w_; asm volatile("" : "=v"(w_)); w_ = __builtin_amdgcn_cvt_pk_bf8_f32(P[B], P[(B) + 1], w_, false); w_ = __builtin_amdgcn_cvt_pk_bf8_f32(P[(B) + 2], P[(B) + 3], w_, true); p8[d] = w_; } while (0)
#define SY_EXN(X, B) do { _Pragma("unroll") for (int e_ = 0; e_ < 8; ++e_) X[(B) + e_] = __builtin_amdgcn_exp2f(X[(B) + e_]); SY_PIN(X); } while (0)
#else
#define SY_PK4(P, B, d) do { } while (0)
#define SY_EXN(X, B) do { } while (0)
#endif
#if MK_SYNTH & 4
#define SY_KLD(dst, kp) do { const sy_u4v a_ = *(LAS const sy_u4v*)(kp), b_ = *(LAS const sy_u4v*)((kp) + 1024); dst = (sy_i8v){(int)a_.x, (int)a_.y, (int)a_.z, (int)a_.w, (int)b_.x, (int)b_.y, (int)b_.z, (int)b_.w}; } while (0)
#else
#define SY_KLD(dst, kp) do { } while (0)
#endif
#if MK_SYNTH & 8
#define SY_BAR() asm volatile("s_waitcnt vmcnt(0) lgkmcnt(0)\n\ts_barrier" ::: "memory")
#else
#define SY_BAR() do { } while (0)
#endif
#define SY_STEP(C0, C1, P0, P1) do { SY_SB(); \
    SY_AQK(C0, kf0, P0); SY_PK4(P0, 0, 0); SY_PK4(P0, 4, 1); SY_PK4(P0, 8, 2); SY_PK4(P0, 12, 3); SY_KLD(vf0, lp + 32768); SY_PIN(p8); SY_SB(); \
    SY_AQK(C1, kf1, P1); SY_PK4(P1, 0, 4); SY_PK4(P1, 4, 5); SY_PK4(P1, 8, 6); SY_PK4(P1, 12, 7); SY_KLD(vf1, lp + 32768 + 512); SY_PIN(p8); SY_SB(); \
    SY_APV(o0, vf0, C0); SY_EXN(C0, 0); SY_SB(); \
    SY_APV(o1, vf1, C0); SY_EXN(C0, 8); SY_KLD(kf0, lp); SY_SB(); \
    SY_APV(lacc, ones8, C1); SY_EXN(C1, 0); SY_KLD(kf1, lp + 512); SY_SB(); \
    SY_EXN(C1, 8); SY_SB(); } while (0)
#pragma nounroll
    for (int t = 0; t < nsteps; t += 2) {
        SY_STEP(pB0, pB1, pA0, pA1); SY_KEEP(); SY_BAR();
        SY_STEP(pA0, pA1, pB0, pB1); SY_KEEP(); SY_BAR();
    }
    asm volatile("s_nop 15\n\ts_nop 15" : "+v"(o0), "+v"(o1), "+v"(lacc), "+v"(pA0), "+v"(pA1), "+v"(pB0), "+v"(pB1));
#if (MK_SYNTH & 33) == 33
    asm volatile("" : "+v"(t0), "+v"(t1), "+v"(t2), "+v"(t3), "+v"(t4), "+v"(t5), "+v"(t6), "+v"(t7), "+v"(t8), "+v"(t9));
#endif
}
#endif
struct Args { const float* in[21]; float* out; unsigned char* ws; int ph_lo, ph_hi; };
__global__ void __launch_bounds__(NWAVES * 64, 2) mk_fwd(Args args) {
    extern __shared__ __attribute__((aligned(16))) unsigned char lds[];
    Frame F;
    F.lds = (LAS unsigned char*)lds;
    F.MISC = (volatile LAS unsigned*)(F.lds + MISC_OFF);
    F.wave = __builtin_amdgcn_readfirstlane((int)threadIdx.x >> 6); F.lane = mk_lane(); F.tid = F.wave * 64 + F.lane;
#define FRESH() do { F.lane = mk_lane(); F.tid = F.wave * 64 + F.lane; } while (0)
    F.G = gridDim.x; { const int bx = blockIdx.x; F.vcu = (F.G % 8 == 0) ? (bx % 8) * (F.G / 8) + bx / 8 : bx; }
    F.ws = args.ws; F.ctl = (gu32*)(args.ws + WS_CTL); F.out = args.out;
#pragma unroll
    for (int i = 0; i < 21; ++i) F.in[i] = args.in[i];
    for (int u = F.tid; u < (LDS_BYTES - LDSCTL_OFF) / 4; u += NWAVES * 64) ((LAS unsigned*)(F.lds + LDSCTL_OFF))[u] = 0u;
    __syncthreads();
    XcdBarrier bar; bar.bar = (unsigned*)(F.ctl + CW_BAR); bar.x = 0; bar.st = nullptr; bar.w = F.wave;
    if (N_LAUNCHES != PER_PHASE) bar = xcd_barrier_post((unsigned*)(F.ctl + CW_BAR), F.MISC + 8, F.wave);
#define GRID_BAR(seam) do { if (N_LAUNCHES == PER_PHASE) { if (F.tid == 0) __hip_atomic_store(F.ctl + CW_TMO, 0xBADBA0u | (unsigned)(seam), RLX_AGENT); } else { xcd_barrier(bar); } } while (0)
    const int lo = args.ph_lo, hi = args.ph_hi;
#define IN(k) (lo <= (k) && (k) < hi)
#define BOTH(k) (IN(k) && IN((k) + 1))
#ifndef MK_REPN
#define MK_REPN 1
#endif
#define NREP(k) (((MK_REPEAT >> (k)) & 1) * MK_REPN)
#define REPEAT(k) for (int rep_ = 0; rep_ <= NREP(k); ++rep_, (rep_ <= NREP(k) ? (void)xcd_barrier(bar) : (void)0))
    const int bx = (int)blockIdx.x;
    const float* MODS0 = (const float*)(F.ws + WS_MODS); const float* MODS1 = MODS0 + 3 * 6 * D;
    bf16* HXB = (bf16*)(F.ws + WS_XS); float* CTXB = (float*)(F.ws + WS_CTXB); float* CTXB2 = CTXB + (size_t)NCTX * D; bf16* HB = (bf16*)(F.ws + WS_BIG);
    bf16* X1B = (bf16*)F.out; bf16* X2B = X1B + (size_t)TT * D; bf16* X3B = (bf16*)(F.ws + WS_X3B);
    bf16* HXB2 = (bf16*)(F.ws + WS_QN);

#if MK_SYNTH
    if (IN(0)) { synth_phase(F, 2080); __syncthreads(); }
#endif
    if (IN(0)) { FRESH(); REPEAT(0) { p0_phase(F); } if (BOTH(0)) GRID_BAR(0); }
    if (IN(2)) { FRESH(); REPEAT(2) { p2_pooldiff_ring(F); } if (BOTH(2)) GRID_BAR(2); }
    if (IN(3)) { FRESH();
        pg8::Gemm g{HXB, (const bf16*)(F.ws + WS_POOL), 256, D, 256}; pg8::GridOrder S{NPT, 4, F.G, bx, 256, 1 + NREP(3)};
        if (MK_FP8_POOL) { pg8::Gemm g8{HXB, (const bf16*)(F.ws + WS_POOL), 128, D / 2, 128}; pg8::GridOrder S8{NPT, 4, F.G, bx, 128, 1 + NREP(3)};
            pg8::EpiResB E{(const unsigned char*)F.in[0], F.in[2], (pg8::bf16_t*)X1B, CTXB, MODS0, F.in[8], 2, 0, 1.0f / (FP8_SA * FP8_SW)};
            pg8::gemm_phase<pg8::EpiResB, pg8::GridOrder, true, true, true>(F.lds + RING_OFF, g8, S8, E, F.wave); }
        else { pg8::EpiResB E{(const unsigned char*)F.in[0], F.in[2], (pg8::bf16_t*)X1B, CTXB, MODS0, F.in[8], 2, 0, 1.0f};
            pg8::gemm_phase<pg8::EpiResB, pg8::GridOrder, true, true>(F.lds + RING_OFF, g, S, E, F.wave); }
        if (BOTH(3)) GRID_BAR(3);
    }
    if (IN(4)) { FRESH(); REPEAT(4) { normmod_phase(F, X1B, CTXB, HXB, F.in[6] + D, MODS0, 3, 4, MT, MK_FFN_SWAP != 0); } if (BOTH(4)) GRID_BAR(4); }
    if (IN(5)) { FRESH();
        pg8::Gemm g{HXB, (const bf16*)(F.ws + WS_W13F), D, D, D}; pg8::GridOrder S{NPT, 22, F.G, bx, 0, 1 + NREP(5)};
        if (MK_FFN_SWAP) { pg8::Gemm g8{HXB, (const bf16*)(F.ws + WS_W13F), D / 2, D / 2, D / 2}; pg8::EpiSwiGLU E{HB, FF, 1.0f / (FP8_SA * FP8_SW)};
            pg8::gemm_phase<pg8::EpiSwiGLU, pg8::GridOrder, true, true, true>(F.lds + RING_OFF, g8, S, E, F.wave); }
        else if (MK_FP8_DENSE) { pg8::EpiSwiGLU8 E{F.ws + WS_BIG, FF, 1.0f, FP8_SH};
            pg8::gemm_phase<pg8::EpiSwiGLU8, pg8::GridOrder, true, true>(F.lds + RING_OFF, g, S, E, F.wave); }
        else { pg8::EpiSwiGLU E{HB, FF, 1.0f};
            pg8::gemm_phase<pg8::EpiSwiGLU, pg8::GridOrder, true, true>(F.lds + RING_OFF, g, S, E, F.wave); }
        tail_convert(F, bx, NPT * 22, 0, MW_N1);
        if (BOTH(5)) GRID_BAR(5);
    }
    if (IN(6)) { FRESH();
        pg8::GridOrder S{NPT, 4, F.G, bx, 0, 1 + NREP(6)};
        if (MK_FP8_DENSE && !MK_FFN_SWAP) { pg8::Gemm g{HB, (const bf16*)(F.ws + WS_W2F), FF / 2, FF / 2, FF / 2};
            pg8::EpiResB E{(const unsigned char*)X1B, CTXB, (pg8::bf16_t*)X2B, CTXB2, MODS0, nullptr, 5, 1, 1.0f / (FP8_SH * FP8_SW)};
            pg8::gemm_phase<pg8::EpiResB, pg8::GridOrder, true, true, true>(F.lds + RING_OFF, g, S, E, F.wave); }
        else { pg8::Gemm g{HB, (const bf16*)(F.ws + WS_W2F), FF, FF, FF};
            pg8::EpiResB E{(const unsigned char*)X1B, CTXB, (pg8::bf16_t*)X2B, CTXB2, MODS0, nullptr, 5, 1, 1.0f};
            pg8::gemm_phase<pg8::EpiResB, pg8::GridOrder, true, true>(F.lds + RING_OFF, g, S, E, F.wave); }
        tail_convert(F, bx, NPT * 4, MW_N1, MW_N2);
        if (BOTH(6)) GRID_BAR(6);
    }
    if (IN(7)) { FRESH(); REPEAT(7) { normmod_phase(F, X2B, CTXB2, HXB2, F.in[6] + 2 * D, MODS1, 0, 1, MT, MK_FP8_DENSE != 0); } if (BOTH(7)) GRID_BAR(7); }
    if (IN(8)) { FRESH();
        pg8::QkvOrder S{F.G, bx, 1 + NREP(8)};
        if (MK_FP8_DENSE) { pg8::Gemm g{HXB2, (const bf16*)(F.ws + WS_WQKV), D / 2, D / 2, D / 2};
            pg8::EpiQKV E{(bf16*)(F.ws + WS_Q), (bf16*)(F.ws + WS_K), (bf16*)(F.ws + WS_V), 1.0f / (FP8_SA * FP8_SW)};
            pg8::gemm_phase<pg8::EpiQKV, pg8::QkvOrder, true, true, true>(F.lds + RING_OFF, g, S, E, F.wave); }
        else { pg8::Gemm g{HXB2, (const bf16*)(F.ws + WS_WQKV), D, D, D};
            pg8::EpiQKV E{(bf16*)(F.ws + WS_Q), (bf16*)(F.ws + WS_K), (bf16*)(F.ws + WS_V), 1.0f};
            pg8::gemm_phase<pg8::EpiQKV, pg8::QkvOrder, true, true>(F.lds + RING_OFF, g, S, E, F.wave); }
        tail_convert(F, bx, 772, MW_N2, NE * 4224);
        if (BOTH(8)) GRID_BAR(8);
    }
    if (IN(9)) { FRESH(); REPEAT(9) { float cref_; const bool fast_ = attn_fast_ok(F, cref_); p9_qknorm(F, fast_); if (fast_) p9_vtrans(F); } if (BOTH(9)) GRID_BAR(9); }
    if (IN(10)) { FRESH(); REPEAT(10) {
        float cref; const bool fast = attn_fast_ok(F, cref);
        const attn_body::AttnTensors AT{(const attn_body::bf16*)(F.ws + WS_QN), (const attn_body::bf16*)(F.ws + WS_KN), (const attn_body::bf16*)(F.ws + WS_V), (attn_body::bf16*)(F.ws + WS_O), F.ws + WS_QN, F.ws + WS_KN, F.ws + WS_VT, cref};
        const attn_body::StaticOrder S((int)F.G, bx);
        attn_body::attn_phase<attn_body::StaticOrder>((char*)lds + RING_OFF, AT, S, fast, F.wave);
        } if (BOTH(10)) GRID_BAR(10);
    }
    if (IN(11)) { FRESH();
        pg8::Gemm g{(const bf16*)(F.ws + WS_O), (const bf16*)(F.ws + WS_WO), D, D, D}; pg8::GridOrder S{NPX, 4, F.G, bx, 0, 1 + NREP(11)};
        float crefo_; const bool fasto_ = MK_FP8_WO && attn_fast_ok(F, crefo_);
        if (fasto_) { pg8::Gemm g8{(const bf16*)(F.ws + WS_O), (const bf16*)(F.ws + WS_WO8), D / 2, D / 2, D / 2};
            pg8::EpiResB E{(const unsigned char*)X2B, CTXB2, (pg8::bf16_t*)X3B, CTXB2, MODS1, nullptr, 2, 1, 1.0f / (64.0f * FP8_SW)};
            pg8::gemm_phase<pg8::EpiResB, pg8::GridOrder, true, true, true>(F.lds + RING_OFF, g8, S, E, F.wave); }
        else { pg8::EpiResB E{(const unsigned char*)X2B, CTXB2, (pg8::bf16_t*)X3B, CTXB2, MODS1, nullptr, 2, 1, 1.0f};
            pg8::gemm_phase<pg8::EpiResB, pg8::GridOrder, true, true>(F.lds + RING_OFF, g, S, E, F.wave); }
        if (BOTH(11)) GRID_BAR(11);
    }
    if (IN(12)) { FRESH(); REPEAT(12) { p12_router(F); } if (BOTH(12)) GRID_BAR(12); }
    if (IN(13)) { FRESH(); REPEAT(13) { p13_slots(F); } if (BOTH(13)) GRID_BAR(13); }
    if (IN(14)) { FRESH();
        const int* PEXP = (const int*)(F.ws + WS_PEXP); const int np = __builtin_amdgcn_readfirstlane(PEXP[512]);
        pg8::Gemm g{(const bf16*)(F.ws + WS_XS), (const bf16*)(F.ws + WS_W13M), D / 2, D / 2, D / 2}; pg8::MoeOrder S{np, 22, F.G, bx, 0, 0, 1 + NREP(14), PEXP};
        pg8::EpiSwiGLU8 E{F.ws + WS_BIG, FF, 1.0f / (FP8_SA * FP8_SW), FP8_SH};
        pg8::gemm_phase<pg8::EpiSwiGLU8, pg8::MoeOrder, true, true, true>(F.lds + RING_OFF, g, S, E, F.wave);
        if (BOTH(14)) GRID_BAR(14);
    }
    if (IN(15)) { FRESH();
        const int* PEXP = (const int*)(F.ws + WS_PEXP); const int np = __builtin_amdgcn_readfirstlane(PEXP[512]);
        pg8::Gemm g{(const bf16*)(F.ws + WS_BIG), (const bf16*)(F.ws + WS_W2M), FF / 2, FF / 2, FF / 2}; pg8::MoeOrder S{np, 4, F.G, bx, 0, 0, 1 + NREP(15), PEXP};
        pg8::EpiBf16 E{(bf16*)(F.ws + WS_XS), D, 1.0f / (FP8_SH * FP8_SW)};
        pg8::gemm_phase<pg8::EpiBf16, pg8::MoeOrder, true, true, true>(F.lds + RING_OFF, g, S, E, F.wave);
        if (BOTH(15)) GRID_BAR(15);
    }
    if (IN(16)) { FRESH(); REPEAT(16) { p18_combine(F); } }
#undef IN
#undef BOTH
}

extern "C" void kernel_launch(void* const* d_in, const int* in_sizes, int n_in, void* d_out, int out_size, void* d_ws, size_t ws_size, hipStream_t stream) {
    static int grid = 0;
    if (grid == 0) {
        if (n_in != 21 || in_sizes[0] != TT * D || out_size != TT * D || ws_size < WS_END) { fprintf(stderr, "kernel_launch: unexpected shapes (n_in %d, in0 %d, out %d, ws %zu); nothing launched\n", n_in, n_in > 0 ? in_sizes[0] : -1, out_size, ws_size); grid = -1; return; }
        int dev = 0, cus = 0, per_cu = 0;
        if (hipGetDevice(&dev) != hipSuccess || hipDeviceGetAttribute(&cus, hipDeviceAttributeMultiprocessorCount, dev) != hipSuccess) { grid = -1; return; }
        if (hipFuncSetAttribute((const void*)mk_fwd, hipFuncAttributeMaxDynamicSharedMemorySize, LDS_BYTES) != hipSuccess) { fprintf(stderr, "kernel_launch: hipFuncSetAttribute failed\n"); grid = -1; return; }
        if (hipOccupancyMaxActiveBlocksPerMultiprocessor(&per_cu, (const void*)mk_fwd, NWAVES * 64, LDS_BYTES) != hipSuccess || per_cu < 1)
            fprintf(stderr, "kernel_launch: note: occupancy query reports %d workgroups per CU\n", per_cu);
        (void)hipGetLastError();
        grid = cus;
    }
    if (grid < 0) return;
    if (hipMemsetAsync((char*)d_ws + WS_CTL, 0, CTL_ZERO_BYTES, stream) != hipSuccess) return;
    Args a{};
    for (int i = 0; i < 21; ++i) a.in[i] = (const float*)d_in[i];
    a.out = (float*)d_out; a.ws = (unsigned char*)d_ws;
    if (N_LAUNCHES == 1) { a.ph_lo = 0; a.ph_hi = PER_PHASE; hipLaunchKernelGGL(mk_fwd, dim3(grid), dim3(NWAVES * 64), LDS_BYTES, stream, a); }
    else for (int li = 0; li < PER_PHASE; ++li) { a.ph_lo = li; a.ph_hi = li + 1; hipLaunchKernelGGL(mk_fwd, dim3(grid), dim3(NWAVES * 64), LDS_BYTES, stream, a); }
}
```
